# Optimizing an MI355X kernel written in HIP

```python
import jax, jax.numpy as jnp
from jax import lax
import numpy as np

D_MODEL = 2048
BATCH = 4
SEQ = 2048
DEPTH = 2
DEC_BATCH = 128
DEC_SEQ = 8
PAST_LEN = 16384
PAGE_SIZE = 128

G_A = 8
DG_A = D_MODEL // 16
D_A = G_A * DG_A
CHUNK = 128
H_B = 16
DK = D_MODEL // H_B
DV = D_MODEL // H_B
D_BK = H_B * DK
D_BV = H_B * DV
HG_CHUNK = 16
D_FF = 5632
CONV_W = 3
N_IN = 2 * D_A + 2 * D_BK + 2 * D_BV + 2 * D_MODEL
SPLITS = tuple(int(s) for s in np.cumsum([D_A, D_A, D_BK, D_BK, D_BV, D_BV, D_MODEL]))
EPS = 1e-6

kernel_name = "hybrid_gmlp_hgrn2_convffn_adaln_step"


def _rmsnorm(x, g):
    xf = x.astype(jnp.float32)
    y = xf * lax.rsqrt(jnp.mean(xf * xf, axis=-1, keepdims=True) + EPS) * g.astype(jnp.float32)
    return y.astype(x.dtype)


def _spatial_gate(u, v, w_s, b_s):
    B, L, G, DG = v.shape
    Lc = min(L, CHUNK)
    n = L // Lc
    w = jnp.tril(w_s[:, :Lc, :Lc])
    vc = v.reshape(B, n, Lc, G, DG)
    s = jnp.einsum('gts,bnsgc->bntgc', w, vc) + b_s[:, :Lc].T[None, None, :, :, None]
    return u * s.reshape(B, L, G, DG)


def _hgrn2(q, k, v, log_f, s0):
    B, L, H, _ = q.shape
    C = min(HG_CHUNK, L)
    n = -(-L // C)
    pad = n * C - L
    f32 = jnp.float32

    def prep(a):
        a = jnp.pad(a.astype(f32), ((0, 0), (0, pad), (0, 0), (0, 0)))
        return a.reshape(B, n, C, H, a.shape[-1]).transpose(1, 0, 3, 2, 4)

    qc, kc, vc, gc = prep(q), prep(k), prep(v), prep(log_f)
    mask = jnp.tril(jnp.ones((C, C), dtype=bool))[:, :, None]

    def step(S, blk):
        qb, kb, vb, gb = blk
        A = jnp.cumsum(gb, axis=2)
        A_last = A[:, :, -1:, :]
        o_inter = jnp.einsum('bhtk,bhkv->bhtv', qb * jnp.exp(A), S)
        decay = jnp.exp(jnp.where(mask, A[:, :, :, None, :] - A[:, :, None, :, :], -jnp.inf))
        scores = jnp.einsum('bhtk,bhtsk,bhsk->bhts', qb, decay, kb)
        o = o_inter + jnp.einsum('bhts,bhsv->bhtv', scores, vb)
        S = jnp.exp(A_last[:, :, 0, :])[..., None] * S + jnp.einsum(
            'bhsk,bhsv->bhkv', kb * jnp.exp(A_last - A), vb)
        return S, o

    S, o = lax.scan(step, s0.astype(f32), (qc, kc, vc, gc))
    o = o.transpose(1, 0, 3, 2, 4).reshape(B, n * C, H, -1)[:, :L]
    return o.astype(v.dtype), S.astype(s0.dtype)


def _layer(x, c, conv_state, s0, lb, ada_w, ada_b, n1, n2, w_in, v_g, w_s, b_s, w_ba,
           o_g, w_bb, w_out, w_up, conv_w, conv_b, w_down):
    B, L, _ = x.shape
    mod = jnp.dot(jax.nn.silu(c), ada_w) + ada_b
    sh1, sc1, g1, sh2, sc2, g2 = [m[:, None, :] for m in jnp.split(mod, 6, axis=-1)]

    h = _rmsnorm(x, n1) * (1 + sc1) + sh1
    z = jnp.einsum('bld,de->ble', h, w_in)
    u, v, q, f, i, og, ga, gb = jnp.split(z, SPLITS, axis=-1)

    u = jax.nn.gelu(u).reshape(B, L, G_A, DG_A)
    v = _rmsnorm(jax.nn.gelu(v).reshape(B, L, G_A, DG_A), v_g.reshape(G_A, DG_A))
    ya = _spatial_gate(u, v, w_s, b_s).reshape(B, L, D_A)
    Lc = min(L, CHUNK)
    start = ((L - 1) // Lc) * Lc
    v_rows = v[:, start:].reshape(B, L - start, D_A)

    q = jax.nn.silu(q).reshape(B, L, H_B, DK) * (DK ** -0.5)
    log_f = jnp.logaddexp(jnp.log(lb), jnp.log1p(-lb) + jax.nn.log_sigmoid(f.astype(jnp.float32)))
    log_f = log_f.reshape(B, L, H_B, DK)
    k = -jnp.expm1(log_f)
    o, s_new = _hgrn2(q, k, i.reshape(B, L, H_B, DV), log_f, s0)
    o = _rmsnorm(o, o_g.reshape(H_B, DV)).reshape(B, L, D_BV) * jax.nn.silu(og)

    y = jax.nn.sigmoid(ga) * jnp.dot(ya, w_ba) + jax.nn.sigmoid(gb) * jnp.dot(o, w_bb)
    x = x + g1 * jnp.dot(y, w_out)

    h = _rmsnorm(x, n2) * (1 + sc2) + sh2
    up = jnp.dot(h, w_up)
    full = jnp.concatenate([conv_state.astype(up.dtype), up], axis=1)
    acc = conv_b
    for j in range(CONV_W):
        acc = acc + full[:, j:j + L] * conv_w[j]
    a, bv = jnp.split(acc, 2, axis=-1)
    x = x + g2 * jnp.dot(jax.nn.gelu(a) * bv, w_down)
    new_conv = full[:, L:]
    return x, new_conv.astype(conv_state.dtype), s_new, v_rows


def setup_inputs(seed: int = 0) -> dict:
    key = jax.random.key(seed)
    ks = jax.random.split(key, 32)

    def nrm(k, shape, scale):
        return jax.random.normal(k, shape, jnp.float32) * scale

    return {
        "x_prompt": nrm(ks[0], (BATCH, SEQ, D_MODEL), 1.0),
        "x_sample": nrm(ks[1], (DEC_BATCH, DEC_SEQ, D_MODEL), 1.0),
        "c_prompt": nrm(ks[2], (BATCH, D_MODEL), 1.0),
        "c_sample": nrm(ks[3], (DEC_BATCH, D_MODEL), 1.0),
        "state_hgrn": nrm(ks[4], (DEPTH, DEC_BATCH, H_B, DK, DV), 0.5),
        "state_ffn_conv": nrm(ks[5], (DEPTH, DEC_BATCH, CONV_W - 1, 2 * D_FF), 1.0),
        "ada_w": nrm(ks[6], (DEPTH, D_MODEL, 6 * D_MODEL), 0.3 * D_MODEL ** -0.5),
        "ada_b": nrm(ks[7], (DEPTH, 6 * D_MODEL), 0.02),
        "norm1_g": 1.0 + nrm(ks[8], (DEPTH, D_MODEL), 0.02),
        "norm2_g": 1.0 + nrm(ks[9], (DEPTH, D_MODEL), 0.02),
        "w_in": nrm(ks[10], (DEPTH, D_MODEL, N_IN), D_MODEL ** -0.5),
        "gmlp_v_g": 1.0 + nrm(ks[11], (DEPTH, D_A), 0.02),
        "gmlp_ws": nrm(ks[12], (DEPTH, G_A, CHUNK, CHUNK), CHUNK ** -0.5),
        "gmlp_bs": 1.0 + nrm(ks[13], (DEPTH, G_A, CHUNK), 0.02),
        "w_branch_a": nrm(ks[14], (DEPTH, D_A, D_MODEL), D_A ** -0.5),
        "hgrn_lower_bounds": nrm(ks[15], (DEPTH, D_BK), 0.5),
        "hgrn_norm_g": 1.0 + nrm(ks[16], (DEPTH, D_BV), 0.02),
        "w_branch_b": nrm(ks[17], (DEPTH, D_BV, D_MODEL), D_BV ** -0.5),
        "w_out": nrm(ks[18], (DEPTH, D_MODEL, D_MODEL), D_MODEL ** -0.5),
        "w_up": nrm(ks[19], (DEPTH, D_MODEL, 2 * D_FF), D_MODEL ** -0.5),
        "conv_w": nrm(ks[20], (DEPTH, CONV_W, 2 * D_FF), CONV_W ** -0.5),
        "conv_b": nrm(ks[21], (DEPTH, 2 * D_FF), 0.02),
        "w_down": nrm(ks[22], (DEPTH, D_FF, D_MODEL), D_FF ** -0.5),
        "final_norm_g": 1.0 + nrm(ks[23], (D_MODEL,), 0.02),
    }


def reference(x_prompt, x_sample, c_prompt, c_sample, state_hgrn, state_ffn_conv,
              ada_w, ada_b, norm1_g, norm2_g, w_in, gmlp_v_g, gmlp_ws, gmlp_bs,
              w_branch_a, hgrn_lower_bounds, hgrn_norm_g, w_branch_b, w_out, w_up,
              conv_w, conv_b, w_down, final_norm_g):
    p = jax.nn.softmax(hgrn_lower_bounds.astype(jnp.float32), axis=0)
    lb_all = jnp.cumsum(p, axis=0)
    lb_all = lb_all - lb_all[0:1]

    conv0 = jnp.zeros((BATCH, CONV_W - 1, 2 * D_FF), state_ffn_conv.dtype)
    s00 = jnp.zeros((BATCH, H_B, DK, DV), state_hgrn.dtype)

    xp, xs = x_prompt, x_sample
    hp, hs, cp, cs, vp, vs = [], [], [], [], [], []
    for l in range(DEPTH):
        w = (ada_w[l], ada_b[l], norm1_g[l], norm2_g[l], w_in[l], gmlp_v_g[l], gmlp_ws[l],
             gmlp_bs[l], w_branch_a[l], hgrn_norm_g[l], w_branch_b[l], w_out[l], w_up[l],
             conv_w[l], conv_b[l], w_down[l])
        xp, c_p, h_p, v_p = _layer(xp, c_prompt, conv0, s00, lb_all[l], *w)
        xs, c_s, h_s, v_s = _layer(xs, c_sample, state_ffn_conv[l], state_hgrn[l], lb_all[l], *w)
        hp.append(h_p); hs.append(h_s); cp.append(c_p); cs.append(c_s); vp.append(v_p); vs.append(v_s)

    y_prompt = _rmsnorm(xp, final_norm_g)
    y_sample = _rmsnorm(xs, final_norm_g)
    return (y_prompt, y_sample, jnp.stack(hp), jnp.stack(hs), jnp.stack(cp), jnp.stack(cs),
            jnp.stack(vp), jnp.stack(vs))
```

```cpp
#include <hip/hip_runtime.h>
#include <cstdio>
#include <cstdint>
namespace pg8 {
#define PG8_LAS __attribute__((address_space(3)))
typedef unsigned short bf16_t;
typedef short bf16x8 __attribute__((ext_vector_type(8)));
typedef float f32x4 __attribute__((ext_vector_type(4)));
typedef unsigned u32x4 __attribute__((ext_vector_type(4)));
constexpr int BM = 256, BK = 64, HALF = 128, HTB = HALF * BK * 2  , STAGE_BYTES = 8 * HTB, NXCD = 8, WGM = 8;

__host__ __device__ __forceinline__ int lds_byte(int r, int c) { const int st = (r >> 4) * 2 + (c >> 5), rr = r & 15, cc = c & 31, ob = rr * 64 + cc * 2; return st * 1024 + (ob ^ (((ob >> 9) & 1) << 5)); }
__host__ __device__ __forceinline__ void stage_rc(int b, int& R, int& C) { const int st = b / 1024, sb = b % 1024, swz = sb ^ (((sb >> 9) & 1) << 5); R = (st >> 1) * 16 + swz / 64; C = (st & 1) * 32 + (swz % 64) / 2; }
__host__ __device__ __forceinline__ int perm32(int rho) { const int n = rho >> 4, i = rho & 15; return 8 * (i >> 2) + 4 * n + (i & 3); }

struct Unit { int pm, pn; };
struct Gemm { const bf16_t* A; const bf16_t* Bt; int M, N, K; };

struct StaticOrder {
    int nM, nN, nwg, G, c;
    __host__ __device__ void init(int M, int N, int G_, int c_) { nM = M / BM; nN = N / BM; nwg = nM * nN; G = G_; c = c_; }
    __host__ __device__ bool next(int i, Unit& u) const {
        const long L = (long)i * G + c; if (L >= nwg) return false;
        int wgid = (int)L; { const int q = nwg / NXCD, r = nwg % NXCD, xcd = wgid % NXCD, off = wgid / NXCD; wgid = (xcd < r ? xcd * (q + 1) : r * (q + 1) + (xcd - r) * q) + off; }
        const int nig = WGM * nN, gid = wgid / nig, fm = gid * WGM, gsz = (nM - fm) < WGM ? (nM - fm) : WGM;
        u.pm = fm + ((wgid % nig) % gsz); u.pn = (wgid % nig) / gsz; return true;
    }
    __device__ __forceinline__ void a_ready(const Unit&) const {}
    __device__ __forceinline__ void done(const Unit&) const {}
};

__device__ __forceinline__ unsigned cvt_pk_bf16(float lo, float hi) { unsigned r; asm volatile("v_cvt_pk_bf16_f32 %0, %1, %2" : "=v"(r) : "v"(lo), "v"(hi)); return r; }
typedef float f32x2 __attribute__((ext_vector_type(2)));
typedef unsigned u32x2 __attribute__((ext_vector_type(2)));
typedef float f32x2 __attribute__((ext_vector_type(2)));
typedef __bf16 bf2_t __attribute__((ext_vector_type(2)));
__device__ __forceinline__ unsigned pkbf(float lo, float hi) { f32x2 v = {lo, hi}; return __builtin_bit_cast(unsigned, __builtin_convertvector(v, bf2_t)); }
__device__ __forceinline__ float bflo(unsigned w) { return __builtin_bit_cast(float, w << 16); }
__device__ __forceinline__ float bfhi(unsigned w) { return __builtin_bit_cast(float, w & 0xffff0000u); }
__device__ __forceinline__ float sigm(float x) { return __builtin_amdgcn_rcpf(1.f + __builtin_amdgcn_exp2f(-1.44269504089f * x)); }
__device__ __forceinline__ float gelu_t(float x) { const float u = x * (1.f + 0.044715f * x * x); return x * sigm(1.59576912161f * u); }

struct EpiF32 {
    static constexpr bool PERM = false, AFTER_DRAIN = false, HAS_MID = false;
    float* C; int ldc; const float* bias;
    __device__ __forceinline__ void operator()(const f32x4 (&acc)[2][2][4][2], const Unit& u, int wr, int wc, int fr, int fq) const {
        const int row0 = u.pm * BM + wr * 64 + fr, col0 = u.pn * BM + wc * 32 + 4 * fq;
        f32x4 bv[2][2];
#pragma unroll
        for (int bj = 0; bj < 2; ++bj)
#pragma unroll
            for (int n = 0; n < 2; ++n) bv[bj][n] = *(const f32x4*)(bias + col0 + bj * HALF + n * 16);
#pragma unroll
        for (int ai = 0; ai < 2; ++ai)
#pragma unroll
            for (int m = 0; m < 4; ++m) { float* rowp = C + (size_t)(row0 + ai * HALF + m * 16) * ldc + col0;
#pragma unroll
                for (int bj = 0; bj < 2; ++bj)
#pragma unroll
                    for (int n = 0; n < 2; ++n) *(f32x4*)(rowp + bj * HALF + n * 16) = acc[ai][bj][m][n] + bv[bj][n]; }
    }
};
template <int MODE> __device__ __forceinline__ float zact(float x) {
    if (MODE == 0) return gelu_t(x);
    if (MODE == 1) return x * sigm(x) * 0.08838834764831845f;
    if (MODE == 2) return x;
    if (MODE == 3) return x * sigm(x);
    return sigm(x);
}
struct EpiZ {
    static constexpr bool PERM = true, AFTER_DRAIN = false, HAS_MID = false;
    bf16_t* Z; int ldc;
    template <int MODE> __device__ __forceinline__ void run(const f32x4 (&acc)[2][2][4][2], const Unit& u, int wr, int wc, int fr, int fq) const {
        const int row0 = u.pm * BM + wr * 64 + fr, col0 = u.pn * BM + wc * 32 + 8 * fq;
#pragma unroll
        for (int ai = 0; ai < 2; ++ai)
#pragma unroll
            for (int m = 0; m < 4; ++m) { bf16_t* rowp = Z + (size_t)(row0 + ai * HALF + m * 16) * ldc + col0;
#pragma unroll
                for (int bj = 0; bj < 2; ++bj) { const f32x4 v0 = acc[ai][bj][m][0], v1 = acc[ai][bj][m][1];
                    u32x4 w; w.x = pkbf(zact<MODE>(v0[0]), zact<MODE>(v0[1])); w.y = pkbf(zact<MODE>(v0[2]), zact<MODE>(v0[3]));
                    w.z = pkbf(zact<MODE>(v1[0]), zact<MODE>(v1[1])); w.w = pkbf(zact<MODE>(v1[2]), zact<MODE>(v1[3]));
                    *(u32x4*)(rowp + bj * HALF) = w; } }
    }
    __device__ __forceinline__ void operator()(const f32x4 (&acc)[2][2][4][2], const Unit& u, int wr, int wc, int fr, int fq) const {
        const int pn = u.pn;
        if (pn < 8) run<0>(acc, u, wr, wc, fr, fq);
        else if (pn < 16) run<1>(acc, u, wr, wc, fr, fq);
        else if (pn < 32) run<2>(acc, u, wr, wc, fr, fq);
        else if (pn < 40) run<3>(acc, u, wr, wc, fr, fq);
        else run<4>(acc, u, wr, wc, fr, fq);
    }
};
template <bool SECOND> struct EpiBranch {
    static constexpr bool PERM = true, AFTER_DRAIN = false, HAS_MID = false;
    const bf16_t* Zg; bf16_t* Y;
    __device__ __forceinline__ void operator()(const f32x4 (&acc)[2][2][4][2], const Unit& u, int wr, int wc, int fr, int fq) const {
        const int row0 = u.pm * BM + wr * 64 + fr, col0 = u.pn * BM + wc * 32 + 8 * fq;
#pragma unroll
        for (int ai = 0; ai < 2; ++ai)
#pragma unroll
            for (int m = 0; m < 4; ++m) { const size_t row = (size_t)(row0 + ai * HALF + m * 16); const bf16_t* zr = Zg + row * 14336 + col0; bf16_t* yr = Y + row * 2048 + col0;
#pragma unroll
                for (int bj = 0; bj < 2; ++bj) { const u32x4 gt = *(const u32x4*)(zr + bj * HALF); const f32x4 v0 = acc[ai][bj][m][0], v1 = acc[ai][bj][m][1];
                    float r[8] = {v0[0] * bflo(gt.x), v0[1] * bfhi(gt.x), v0[2] * bflo(gt.y), v0[3] * bfhi(gt.y), v1[0] * bflo(gt.z), v1[1] * bfhi(gt.z), v1[2] * bflo(gt.w), v1[3] * bfhi(gt.w)};
                    if (SECOND) { const u32x4 p = *(const u32x4*)(yr + bj * HALF);
                        r[0] += bflo(p.x); r[1] += bfhi(p.x); r[2] += bflo(p.y); r[3] += bfhi(p.y); r[4] += bflo(p.z); r[5] += bfhi(p.z); r[6] += bflo(p.w); r[7] += bfhi(p.w); }
                    u32x4 w; w.x = pkbf(r[0], r[1]); w.y = pkbf(r[2], r[3]); w.z = pkbf(r[4], r[5]); w.w = pkbf(r[6], r[7]);
                    *(u32x4*)(yr + bj * HALF) = w; }
                asm volatile("" ::: "memory"); }
    }
};
struct EpiResid {
    static constexpr bool PERM = false, AFTER_DRAIN = false, HAS_MID = false;
    const float* base_p; const float* base_s; float* X; const float* gate;
    __device__ __forceinline__ void operator()(const f32x4 (&acc)[2][2][4][2], const Unit& u, int wr, int wc, int fr, int fq) const {
        const int row0 = u.pm * BM + wr * 64 + fr, col0 = u.pn * BM + wc * 32 + 4 * fq;
#pragma unroll
        for (int ai = 0; ai < 2; ++ai)
#pragma unroll
            for (int m = 0; m < 4; ++m) { const int row = row0 + ai * HALF + m * 16; const int cb = row < 8192 ? (row >> 11) : 4 + ((row - 8192) >> 3);
                const float* bp = (row < 8192 ? base_p + (size_t)row * 2048 : base_s + (size_t)(row - 8192) * 2048) + col0;
                const float* gp = gate + (size_t)cb * 24576 + col0; float* xo = X + (size_t)row * 2048 + col0;
#pragma unroll
                for (int bj = 0; bj < 2; ++bj)
#pragma unroll
                    for (int n = 0; n < 2; ++n) { const int off = bj * HALF + n * 16; const f32x4 b = *(const f32x4*)(bp + off), g = *(const f32x4*)(gp + off); *(f32x4*)(xo + off) = b + g * acc[ai][bj][m][n]; }
                asm volatile("" ::: "memory"); }
    }
};
struct EpiUp {
    static constexpr bool PERM = true, AFTER_DRAIN = false, HAS_MID = false;
    bf16_t* UP; float* outp; float* outs;
    __device__ __forceinline__ void operator()(const f32x4 (&acc)[2][2][4][2], const Unit& u, int wr, int wc, int fr, int fq) const {
        const int row0 = u.pm * BM + wr * 64 + fr, col0 = u.pn * BM + wc * 32 + 8 * fq;
#pragma unroll
        for (int ai = 0; ai < 2; ++ai)
#pragma unroll
            for (int m = 0; m < 4; ++m) { const int row = row0 + ai * HALF + m * 16; bf16_t* rowp = UP + (size_t)row * 11264 + col0;
                float* fo = nullptr;
                if (row < 8192) { const int t = row & 2047; if (t >= 2046) fo = outp + (size_t)((row >> 11) * 2 + (t - 2046)) * 11264 + col0; }
                else { const int rr = row - 8192, t = rr & 7; if (t >= 6) fo = outs + (size_t)((rr >> 3) * 2 + (t - 6)) * 11264 + col0; }
#pragma unroll
                for (int bj = 0; bj < 2; ++bj) { const f32x4 v0 = acc[ai][bj][m][0], v1 = acc[ai][bj][m][1];
                    u32x4 w; w.x = pkbf(v0[0], v0[1]); w.y = pkbf(v0[2], v0[3]); w.z = pkbf(v1[0], v1[1]); w.w = pkbf(v1[2], v1[3]);
                    *(u32x4*)(rowp + bj * HALF) = w;
                    if (fo) { *(f32x4*)(fo + bj * HALF) = v0; *(f32x4*)(fo + bj * HALF + 4) = v1; } } }
    }
};

template <class Epi, class Sched, bool ALIGN_EPI = false, bool SP2 = false>
__device__ __forceinline__ void gemm_phase(PG8_LAS unsigned char* lds, const Gemm g, const Sched& S, const Epi& E) {
    int tid_ = threadIdx.x; asm volatile("" : "+v"(tid_));
    const int tid = tid_, wid = __builtin_amdgcn_readfirstlane(tid >> 6), lane = tid & 63, wr = wid >> 2, wc = wid & 3, fr = lane & 15, fq = lane >> 4;
    const int K = g.K, nt = K / BK;
    unsigned voffA[2], voffB[2];
#pragma unroll
    for (int i = 0; i < 2; ++i) { int R, C; stage_rc(tid * 16 + i * 8192, R, C); const int Rb = Epi::PERM ? ((R & ~31) + perm32(R & 31)) : R;
        voffA[i] = (unsigned)(R * K + C) * 2u; voffB[i] = (unsigned)(Rb * K + C) * 2u; }
    const size_t kstep = (size_t)(BK * 2);
    const size_t hstep = (size_t)HALF * K * 2;
    const size_t tstep = 2 * hstep;
    const unsigned ldsw = (unsigned)wid * 1024u;
    const int aoff = lds_byte(wr * 64 + fr, fq * 8), boff = lds_byte(wc * 32 + fr, fq * 8);
#define PG8_SA(b, h) (((b) * 2 + (h)) * HTB)
#define PG8_SB(b, h) ((4 + (b) * 2 + (h)) * HTB)
#define PG8_STAGE(bufoff, gbase, voff) do { _Pragma("unroll") for (int _i = 0; _i < 2; ++_i) \
        __builtin_amdgcn_global_load_lds((const unsigned*)((const char*)(gbase) + (voff)[_i]), (PG8_LAS unsigned*)(lds + (bufoff) + ldsw + _i * 8192), 16, 0, 0); } while (0)
#define PG8_LDA(dst, b, h) do { _Pragma("unroll") for (int m = 0; m < 4; ++m) _Pragma("unroll") for (int k = 0; k < 2; ++k) dst[m][k] = *(const PG8_LAS bf16x8*)(lds + PG8_SA(b, h) + aoff + m * 2048 + k * 1024); } while (0)
#define PG8_LDB(dst, b, h) do { _Pragma("unroll") for (int n = 0; n < 2; ++n) _Pragma("unroll") for (int k = 0; k < 2; ++k) dst[n][k] = *(const PG8_LAS bf16x8*)(lds + PG8_SB(b, h) + boff + n * 2048 + k * 1024); } while (0)
#define PG8_MMA(ai, bj, At, Bt) do { __builtin_amdgcn_s_setprio(1); _Pragma("unroll") for (int m = 0; m < 4; ++m) _Pragma("unroll") for (int n = 0; n < 2; ++n) _Pragma("unroll") for (int k = 0; k < 2; ++k) \
        acc[ai][bj][m][n] = __builtin_amdgcn_mfma_f32_16x16x32_bf16(Bt[n][k], At[m][k], acc[ai][bj][m][n], 0, 0, 0); __builtin_amdgcn_s_setprio(0); } while (0)
#define PG8_WAIT_V(n) asm volatile("s_waitcnt vmcnt(" #n ")" ::: "memory")
#define PG8_WAIT_L(n) asm volatile("s_waitcnt lgkmcnt(" #n ")" ::: "memory")
#define PG8_BAR __builtin_amdgcn_s_barrier()
#define PG8_SCHED __builtin_amdgcn_sched_barrier(0)
    Unit cur, nxt; int ui = 0;
    if (!S.next(0, cur)) return;
    f32x4 acc[2][2][4][2];
#pragma unroll
    for (int a = 0; a < 2; ++a)
#pragma unroll
        for (int b = 0; b < 2; ++b)
#pragma unroll
            for (int m = 0; m < 4; ++m)
#pragma unroll
                for (int n = 0; n < 2; ++n) acc[a][b][m][n] = (f32x4){0.f, 0.f, 0.f, 0.f};
    bf16x8 At[4][2], B0[2][2], B1[2][2];
    const char* cA = (const char*)g.A + (size_t)cur.pm * tstep; const char* cB = (const char*)g.Bt + (size_t)cur.pn * tstep;
    S.a_ready(cur);
    if constexpr (SP2) {
        PG8_STAGE(PG8_SB(0, 0), cB, voffB); PG8_STAGE(PG8_SB(0, 1), cB + hstep, voffB); PG8_STAGE(PG8_SA(0, 0), cA, voffA); PG8_STAGE(PG8_SA(0, 1), cA + hstep, voffA);
        if (wr == 1) PG8_BAR;
        PG8_WAIT_V(2); PG8_BAR;
        PG8_STAGE(PG8_SB(1, 0), cB + kstep, voffB); PG8_STAGE(PG8_SA(1, 0), cA + kstep, voffA); PG8_STAGE(PG8_SB(1, 1), cB + hstep + kstep, voffB);
        PG8_WAIT_V(6); PG8_BAR;
    } else {
        PG8_STAGE(PG8_SB(0, 0), cB, voffB); PG8_STAGE(PG8_SA(0, 0), cA, voffA); PG8_STAGE(PG8_SB(0, 1), cB + hstep, voffB); PG8_STAGE(PG8_SA(0, 1), cA + hstep, voffA);
        if (wr == 1) PG8_BAR;
        PG8_WAIT_V(4); PG8_BAR;
        PG8_STAGE(PG8_SB(1, 0), cB + kstep, voffB); PG8_STAGE(PG8_SA(1, 0), cA + kstep, voffA); PG8_STAGE(PG8_SB(1, 1), cB + hstep + kstep, voffB);
        PG8_WAIT_V(6); PG8_BAR;
    }
    for (;;) {
        const bool has_next = S.next(ui + 1, nxt);
        const char* nA = has_next ? (const char*)g.A + (size_t)nxt.pm * tstep : cA; const char* nB = has_next ? (const char*)g.Bt + (size_t)nxt.pn * tstep : cB;
        for (int t = 0; t < nt; t += 2) {
            if constexpr (Epi::HAS_MID) { if (t == E.tmid) E.mid(acc, cur, wr, wc, fr, fq); }
            const bool last = (t == nt - 2);
            const char* a1 = cA + (size_t)(t + 1) * kstep;
            const char* a2 = last ? nA : cA + (size_t)(t + 2) * kstep; const char* b2 = last ? nB : cB + (size_t)(t + 2) * kstep;
            const char* a3 = a2 + kstep; const char* b3 = b2 + kstep;
            if (last && has_next) S.a_ready(nxt);
            if constexpr (SP2) {
            PG8_LDB(B0, 0, 0); PG8_LDB(B1, 0, 1); PG8_SCHED; PG8_LDA(At, 0, 0); PG8_STAGE(PG8_SA(1, 1), a1 + hstep, voffA);
            PG8_WAIT_V(8); PG8_WAIT_L(0); PG8_BAR; PG8_MMA(0, 0, At, B0); PG8_MMA(0, 1, At, B1); PG8_BAR; PG8_SCHED;
            PG8_LDA(At, 0, 1); PG8_STAGE(PG8_SB(0, 0), b2, voffB); PG8_STAGE(PG8_SB(0, 1), b2 + hstep, voffB); PG8_STAGE(PG8_SA(0, 0), a2, voffA);
            PG8_WAIT_V(8); PG8_WAIT_L(0); PG8_BAR; PG8_MMA(1, 0, At, B0); PG8_MMA(1, 1, At, B1); PG8_BAR; PG8_SCHED;
            PG8_LDB(B0, 1, 0); PG8_LDB(B1, 1, 1); PG8_SCHED; PG8_LDA(At, 1, 0); PG8_STAGE(PG8_SA(0, 1), a2 + hstep, voffA);
            PG8_WAIT_V(8); PG8_WAIT_L(0); PG8_BAR; PG8_MMA(0, 0, At, B0); PG8_MMA(0, 1, At, B1); PG8_BAR; PG8_SCHED;
            PG8_LDA(At, 1, 1); PG8_STAGE(PG8_SB(1, 0), b3, voffB); PG8_STAGE(PG8_SB(1, 1), b3 + hstep, voffB); PG8_STAGE(PG8_SA(1, 0), a3, voffA);
            PG8_WAIT_V(8); PG8_WAIT_L(0); PG8_BAR; PG8_MMA(1, 0, At, B0); PG8_MMA(1, 1, At, B1); PG8_BAR; PG8_SCHED;
            } else {
            PG8_LDB(B0, 0, 0); PG8_SCHED; PG8_LDA(At, 0, 0); PG8_STAGE(PG8_SA(1, 1), a1 + hstep, voffA);
            PG8_WAIT_L(8); PG8_BAR; PG8_WAIT_L(0); PG8_MMA(0, 0, At, B0); PG8_BAR; PG8_SCHED;
            PG8_LDB(B1, 0, 1); PG8_STAGE(PG8_SB(0, 0), b2, voffB);
            PG8_BAR; PG8_WAIT_L(0); PG8_MMA(0, 1, At, B1); PG8_BAR;
            PG8_LDA(At, 0, 1); PG8_STAGE(PG8_SA(0, 0), a2, voffA);
            PG8_BAR; PG8_WAIT_L(0); PG8_MMA(1, 0, At, B0); PG8_BAR; PG8_SCHED;
            PG8_STAGE(PG8_SB(0, 1), b2 + hstep, voffB);
            PG8_WAIT_V(6); PG8_BAR; PG8_MMA(1, 1, At, B1); PG8_BAR;
            PG8_LDB(B0, 1, 0); PG8_SCHED; PG8_LDA(At, 1, 0); PG8_STAGE(PG8_SA(0, 1), a2 + hstep, voffA);
            PG8_WAIT_L(8); PG8_BAR; PG8_WAIT_L(0); PG8_MMA(0, 0, At, B0); PG8_BAR; PG8_SCHED;
            PG8_LDB(B1, 1, 1); PG8_STAGE(PG8_SB(1, 0), b3, voffB);
            PG8_BAR; PG8_WAIT_L(0); PG8_MMA(0, 1, At, B1); PG8_BAR;
            PG8_LDA(At, 1, 1); PG8_STAGE(PG8_SA(1, 0), a3, voffA);
            PG8_BAR; PG8_WAIT_L(0); PG8_MMA(1, 0, At, B0); PG8_BAR; PG8_SCHED;
            PG8_STAGE(PG8_SB(1, 1), b3 + hstep, voffB);
            PG8_WAIT_V(6); PG8_BAR; PG8_MMA(1, 1, At, B1); PG8_BAR;
            }
        }
        if constexpr (ALIGN_EPI) { if (wr == 0) PG8_BAR; }
        if constexpr (!Epi::AFTER_DRAIN) { E(acc, cur, wr, wc, fr, fq); S.done(cur); }
        if (!has_next) break;
#pragma unroll
        for (int a = 0; a < 2; ++a)
#pragma unroll
            for (int b = 0; b < 2; ++b)
#pragma unroll
                for (int m = 0; m < 4; ++m)
#pragma unroll
                    for (int n = 0; n < 2; ++n) acc[a][b][m][n] = (f32x4){0.f, 0.f, 0.f, 0.f};
        cur = nxt; cA = nA; cB = nB; ++ui;
        if constexpr (ALIGN_EPI) { if (wr == 1) PG8_BAR; }
    }
    PG8_WAIT_V(0);
    if constexpr (!ALIGN_EPI) { if (wr == 0) PG8_BAR; }
    PG8_BAR;
    if constexpr (Epi::AFTER_DRAIN) { E.fused(acc, cur, wr, wc, fr, fq, lds, wid, lane); S.done(cur); }
#undef PG8_SA
#undef PG8_SB
#undef PG8_STAGE
#undef PG8_LDA
#undef PG8_LDB
#undef PG8_MMA
#undef PG8_WAIT_V
#undef PG8_WAIT_L
#undef PG8_BAR
#undef PG8_SCHED
}
}
#define GAS __attribute__((address_space(1)))
#define LAS __attribute__((address_space(3)))
typedef unsigned short bf16;
typedef unsigned v4u __attribute__((ext_vector_type(4)));
typedef float f32x4 __attribute__((ext_vector_type(4)));
typedef short bf16x8 __attribute__((ext_vector_type(8)));
typedef GAS unsigned gu32;
typedef GAS unsigned long long gu64;
#define RLX_AGENT __ATOMIC_RELAXED, __HIP_MEMORY_SCOPE_AGENT
#define LDS_WAIT() asm volatile("s_waitcnt lgkmcnt(0)" ::: "memory")
#define VM_WAIT() asm volatile("s_waitcnt vmcnt(0)" ::: "memory")
__device__ __forceinline__ unsigned long long rt() { return __builtin_amdgcn_s_memrealtime(); }
__device__ __forceinline__ unsigned f2bf(float f) { unsigned u = __builtin_bit_cast(unsigned, f); return (u + 0x7fffu + ((u >> 16) & 1u)) >> 16; }
__device__ __forceinline__ unsigned pk2(float lo, float hi) { return f2bf(lo) | (f2bf(hi) << 16); }

#define XB_TMO      128
#define XB_XCNT(j)  (256  + 64 * (j))
#define XB_XSUB(j)  (1280 + 64 * (j))
#define XB_XGEN(j)  (2304 + 64 * (j))
#define XB_TOP      3328
#define XB_TOPGEN   3392
#define XCD_BAR_WORDS 3456
#define XB_SPIN_CAP (1u << 18)

__device__ __forceinline__ unsigned xb_ld(unsigned* p)              { return __hip_atomic_load(p, __ATOMIC_RELAXED, __HIP_MEMORY_SCOPE_AGENT); }
__device__ __forceinline__ unsigned xb_add(unsigned* p, unsigned v) { return __hip_atomic_fetch_add(p, v, __ATOMIC_RELAXED, __HIP_MEMORY_SCOPE_AGENT); }
__device__ __forceinline__ unsigned xb_xcc_id() { return (unsigned)__builtin_amdgcn_s_getreg((3 << 11) | 20) & 0xFu; }
#define XB_SPIN(cond, bar) do { unsigned _sp = 0; while (cond) { __builtin_amdgcn_s_sleep(1); \
    if ((++_sp & 255u) == 0u) { if (xb_ld(&(bar)[XB_TMO])) break; if (_sp > XB_SPIN_CAP) { atomicAdd(&(bar)[XB_TMO], 1u); break; } } } } while (0)

struct XcdBarrier {
    unsigned* bar; unsigned x;
    volatile LAS unsigned* st;
};

__device__ __forceinline__ XcdBarrier xcd_barrier_post(unsigned* bar, volatile LAS unsigned* st) {
    XcdBarrier b; b.bar = bar; b.x = xb_xcc_id(); b.st = st;
    if (threadIdx.x == 0) (void)xb_add(&bar[XB_XCNT(b.x)], 1u);
    return b;
}
__device__ __forceinline__ void xcd_barrier_complete(unsigned* bar, unsigned x, unsigned& nloc, unsigned& nx) {
    const unsigned G = gridDim.x * gridDim.y * gridDim.z;
    unsigned sum, cnt, mine, sp = 0u;
    for (;;) {
        sum = 0u; cnt = 0u; mine = 0u;
#pragma unroll
        for (unsigned j = 0; j < 16; ++j) { const unsigned c = xb_ld(&bar[XB_XCNT(j)]); sum += c; cnt += (c > 0u) ? 1u : 0u; mine = (j == x) ? c : mine; }
        if (sum == G) break;
        __builtin_amdgcn_s_sleep(1);
        if ((++sp & 255u) == 0u) { if (xb_ld(&bar[XB_TMO])) break; if (sp > XB_SPIN_CAP) { atomicAdd(&bar[XB_TMO], 1u); break; } }
    }
    nloc = mine > 0u ? mine : 1u; nx = cnt > 0u ? cnt : 1u;
}

__device__ __forceinline__ void xcd_barrier(const XcdBarrier& b) {
    asm volatile("s_waitcnt vmcnt(0)" ::: "memory");
    __syncthreads();
    if (threadIdx.x == 0) {
        unsigned* bar = b.bar;
        __builtin_amdgcn_s_waitcnt(0);
        unsigned nloc = b.st[0], nx = b.st[1];
        if (nloc == 0u) { xcd_barrier_complete(bar, b.x, nloc, nx); b.st[0] = nloc; b.st[1] = nx; }
        const unsigned old = xb_add(&bar[XB_XSUB(b.x)], 1u);
        const unsigned gen = old / nloc;
        if (old + 1u == (gen + 1u) * nloc) {
            __builtin_amdgcn_fence(__ATOMIC_RELEASE, "agent");
            asm volatile("s_waitcnt vmcnt(0)" ::: "memory");
            const unsigned og = xb_add(&bar[XB_TOP], 1u);
            const unsigned tg = og / nx;
            if (og + 1u == (tg + 1u) * nx) xb_add(&bar[XB_TOPGEN], 1u);
            else XB_SPIN(xb_ld(&bar[XB_TOPGEN]) == tg, bar);
            __builtin_amdgcn_fence(__ATOMIC_ACQUIRE, "agent");
            xb_add(&bar[XB_XGEN(b.x)], 1u);
            asm volatile("s_waitcnt vmcnt(0)" ::: "memory");
        } else {
            XB_SPIN(xb_ld(&bar[XB_XGEN(b.x)]) == gen, bar);
            __builtin_amdgcn_fence(__ATOMIC_ACQUIRE, "agent");
            asm volatile("s_waitcnt vmcnt(0)" ::: "memory");
        }
    }
    __syncthreads();
}

constexpr int NWAVES = 8;
constexpr int DM = 2048, MP = 8192, MS = 1024, MT = MP + MS;
constexpr int NIN = 14336, DFF = 5632, NUP = 2 * DFF, NCOND = 132, MODP = 24576;
constexpr int ZU = 0, ZV = 1024, ZQ = 2048, ZF = 4096, ZI = 6144, ZOG = 8192, ZGA = 10240, ZGB = 12288;
constexpr float EPS = 1e-6f, L2E = 1.44269504089f;
constexpr size_t O_YP = 0, O_YS = 16777216, O_HP = 18874368, O_HS = 20971520, O_CP = 88080384, O_CS = 88260608, O_VP = 94027776, O_VS = 95076352, O_END = 97173504;
constexpr size_t MiB = 1u << 20;
constexpr size_t WS_CTL = 0, CTL_ZERO_BYTES = 1 * MiB;
constexpr size_t WS_AC = 1 * MiB;
constexpr size_t WS_MOD = 2 * MiB;
constexpr size_t WS_ADAT = 26 * MiB;
constexpr size_t WS_WIN = 122 * MiB, SZ_WIN = 56 * MiB;
constexpr size_t WS_WBA = 234 * MiB, SZ_WBA = 4 * MiB;
constexpr size_t WS_WBB = 242 * MiB, SZ_WBB = 8 * MiB;
constexpr size_t WS_WOUT = 258 * MiB, SZ_WOUT = 8 * MiB;
constexpr size_t WS_WUP = 274 * MiB, SZ_WUP = 44 * MiB;
constexpr size_t WS_WDN = 362 * MiB, SZ_WDN = 22 * MiB;
constexpr size_t WS_X = 406 * MiB;
constexpr size_t WS_H = 478 * MiB;
constexpr size_t WS_Z = 514 * MiB;
constexpr size_t WS_YA = 766 * MiB;
constexpr size_t WS_O = 784 * MiB;
constexpr size_t WS_Y = 820 * MiB;
constexpr size_t WS_ACT = 856 * MiB;
constexpr size_t WS_END = 955 * MiB;
constexpr int CW_BAR = 4096;
constexpr int RING_OFF = 0, RING_BYTES = 131072;
constexpr int LDSCTL_OFF = RING_BYTES, MISC_OFF = LDSCTL_OFF + 320;
constexpr int LDS_BYTES = 147456;

#define DI __device__ __forceinline__
typedef unsigned v2u __attribute__((ext_vector_type(2)));
using pg8::pkbf; using pg8::bflo; using pg8::bfhi; using pg8::sigm; using pg8::gelu_t;
DI float fexp2(float x) { return __builtin_amdgcn_exp2f(x); }
DI float flog2(float x) { return __builtin_amdgcn_logf(x); }
DI float frcp(float x) { return __builtin_amdgcn_rcpf(x); }
DI float frsq(float x) { return __builtin_amdgcn_rsqf(x); }
DI float wave_sum(float v) {
#pragma unroll
    for (int o = 1; o < 64; o <<= 1) v += __shfl_xor(v, o);
    return v;
}
#define LDS_BARRIER() do { asm volatile("s_waitcnt lgkmcnt(0)" ::: "memory"); __builtin_amdgcn_s_barrier(); asm volatile("" ::: "memory"); } while (0)
#define MFMA16(a, b, c) __builtin_amdgcn_mfma_f32_16x16x32_bf16((a), (b), (c), 0, 0, 0)

struct Args { const float* in[24]; float* out; unsigned char* ws; };
enum { I_XP = 0, I_XS, I_CP, I_CS, I_SH, I_SC, I_ADAW, I_ADAB, I_N1, I_N2, I_WIN, I_VG, I_WS, I_BS, I_WBA, I_LB, I_HNG, I_WBB, I_WOUT, I_WUP, I_CW, I_CB, I_WDN, I_FNG };

DI void p0_transpose_item(const float* W, int N, bf16* WT, int pitch, int col_off, LAS float* scr, int item, int lane) {
    asm volatile("" : "+v"(lane));
    const int nblk = N / 32, kb = item / nblk, nb = item % nblk, k0 = 64 * kb, n0 = 32 * nb;
#pragma unroll 8
    for (int i = 0; i < 32; ++i) { const int kk = 2 * i + (lane >> 5); scr[kk * 33 + (lane & 31)] = W[(size_t)(k0 + kk) * N + n0 + (lane & 31)]; }
    LDS_WAIT(); asm volatile("" ::: "memory");
    const int c = lane & 7;
#pragma unroll
    for (int j = 0; j < 4; ++j) { const int n = (lane >> 3) + 8 * j; const LAS float* s = scr + (8 * c) * 33 + n;
        v4u o; o.x = pkbf(s[0 * 33], s[1 * 33]); o.y = pkbf(s[2 * 33], s[3 * 33]); o.z = pkbf(s[4 * 33], s[5 * 33]); o.w = pkbf(s[6 * 33], s[7 * 33]);
        *(GAS v4u*)(WT + (size_t)(n0 + n) * pitch + col_off + k0 + 8 * c) = o; }
    LDS_WAIT(); asm volatile("" ::: "memory");
}

template <bool FINAL>
DI void norm_rows(const float* xp, const float* xs, const float* g, const float* modsh  , bf16* H, float* out, int gw, int NGW, int lane) {
    asm volatile("" : "+v"(lane), "+s"(gw));
    for (int row = gw; row < MT; row += NGW) {
        const GAS f32x4* xr = (const GAS f32x4*)(row < MP ? xp + (size_t)row * DM : xs + (size_t)(row - MP) * DM) + lane;
        f32x4 v[8]; float ss = 0.f;
#pragma unroll
        for (int j = 0; j < 8; ++j) { v[j] = xr[64 * j]; ss += (v[j].x * v[j].x + v[j].y * v[j].y) + (v[j].z * v[j].z + v[j].w * v[j].w); }
        const float rstd = frsq(wave_sum(ss) * (1.f / DM) + EPS);
        if (FINAL) {
            GAS f32x4* o = (GAS f32x4*)(out + (size_t)row * DM) + lane;
#pragma unroll
            for (int j = 0; j < 8; ++j) { const f32x4 gg = ((const GAS f32x4*)g)[lane + 64 * j]; o[64 * j] = v[j] * rstd * gg; }
        } else {
            const int cb = row < MP ? (row >> 11) : 4 + ((row - MP) >> 3);
            const GAS f32x4* sh = (const GAS f32x4*)(modsh + (size_t)cb * MODP) + lane; const GAS f32x4* sc = sh + DM / 4;
            GAS v2u* o = (GAS v2u*)(H + (size_t)row * DM) + lane;
#pragma unroll
            for (int j = 0; j < 8; ++j) { const f32x4 gg = ((const GAS f32x4*)g)[lane + 64 * j], s1 = sc[64 * j], s0 = sh[64 * j];
                const f32x4 h = v[j] * rstd * gg * (s1 + 1.f) + s0; v2u w; w.x = pkbf(h.x, h.y); w.y = pkbf(h.z, h.w); o[64 * j] = w; }
        }
    }
}

constexpr int HP = 272, HPK = 144;
constexpr int HG_QT = 0, HG_QE = 64 * HP, HG_KT = 2 * 64 * HP, HG_KDT = 3 * 64 * HP, HG_IVT = HG_KDT + 128 * HPK, HG_P = HG_IVT + 128 * HPK, HG_TOT = HG_P + 64 * HPK, HG_DEC = HG_TOT + 8192, HG_PART = HG_DEC + 512, HG_END = HG_PART + 2048;
static_assert(HG_END <= RING_BYTES, "hgrn lds");
template <int TT>
DI void hgrn_unit(LAS unsigned char* lds, int tid, int wave, int lane, const bf16* Z, bf16* OB, const float* s_in, float* s_out,
                  const float* ogain  , const float* lbp  , int l, int h, int row0, int nblk) {
    constexpr int C = TT * 16;
    constexpr int CS = (TT == 4) ? 64 : 32;
    constexpr int NG = CS / 4;
    asm volatile("" : "+v"(tid), "+v"(lane), "+s"(wave));
    const int kq = tid & 31, tg = tid >> 5, k0 = 4 * kq, i = lane & 15, q = lane >> 4;
    const bool act = tg < NG;
    const bool valid = (TT == 4) ? true : (tg < 2);
    float lb[4], oml[4];
#pragma unroll
    for (int c = 0; c < 4; ++c) { lb[c] = (l == 0) ? 0.f : sigm(lbp[2048 + h * 128 + k0 + c] - lbp[h * 128 + k0 + c]); oml[c] = 1.f - lb[c]; }
    f32x4 S[8];
#pragma unroll
    for (int a = 0; a < 8; ++a)
#pragma unroll
        for (int r = 0; r < 4; ++r) S[a][r] = s_in ? s_in[(size_t)(16 * a + 4 * q + r) * 128 + 16 * wave + i] : 0.f;
    const f32x4 og4 = *(const f32x4*)(ogain + 16 * wave + 4 * q);
    for (int blk = 0; blk < nblk; ++blk) {
        const int rowb = row0 + blk * C;
        v2u qw[4], fw[4], iw[4];
#pragma unroll
        for (int j = 0; j < 4; ++j) {
            if (valid) { const bf16* zr = Z + (size_t)(rowb + 4 * tg + j) * NIN + h * 128 + k0;
                qw[j] = *(const v2u*)(zr + ZQ); fw[j] = *(const v2u*)(zr + ZF); iw[j] = *(const v2u*)(zr + ZI); }
            else { qw[j] = (v2u){0u, 0u}; fw[j] = (v2u){0u, 0u}; iw[j] = (v2u){0u, 0u}; }
        }
        float lf[4][4], kk[4][4];
#pragma unroll
        for (int j = 0; j < 4; ++j)
#pragma unroll
            for (int c = 0; c < 4; ++c) {
                const unsigned w = (c < 2) ? fw[j].x : fw[j].y; const float fr = (c & 1) ? bfhi(w) : bflo(w);
                const float e = fexp2(fminf(-L2E * fr, 60.f)), r = frcp(1.f + e);
                const float f = (1.f + lb[c] * e) * r;
                kk[j][c] = valid ? oml[c] * e * r : 0.f;
                lf[j][c] = valid ? flog2(f) : 0.f;
            }
#pragma unroll
        for (int j = 1; j < 4; ++j)
#pragma unroll
            for (int c = 0; c < 4; ++c) lf[j][c] += lf[j - 1][c];
        if (act) *(LAS f32x4*)(lds + HG_TOT + (tg * 128 + k0) * 4) = (f32x4){lf[3][0], lf[3][1], lf[3][2], lf[3][3]};
        LDS_BARRIER();
        if (act) {
            f32x4 before = {0.f, 0.f, 0.f, 0.f}, aref = before, al = before;
#pragma unroll
            for (int g = 0; g < NG; ++g) { const f32x4 t4 = *(const LAS f32x4*)(lds + HG_TOT + (g * 128 + k0) * 4);
                if (g < tg) before += t4; if (g < NG / 2) aref += t4; al += t4; }
            float kd[4][4];
#pragma unroll
            for (int j = 0; j < 4; ++j) {
                float qt[4], qe[4], kt[4];
#pragma unroll
                for (int c = 0; c < 4; ++c) {
                    const unsigned w = (c < 2) ? qw[j].x : qw[j].y; const float qv = (c & 1) ? bfhi(w) : bflo(w);
                    const float A = before[c] + lf[j][c];
                    qt[c] = qv * fexp2(fminf(A - aref[c], 100.f)); qe[c] = qv * fexp2(A);
                    kt[c] = kk[j][c] * fexp2(fminf(aref[c] - A, 100.f)); kd[j][c] = kk[j][c] * fexp2(al[c] - A);
                }
                const int ro = (4 * tg + j) * HP + k0 * 2;
                *(LAS v2u*)(lds + HG_QT + ro) = (v2u){pkbf(qt[0], qt[1]), pkbf(qt[2], qt[3])};
                *(LAS v2u*)(lds + HG_QE + ro) = (v2u){pkbf(qe[0], qe[1]), pkbf(qe[2], qe[3])};
                *(LAS v2u*)(lds + HG_KT + ro) = (v2u){pkbf(kt[0], kt[1]), pkbf(kt[2], kt[3])};
            }
#pragma unroll
            for (int c = 0; c < 4; ++c) {
                *(LAS v2u*)(lds + HG_KDT + (k0 + c) * HPK + 8 * tg) = (v2u){pkbf(kd[0][c], kd[1][c]), pkbf(kd[2][c], kd[3][c])};
                unsigned e0, e1, e2, e3;
                if (c == 0) { e0 = iw[0].x & 0xffffu; e1 = iw[1].x & 0xffffu; e2 = iw[2].x & 0xffffu; e3 = iw[3].x & 0xffffu; }
                else if (c == 1) { e0 = iw[0].x >> 16; e1 = iw[1].x >> 16; e2 = iw[2].x >> 16; e3 = iw[3].x >> 16; }
                else if (c == 2) { e0 = iw[0].y & 0xffffu; e1 = iw[1].y & 0xffffu; e2 = iw[2].y & 0xffffu; e3 = iw[3].y & 0xffffu; }
                else { e0 = iw[0].y >> 16; e1 = iw[1].y >> 16; e2 = iw[2].y >> 16; e3 = iw[3].y >> 16; }
                *(LAS v2u*)(lds + HG_IVT + (k0 + c) * HPK + 8 * tg) = (v2u){e0 | (e1 << 16), e2 | (e3 << 16)};
            }
            if (tg == 0) *(LAS f32x4*)(lds + HG_DEC + k0 * 4) = (f32x4){fexp2(al[0]), fexp2(al[1]), fexp2(al[2]), fexp2(al[3])};
        }
        LDS_BARRIER();
        v2u ogw[TT];
#pragma unroll
        for (int it = 0; it < TT; ++it) ogw[it] = (TT == 4 || i < 8) ? *(const v2u*)(Z + (size_t)(rowb + 16 * it + i) * NIN + ZOG + h * 128 + 16 * wave + 4 * q) : (v2u){0u, 0u};
        if (TT == 4 || wave == 0) {
            const int it = (TT == 4) ? (wave >> 1) : 0;
#pragma unroll
            for (int is2 = 0; is2 < 2; ++is2) { const int is = ((TT == 4) ? 2 * (wave & 1) : 0) + is2;
                f32x4 sc = {0.f, 0.f, 0.f, 0.f};
#pragma unroll
                for (int ks = 0; ks < 4; ++ks) { const bf16x8 X = *(const LAS bf16x8*)(lds + HG_KT + (16 * is + i) * HP + (32 * ks + 8 * q) * 2), Y = *(const LAS bf16x8*)(lds + HG_QT + (16 * it + i) * HP + (32 * ks + 8 * q) * 2);
                    sc = MFMA16(X, Y, sc); }
                const int t = 16 * it + i, s0 = 16 * is + 4 * q;
                *(LAS v2u*)(lds + HG_P + t * HPK + s0 * 2) = (v2u){pkbf(s0 <= t ? sc[0] : 0.f, s0 + 1 <= t ? sc[1] : 0.f), pkbf(s0 + 2 <= t ? sc[2] : 0.f, s0 + 3 <= t ? sc[3] : 0.f)};
            }
        }
        f32x4 o[TT];
        {
            bf16x8 Sf[4];
#pragma unroll
            for (int ks = 0; ks < 4; ++ks) { v4u p; p.x = pkbf(S[2 * ks][0], S[2 * ks][1]); p.y = pkbf(S[2 * ks][2], S[2 * ks][3]); p.z = pkbf(S[2 * ks + 1][0], S[2 * ks + 1][1]); p.w = pkbf(S[2 * ks + 1][2], S[2 * ks + 1][3]); Sf[ks] = __builtin_bit_cast(bf16x8, p); }
#pragma unroll
            for (int it = 0; it < TT; ++it) { o[it] = (f32x4){0.f, 0.f, 0.f, 0.f};
#pragma unroll
                for (int ks = 0; ks < 4; ++ks) { const v2u lo = *(const LAS v2u*)(lds + HG_QE + (16 * it + i) * HP + (32 * ks + 4 * q) * 2), hi = *(const LAS v2u*)(lds + HG_QE + (16 * it + i) * HP + (32 * ks + 16 + 4 * q) * 2);
                    const v4u y = {lo.x, lo.y, hi.x, hi.y}; o[it] = MFMA16(Sf[ks], __builtin_bit_cast(bf16x8, y), o[it]); } }
        }
        bf16x8 IVf[CS / 32];
#pragma unroll
        for (int ss = 0; ss < CS / 32; ++ss) IVf[ss] = *(const LAS bf16x8*)(lds + HG_IVT + (16 * wave + i) * HPK + (32 * ss + 8 * q) * 2);
        LDS_BARRIER();
#pragma unroll
        for (int it = 0; it < TT; ++it)
#pragma unroll
            for (int ss = 0; ss < CS / 32; ++ss) if (TT != 4 || ss <= (it >> 1)) { const bf16x8 Y = *(const LAS bf16x8*)(lds + HG_P + (16 * it + i) * HPK + (32 * ss + 8 * q) * 2); o[it] = MFMA16(IVf[ss], Y, o[it]); }
#pragma unroll
        for (int a = 0; a < 8; ++a) { const f32x4 d = *(const LAS f32x4*)(lds + HG_DEC + (16 * a + 4 * q) * 4); S[a] *= d;
#pragma unroll
            for (int ss = 0; ss < CS / 32; ++ss) { const bf16x8 X = *(const LAS bf16x8*)(lds + HG_KDT + (16 * a + i) * HPK + (32 * ss + 8 * q) * 2); S[a] = MFMA16(X, IVf[ss], S[a]); } }
#pragma unroll
        for (int it = 0; it < TT; ++it) { float p = (o[it][0] * o[it][0] + o[it][1] * o[it][1]) + (o[it][2] * o[it][2] + o[it][3] * o[it][3]); p += __shfl_xor(p, 16); p += __shfl_xor(p, 32);
            if (q == 0) *(LAS float*)(lds + HG_PART + (wave * 64 + 16 * it + i) * 4) = p; }
        LDS_BARRIER();
#pragma unroll
        for (int it = 0; it < TT; ++it) { float tot = 0.f;
#pragma unroll
            for (int w = 0; w < 8; ++w) tot += *(const LAS float*)(lds + HG_PART + (w * 64 + 16 * it + i) * 4);
            const float rstd = frsq(tot * (1.f / 128.f) + EPS);
            if (TT == 4 || i < 8) { const v2u g = ogw[it];
                const float r0 = o[it][0] * rstd * og4[0] * bflo(g.x), r1 = o[it][1] * rstd * og4[1] * bfhi(g.x), r2 = o[it][2] * rstd * og4[2] * bflo(g.y), r3 = o[it][3] * rstd * og4[3] * bfhi(g.y);
                *(v2u*)(OB + (size_t)(rowb + 16 * it + i) * 2048 + h * 128 + 16 * wave + 4 * q) = (v2u){pkbf(r0, r1), pkbf(r2, r3)}; } }
    }
#pragma unroll
    for (int a = 0; a < 8; ++a)
#pragma unroll
        for (int r = 0; r < 4; ++r) s_out[(size_t)(16 * a + 4 * q + r) * 128 + 16 * wave + i] = S[a][r];
    LDS_BARRIER();
}

constexpr int MX_VNT = 0, MX_W = 128 * HP, MX_END = 2 * 128 * HP;
static_assert(MX_END <= RING_BYTES, "mixer lds");
DI void mixer_unit(LAS unsigned char* lds, int tid, int wave, int lane, int tt, int g, const bf16* Z, bf16* YA, const float* wsp  , const float* bsp  , const float* vgp  , float* vout  ) {
    asm volatile("" : "+v"(tid), "+v"(lane), "+s"(wave));
    const int r0 = tt * 128; const bool sample = tt >= 64;
    {
        const int cq = tid & 31, sg = tid >> 5, c0 = 4 * cq;
        const f32x4 vg4 = *(const f32x4*)(vgp + c0);
        float vn[8][4];
#pragma unroll
        for (int j = 0; j < 8; ++j) { const int s = 8 * sg + j; const v2u w = *(const v2u*)(Z + (size_t)(r0 + s) * NIN + ZV + g * 128 + c0);
            const float x0 = bflo(w.x), x1 = bfhi(w.x), x2 = bflo(w.y), x3 = bfhi(w.y);
            float ss = (x0 * x0 + x1 * x1) + (x2 * x2 + x3 * x3);
            ss += __shfl_xor(ss, 1); ss += __shfl_xor(ss, 2); ss += __shfl_xor(ss, 4); ss += __shfl_xor(ss, 8); ss += __shfl_xor(ss, 16);
            const float rstd = frsq(ss * (1.f / 128.f) + EPS);
            vn[j][0] = x0 * rstd * vg4[0]; vn[j][1] = x1 * rstd * vg4[1]; vn[j][2] = x2 * rstd * vg4[2]; vn[j][3] = x3 * rstd * vg4[3];
            if (vout) *(f32x4*)(vout + (size_t)s * 1024 + c0) = (f32x4){vn[j][0], vn[j][1], vn[j][2], vn[j][3]}; }
#pragma unroll
        for (int c = 0; c < 4; ++c) { v4u p; p.x = pkbf(vn[0][c], vn[1][c]); p.y = pkbf(vn[2][c], vn[3][c]); p.z = pkbf(vn[4][c], vn[5][c]); p.w = pkbf(vn[6][c], vn[7][c]);
            *(LAS v4u*)(lds + MX_VNT + (c0 + c) * HP + 16 * sg) = p; }
    }
    {
        const int t = tid >> 2, sq = tid & 3;
#pragma unroll
        for (int jj = 0; jj < 4; ++jj) { const int s0 = sq * 32 + 8 * jj; float x[8];
            if (!sample) { const f32x4 a = *(const f32x4*)(wsp + t * 128 + s0), b = *(const f32x4*)(wsp + t * 128 + s0 + 4);
                x[0] = a[0]; x[1] = a[1]; x[2] = a[2]; x[3] = a[3]; x[4] = b[0]; x[5] = b[1]; x[6] = b[2]; x[7] = b[3];
#pragma unroll
                for (int e = 0; e < 8; ++e) x[e] = (s0 + e <= t) ? x[e] : 0.f; }
            else {
#pragma unroll
                for (int e = 0; e < 8; ++e) { const int s = s0 + e; x[e] = ((s >> 3) == (t >> 3) && (s & 7) <= (t & 7)) ? wsp[(t & 7) * 128 + (s & 7)] : 0.f; } }
            v4u p; p.x = pkbf(x[0], x[1]); p.y = pkbf(x[2], x[3]); p.z = pkbf(x[4], x[5]); p.w = pkbf(x[6], x[7]);
            *(LAS v4u*)(lds + MX_W + t * HP + s0 * 2) = p; }
    }
    LDS_BARRIER();
    const int i = lane & 15, q = lane >> 4;
    f32x4 acc[8];
#pragma unroll
    for (int ct = 0; ct < 8; ++ct) acc[ct] = (f32x4){0.f, 0.f, 0.f, 0.f};
    const int nks = (wave >> 1) + 1;
    for (int ks = 0; ks < nks; ++ks) { const bf16x8 Y = *(const LAS bf16x8*)(lds + MX_W + (16 * wave + i) * HP + (32 * ks + 8 * q) * 2);
#pragma unroll
        for (int ct = 0; ct < 8; ++ct) { const bf16x8 X = *(const LAS bf16x8*)(lds + MX_VNT + (16 * ct + i) * HP + (32 * ks + 8 * q) * 2); acc[ct] = MFMA16(X, Y, acc[ct]); } }
    const int t = 16 * wave + i; const float bias = bsp[sample ? (t & 7) : t];
#pragma unroll
    for (int ct = 0; ct < 8; ++ct) { const int c = g * 128 + 16 * ct + 4 * q; const v2u uw = *(const v2u*)(Z + (size_t)(r0 + t) * NIN + ZU + c);
        const float y0 = bflo(uw.x) * (acc[ct][0] + bias), y1 = bfhi(uw.x) * (acc[ct][1] + bias), y2 = bflo(uw.y) * (acc[ct][2] + bias), y3 = bfhi(uw.y) * (acc[ct][3] + bias);
        *(v2u*)(YA + (size_t)(r0 + t) * 1024 + c) = (v2u){pkbf(y0, y1), pkbf(y2, y3)}; }
    LDS_BARRIER();
}

__global__ void __launch_bounds__(NWAVES * 64, 2) mk_fwd(Args args) {
    extern __shared__ __attribute__((aligned(16))) unsigned char lds_raw[];
    LAS unsigned char* lds = (LAS unsigned char*)lds_raw;
    volatile LAS unsigned* MISC = (volatile LAS unsigned*)(lds + MISC_OFF);
    const int tid = threadIdx.x, lane = tid & 63, wave = __builtin_amdgcn_readfirstlane(tid >> 6);
    const int G = gridDim.x, bx = blockIdx.x;
    const int vcu = (G % 8 == 0) ? (bx % 8) * (G / 8) + bx / 8 : bx;
    const int gw = vcu * NWAVES + wave, NGW = G * NWAVES;
    unsigned char* ws = args.ws;
    gu32* ctl = (gu32*)(ws + WS_CTL);
    for (int u = tid; u < (LDS_BYTES - LDSCTL_OFF) / 4; u += NWAVES * 64) ((LAS unsigned*)(lds + LDSCTL_OFF))[u] = 0u;
    __syncthreads();
    XcdBarrier bar = xcd_barrier_post((unsigned*)(ctl + CW_BAR), MISC + 8);
#define GRID_BAR() xcd_barrier(bar)

    bf16* AC = (bf16*)(ws + WS_AC); float* MOD = (float*)(ws + WS_MOD); bf16* ADAT = (bf16*)(ws + WS_ADAT);
    float* X = (float*)(ws + WS_X); bf16* H = (bf16*)(ws + WS_H); bf16* Z = (bf16*)(ws + WS_Z); bf16* UP = Z;
    bf16* YA = (bf16*)(ws + WS_YA); bf16* OB = (bf16*)(ws + WS_O); bf16* Y = (bf16*)(ws + WS_Y); bf16* ACT = (bf16*)(ws + WS_ACT);
    float* out = args.out;

    {
        LAS float* scr = (LAS float*)(lds + RING_OFF + wave * 16384);
        constexpr int IT_ADA = 32 * 384, IT_IN = 32 * 448, IT_BA = 16 * 64, IT_BB = 32 * 64, IT_OUT = 32 * 64, IT_UP = 32 * 352, IT_DN = 88 * 64;
        constexpr int IT_L = IT_ADA + IT_IN + IT_BA + IT_BB + IT_OUT + IT_UP + IT_DN;
        for (int it = gw; it < 2 * IT_L; it += NGW) {
            const int l = it / IT_L; int r = it - l * IT_L;
            if (r < IT_ADA) { p0_transpose_item(args.in[I_ADAW] + (size_t)l * 2048 * 12288, 12288, ADAT + (size_t)l * 12288 * 2048, 2048, 0, scr, r, lane); continue; } r -= IT_ADA;
            if (r < IT_IN) { p0_transpose_item(args.in[I_WIN] + (size_t)l * 2048 * NIN, NIN, (bf16*)(ws + WS_WIN + l * SZ_WIN), 2048, 0, scr, r, lane); continue; } r -= IT_IN;
            if (r < IT_BA) { p0_transpose_item(args.in[I_WBA] + (size_t)l * 1024 * 2048, 2048, (bf16*)(ws + WS_WBA + l * SZ_WBA), 1024, 0, scr, r, lane); continue; } r -= IT_BA;
            if (r < IT_BB) { p0_transpose_item(args.in[I_WBB] + (size_t)l * 2048 * 2048, 2048, (bf16*)(ws + WS_WBB + l * SZ_WBB), 2048, 0, scr, r, lane); continue; } r -= IT_BB;
            if (r < IT_OUT) { p0_transpose_item(args.in[I_WOUT] + (size_t)l * 2048 * 2048, 2048, (bf16*)(ws + WS_WOUT + l * SZ_WOUT), 2048, 0, scr, r, lane); continue; } r -= IT_OUT;
            if (r < IT_UP) { p0_transpose_item(args.in[I_WUP] + (size_t)l * 2048 * NUP, NUP, (bf16*)(ws + WS_WUP + l * SZ_WUP), 2048, 0, scr, r, lane); continue; } r -= IT_UP;
            p0_transpose_item(args.in[I_WDN] + (size_t)l * DFF * 2048, 2048, (bf16*)(ws + WS_WDN + l * SZ_WDN), DFF, 0, scr, r, lane);
        }
        for (int e = bx * (NWAVES * 64) + tid; e < 256 * (DM / 4); e += G * NWAVES * 64) { const int row = e / (DM / 4), c4 = e % (DM / 4);
            f32x4 v = {0.f, 0.f, 0.f, 0.f};
            if (row < 4) v = *(const f32x4*)(args.in[I_CP] + (size_t)row * DM + 4 * c4); else if (row < NCOND) v = *(const f32x4*)(args.in[I_CS] + (size_t)(row - 4) * DM + 4 * c4);
            v2u w; w.x = pkbf(v.x * sigm(v.x), v.y * sigm(v.y)); w.y = pkbf(v.z * sigm(v.z), v.w * sigm(v.w));
            *(v2u*)(AC + (size_t)row * DM + 4 * c4) = w; }
    }
    GRID_BAR();
    {
        pg8::Gemm g{AC, ADAT, 256, MODP, DM}; pg8::StaticOrder S; S.init(256, MODP, G, bx);
        pg8::EpiF32 E{MOD, MODP, args.in[I_ADAB]};
        pg8::gemm_phase<pg8::EpiF32, pg8::StaticOrder, true, true>(lds + RING_OFF, g, S, E);
    }
    GRID_BAR();

    for (int l = 0; l < 2; ++l) {
        const float* modl = MOD + (size_t)l * 12288;
        const float* xin_p = (l == 0) ? args.in[I_XP] : X; const float* xin_s = (l == 0) ? args.in[I_XS] : X + (size_t)MP * DM;
        norm_rows<false>(xin_p, xin_s, args.in[I_N1] + l * DM, modl, H, nullptr, gw, NGW, lane);
        GRID_BAR();
        {
            pg8::Gemm g{H, (const bf16*)(ws + WS_WIN + l * SZ_WIN), MT, NIN, DM}; pg8::StaticOrder S; S.init(MT, NIN, G, bx);
            pg8::EpiZ E{Z, NIN};
            pg8::gemm_phase<pg8::EpiZ, pg8::StaticOrder, true, true>(lds + RING_OFF, g, S, E);
        }
        GRID_BAR();
        {
            const float* hng = args.in[I_HNG] + l * 2048; const float* lbp = args.in[I_LB];
            for (int pu = bx; pu < 64; pu += G) { const int b = pu >> 4, h = pu & 15;
                hgrn_unit<4>(lds, tid, wave, lane, Z, OB, nullptr, out + O_HP + ((size_t)(l * 4 + b) * 16 + h) * 16384, hng + h * 128, lbp, l, h, b * 2048, 32); }
            const int nb = (G > 64) ? G - 64 : G, jb = (G > 64) ? bx - 64 : bx;
            if (jb >= 0) {
                for (int su = jb; su < 2048; su += nb) { const int b = su >> 4, h = su & 15; const size_t so = ((size_t)(l * 128 + b) * 16 + h) * 16384;
                    hgrn_unit<1>(lds, tid, wave, lane, Z, OB, args.in[I_SH] + so, out + O_HS + so, hng + h * 128, lbp, l, h, MP + b * 8, 1); }
                for (int mu = jb; mu < 576; mu += nb) { const int tt = mu % 72, g = mu / 72;
                    float* vout = nullptr;
                    if (tt >= 64) vout = out + O_VS + ((size_t)l * 1024 + (size_t)(tt - 64) * 128) * 1024 + g * 128;
                    else if ((tt & 15) == 15) vout = out + O_VP + ((size_t)(l * 4 + (tt >> 4)) * 128) * 1024 + g * 128;
                    mixer_unit(lds, tid, wave, lane, tt, g, Z, YA, args.in[I_WS] + (size_t)(l * 8 + g) * 16384, args.in[I_BS] + (l * 8 + g) * 128, args.in[I_VG] + l * 1024 + g * 128, vout); }
            }
        }
        GRID_BAR();
        {
            pg8::StaticOrder S; S.init(MT, DM, G, bx);
            { pg8::Gemm g{YA, (const bf16*)(ws + WS_WBA + l * SZ_WBA), MT, DM, 1024}; pg8::EpiBranch<false> E{Z + ZGA, Y};
              pg8::gemm_phase<pg8::EpiBranch<false>, pg8::StaticOrder, true, true>(lds + RING_OFF, g, S, E); }
            { pg8::Gemm g{OB, (const bf16*)(ws + WS_WBB + l * SZ_WBB), MT, DM, 2048}; pg8::EpiBranch<true> E{Z + ZGB, Y};
              pg8::gemm_phase<pg8::EpiBranch<true>, pg8::StaticOrder, true, true>(lds + RING_OFF, g, S, E); }
        }
        GRID_BAR();
        {
            pg8::Gemm g{Y, (const bf16*)(ws + WS_WOUT + l * SZ_WOUT), MT, DM, DM}; pg8::StaticOrder S; S.init(MT, DM, G, bx);
            pg8::EpiResid E{xin_p, xin_s, X, modl + 2 * DM};
            pg8::gemm_phase<pg8::EpiResid, pg8::StaticOrder, true, true>(lds + RING_OFF, g, S, E);
        }
        GRID_BAR();
        norm_rows<false>(X, X + (size_t)MP * DM, args.in[I_N2] + l * DM, modl + 3 * DM, H, nullptr, gw, NGW, lane);
        GRID_BAR();
        {
            pg8::Gemm g{H, (const bf16*)(ws + WS_WUP + l * SZ_WUP), MT, NUP, DM}; pg8::StaticOrder S; S.init(MT, NUP, G, bx);
            pg8::EpiUp E{UP, out + O_CP + (size_t)l * 4 * 2 * NUP, out + O_CS + (size_t)l * 128 * 2 * NUP};
            pg8::gemm_phase<pg8::EpiUp, pg8::StaticOrder, true, true>(lds + RING_OFF, g, S, E);
        }
        GRID_BAR();
        {
            const float* cw = args.in[I_CW] + (size_t)l * 3 * NUP; const float* cbias = args.in[I_CB] + (size_t)l * NUP; const float* cst = args.in[I_SC] + (size_t)l * 128 * 2 * NUP;
            constexpr int NCG = DFF / 8, NRG = MT / 8;
            for (int item = bx * (NWAVES * 64) + tid; item < NCG * NRG; item += G * NWAVES * 64) {
                int item_ = item; asm volatile("" : "+v"(item_));
                const int rg = item_ / NCG, cg = item_ - rg * NCG, r0 = rg * 8, col = cg * 8;
                float wa[3][8], wb[3][8], ba[8], bb[8];
#pragma unroll
                for (int k = 0; k < 3; ++k) { const f32x4 a0 = *(const f32x4*)(cw + k * NUP + col), a1 = *(const f32x4*)(cw + k * NUP + col + 4), b0 = *(const f32x4*)(cw + k * NUP + DFF + col), b1 = *(const f32x4*)(cw + k * NUP + DFF + col + 4);
#pragma unroll
                    for (int e = 0; e < 4; ++e) { wa[k][e] = a0[e]; wa[k][4 + e] = a1[e]; wb[k][e] = b0[e]; wb[k][4 + e] = b1[e]; } }
                { const f32x4 a0 = *(const f32x4*)(cbias + col), a1 = *(const f32x4*)(cbias + col + 4), b0 = *(const f32x4*)(cbias + DFF + col), b1 = *(const f32x4*)(cbias + DFF + col + 4);
#pragma unroll
                  for (int e = 0; e < 4; ++e) { ba[e] = a0[e]; ba[4 + e] = a1[e]; bb[e] = b0[e]; bb[4 + e] = b1[e]; } }
                float pa2[8], pa1[8], pb2[8], pb1[8];
                if (r0 >= MP) { const float* s0 = cst + (size_t)((r0 - MP) >> 3) * 2 * NUP + col;
#pragma unroll
                    for (int e = 0; e < 8; ++e) { pa2[e] = s0[e]; pa1[e] = s0[NUP + e]; pb2[e] = s0[DFF + e]; pb1[e] = s0[NUP + DFF + e]; } }
                else if ((r0 & 2047) == 0) {
#pragma unroll
                    for (int e = 0; e < 8; ++e) { pa2[e] = 0.f; pa1[e] = 0.f; pb2[e] = 0.f; pb1[e] = 0.f; } }
                else { const v4u a2 = *(const v4u*)(UP + (size_t)(r0 - 2) * NUP + col), a1 = *(const v4u*)(UP + (size_t)(r0 - 1) * NUP + col), b2 = *(const v4u*)(UP + (size_t)(r0 - 2) * NUP + DFF + col), b1 = *(const v4u*)(UP + (size_t)(r0 - 1) * NUP + DFF + col);
#pragma unroll
                    for (int e = 0; e < 4; ++e) { pa2[2 * e] = bflo(a2[e]); pa2[2 * e + 1] = bfhi(a2[e]); pa1[2 * e] = bflo(a1[e]); pa1[2 * e + 1] = bfhi(a1[e]);
                        pb2[2 * e] = bflo(b2[e]); pb2[2 * e + 1] = bfhi(b2[e]); pb1[2 * e] = bflo(b1[e]); pb1[2 * e + 1] = bfhi(b1[e]); } }
#pragma unroll
                for (int j = 0; j < 8; ++j) { const v4u av = *(const v4u*)(UP + (size_t)(r0 + j) * NUP + col), bv = *(const v4u*)(UP + (size_t)(r0 + j) * NUP + DFF + col);
                    float ca[8], cb2[8], res[8];
#pragma unroll
                    for (int e = 0; e < 4; ++e) { ca[2 * e] = bflo(av[e]); ca[2 * e + 1] = bfhi(av[e]); cb2[2 * e] = bflo(bv[e]); cb2[2 * e + 1] = bfhi(bv[e]); }
#pragma unroll
                    for (int e = 0; e < 8; ++e) { const float a = ba[e] + wa[0][e] * pa2[e] + wa[1][e] * pa1[e] + wa[2][e] * ca[e]; const float b = bb[e] + wb[0][e] * pb2[e] + wb[1][e] * pb1[e] + wb[2][e] * cb2[e];
                        res[e] = gelu_t(a) * b; pa2[e] = pa1[e]; pa1[e] = ca[e]; pb2[e] = pb1[e]; pb1[e] = cb2[e]; }
                    v4u w; w.x = pkbf(res[0], res[1]); w.y = pkbf(res[2], res[3]); w.z = pkbf(res[4], res[5]); w.w = pkbf(res[6], res[7]);
                    *(v4u*)(ACT + (size_t)(r0 + j) * DFF + col) = w; }
            }
        }
        GRID_BAR();
        {
            pg8::Gemm g{ACT, (const bf16*)(ws + WS_WDN + l * SZ_WDN), MT, DM, DFF}; pg8::StaticOrder S; S.init(MT, DM, G, bx);
            pg8::EpiResid E{X, X + (size_t)MP * DM, X, modl + 5 * DM};
            pg8::gemm_phase<pg8::EpiResid, pg8::StaticOrder, true, true>(lds + RING_OFF, g, S, E);
        }
        GRID_BAR();
    }
    norm_rows<true>(X, X + (size_t)MP * DM, args.in[I_FNG], nullptr, nullptr, out, gw, NGW, lane);
}

extern "C" void kernel_launch(void* const* d_in, const int* in_sizes, int n_in, void* d_out, int out_size, void* d_ws, size_t ws_size, hipStream_t stream) {
    static int grid = 0;
    if (grid == 0) {
        if (n_in != 24 || (size_t)out_size != O_END || ws_size < WS_END) { fprintf(stderr, "kernel_launch: unexpected shapes (n_in %d, out %d, ws %zu); nothing launched\n", n_in, out_size, ws_size); grid = -1; return; }
        int dev = 0, cus = 0, per_cu = 0;
        if (hipGetDevice(&dev) != hipSuccess || hipDeviceGetAttribute(&cus, hipDeviceAttributeMultiprocessorCount, dev) != hipSuccess) { grid = -1; return; }
        if (hipFuncSetAttribute((const void*)mk_fwd, hipFuncAttributeMaxDynamicSharedMemorySize, LDS_BYTES) != hipSuccess) { fprintf(stderr, "kernel_launch: hipFuncSetAttribute failed\n"); grid = -1; return; }
        if (hipOccupancyMaxActiveBlocksPerMultiprocessor(&per_cu, (const void*)mk_fwd, NWAVES * 64, LDS_BYTES) != hipSuccess || per_cu < 1) { fprintf(stderr, "kernel_launch: occupancy query reports %d blocks per CU\n", per_cu); }
        (void)hipGetLastError();
        grid = cus;
    }
    if (grid < 0) return;
    if (hipMemsetAsync((char*)d_ws + WS_CTL, 0, CTL_ZERO_BYTES, stream) != hipSuccess) return;
    Args a{};
    for (int i = 0; i < 24; ++i) a.in[i] = (const float*)d_in[i];
    a.out = (float*)d_out; a.ws = (unsigned char*)d_ws;
    hipLaunchKernelGGL(mk_fwd, dim3(grid), dim3(NWAVES * 64), LDS_BYTES, stream, a);
}
```

```cpp
#include <hip/hip_runtime.h>
#include <cstdio>
#include <cstdint>
__device__ __forceinline__ int hw_lane() { int l; asm volatile("v_mbcnt_lo_u32_b32 %0, -1, 0\n\tv_mbcnt_hi_u32_b32 %0, -1, %0" : "=v"(l)); return l; }
namespace pg8 {
#define PG8_LAS __attribute__((address_space(3)))
typedef unsigned short bf16_t;
typedef short bf16x8 __attribute__((ext_vector_type(8)));
typedef float f32x4 __attribute__((ext_vector_type(4)));
typedef unsigned u32x4 __attribute__((ext_vector_type(4)));
constexpr int BM = 256, BK = 64, HALF = 128, HTB = HALF * BK * 2  , STAGE_BYTES = 8 * HTB, NXCD = 8, WGM = 4;

__host__ __device__ __forceinline__ int lds_byte(int r, int c) { const int st = (r >> 4) * 2 + (c >> 5), rr = r & 15, cc = c & 31, ob = rr * 64 + cc * 2; return st * 1024 + (ob ^ (((ob >> 9) & 1) << 5)); }
__host__ __device__ __forceinline__ void stage_rc(int b, int& R, int& C) { const int st = b / 1024, sb = b % 1024, swz = sb ^ (((sb >> 9) & 1) << 5); R = (st >> 1) * 16 + swz / 64; C = (st & 1) * 32 + (swz % 64) / 2; }
__host__ __device__ __forceinline__ int perm32(int rho) { const int n = rho >> 4, i = rho & 15; return 8 * (i >> 2) + 4 * n + (i & 3); }

struct Unit { int pm, pn, kt0, nkt, aux; };
struct Gemm { const bf16_t* A; const bf16_t* Bt; int M, N, K; };

struct StaticOrder {
    static constexpr bool PARTS = false;
    int nM, nN, nwg, G, c, nkt;
    __host__ __device__ __forceinline__ void init(int M, int N, int K, int G_, int c_) { nM = M / BM; nN = N / BM; nwg = nM * nN; G = G_; c = c_; nkt = K / BK; }
    __host__ __device__ __forceinline__ bool next(int i, Unit& u) const {
        const long L = (long)i * G + c; if (L >= nwg) return false;
        int wgid = (int)L; { const int q = nwg / NXCD, r = nwg % NXCD, xcd = wgid % NXCD, off = wgid / NXCD; wgid = (xcd < r ? xcd * (q + 1) : r * (q + 1) + (xcd - r) * q) + off; }
        const int nig = WGM * nN, gid = wgid / nig, fm = gid * WGM, gsz = (nM - fm) < WGM ? (nM - fm) : WGM;
        u.pm = fm + ((wgid % nig) % gsz); u.pn = (wgid % nig) / gsz; u.kt0 = 0; u.nkt = nkt; u.aux = -1; return true;
    }
    __device__ __forceinline__ void a_ready(const Unit&) const {}
    __device__ __forceinline__ void done(const Unit&) const {}
};

__device__ __forceinline__ unsigned cvt_pk_bf16(float lo, float hi) { unsigned r; asm volatile("v_cvt_pk_bf16_f32 %0, %1, %2" : "=v"(r) : "v"(lo), "v"(hi)); return r; }
typedef float f32x2 __attribute__((ext_vector_type(2)));
typedef unsigned u32x2 __attribute__((ext_vector_type(2)));
typedef float f32x2 __attribute__((ext_vector_type(2)));
typedef __bf16 bf2_t __attribute__((ext_vector_type(2)));
__device__ __forceinline__ unsigned pkbf(float lo, float hi) { f32x2 v = {lo, hi}; return __builtin_bit_cast(unsigned, __builtin_convertvector(v, bf2_t)); }
__device__ __forceinline__ float bflo(unsigned w) { return __builtin_bit_cast(float, w << 16); }
__device__ __forceinline__ float bfhi(unsigned w) { return __builtin_bit_cast(float, w & 0xffff0000u); }
__device__ __forceinline__ float sigm(float x) { return __builtin_amdgcn_rcpf(1.f + __builtin_amdgcn_exp2f(-1.44269504089f * x)); }
__device__ __forceinline__ float gelu_t(float x) { const float u = x * (1.f + 0.044715f * x * x); return x * sigm(1.59576912161f * u); }

struct EpiF32 {
    static constexpr bool PERM = false, AFTER_DRAIN = false, HAS_MID = false;
    float* C; int ldc; const float* bias;
    __device__ __forceinline__ void operator()(const f32x4 (&acc)[2][2][4][2], const Unit& u, int wr, int wc, int fr, int fq) const {
        const int row0 = u.pm * BM + wr * 64 + fr, col0 = u.pn * BM + wc * 32 + 4 * fq;
        f32x4 bv[2][2];
#pragma unroll
        for (int bj = 0; bj < 2; ++bj)
#pragma unroll
            for (int n = 0; n < 2; ++n) bv[bj][n] = *(const f32x4*)(bias + col0 + bj * HALF + n * 16);
#pragma unroll
        for (int ai = 0; ai < 2; ++ai)
#pragma unroll
            for (int m = 0; m < 4; ++m) { float* rowp = C + (size_t)(row0 + ai * HALF + m * 16) * ldc + col0;
#pragma unroll
                for (int bj = 0; bj < 2; ++bj)
#pragma unroll
                    for (int n = 0; n < 2; ++n) *(f32x4*)(rowp + bj * HALF + n * 16) = acc[ai][bj][m][n] + bv[bj][n]; }
    }
};
template <int MODE> __device__ __forceinline__ float zact(float x) {
    if (MODE == 0) return gelu_t(x);
    if (MODE == 1) return x * sigm(x) * 0.08838834764831845f;
    if (MODE == 2) return x;
    if (MODE == 3) return x * sigm(x);
    return sigm(x);
}
struct EpiZ {
    static constexpr bool PERM = true, AFTER_DRAIN = false, HAS_MID = false;
    bf16_t* Z; int ldc; int pn_off;
    template <int MODE> __device__ __forceinline__ void run(const f32x4 (&acc)[2][2][4][2], const Unit& u, int wr, int wc, int fr, int fq) const {
        const int row0 = u.pm * BM + wr * 64 + fr, col0 = (u.pn + pn_off) * BM + wc * 32 + 8 * fq;
#pragma unroll
        for (int ai = 0; ai < 2; ++ai)
#pragma unroll
            for (int m = 0; m < 4; ++m) { bf16_t* rowp = Z + (size_t)(row0 + ai * HALF + m * 16) * ldc + col0;
#pragma unroll
                for (int bj = 0; bj < 2; ++bj) { const f32x4 v0 = acc[ai][bj][m][0], v1 = acc[ai][bj][m][1];
                    u32x4 w; w.x = pkbf(zact<MODE>(v0[0]), zact<MODE>(v0[1])); w.y = pkbf(zact<MODE>(v0[2]), zact<MODE>(v0[3]));
                    w.z = pkbf(zact<MODE>(v1[0]), zact<MODE>(v1[1])); w.w = pkbf(zact<MODE>(v1[2]), zact<MODE>(v1[3]));
                    *(u32x4*)(rowp + bj * HALF) = w; } }
    }
    __device__ __forceinline__ void operator()(const f32x4 (&acc)[2][2][4][2], const Unit& u, int wr, int wc, int fr, int fq) const {
        const int pn = u.pn + pn_off;
        if (pn < 8) run<0>(acc, u, wr, wc, fr, fq);
        else if (pn < 16) run<1>(acc, u, wr, wc, fr, fq);
        else if (pn < 32) run<2>(acc, u, wr, wc, fr, fq);
        else if (pn < 40) run<3>(acc, u, wr, wc, fr, fq);
        else run<4>(acc, u, wr, wc, fr, fq);
    }
};
template <bool SECOND> struct EpiBranch {
    static constexpr bool PERM = true, AFTER_DRAIN = false, HAS_MID = false;
    const bf16_t* Zg; bf16_t* Y;
    __device__ __forceinline__ void operator()(const f32x4 (&acc)[2][2][4][2], const Unit& u, int wr, int wc, int fr, int fq) const {
        const int row0 = u.pm * BM + wr * 64 + fr, col0 = u.pn * BM + wc * 32 + 8 * fq;
#pragma unroll
        for (int ai = 0; ai < 2; ++ai) {
            u32x4 gt[4][2], pv[4][2];
#pragma unroll
            for (int m = 0; m < 4; ++m) { const size_t row = (size_t)(row0 + ai * HALF + m * 16);
#pragma unroll
                for (int bj = 0; bj < 2; ++bj) { gt[m][bj] = *(const u32x4*)(Zg + row * 14336 + col0 + bj * HALF); if (SECOND) pv[m][bj] = *(const u32x4*)(Y + row * 2048 + col0 + bj * HALF); } }
#pragma unroll
            for (int m = 0; m < 4; ++m) { bf16_t* yr = Y + (size_t)(row0 + ai * HALF + m * 16) * 2048 + col0;
#pragma unroll
                for (int bj = 0; bj < 2; ++bj) { const u32x4 g = gt[m][bj]; const f32x4 v0 = acc[ai][bj][m][0], v1 = acc[ai][bj][m][1];
                    float r[8] = {v0[0] * bflo(g.x), v0[1] * bfhi(g.x), v0[2] * bflo(g.y), v0[3] * bfhi(g.y), v1[0] * bflo(g.z), v1[1] * bfhi(g.z), v1[2] * bflo(g.w), v1[3] * bfhi(g.w)};
                    if (SECOND) { const u32x4 p = pv[m][bj];
                        r[0] += bflo(p.x); r[1] += bfhi(p.x); r[2] += bflo(p.y); r[3] += bfhi(p.y); r[4] += bflo(p.z); r[5] += bfhi(p.z); r[6] += bflo(p.w); r[7] += bfhi(p.w); }
                    u32x4 w; w.x = pkbf(r[0], r[1]); w.y = pkbf(r[2], r[3]); w.z = pkbf(r[4], r[5]); w.w = pkbf(r[6], r[7]);
                    *(u32x4*)(yr + bj * HALF) = w; } }
            asm volatile("" ::: "memory"); }
    }
};
struct EpiResid {
    static constexpr bool PERM = true, AFTER_DRAIN = false, HAS_MID = false;
    const float* base_f; bf16_t* X; const float* gate; bool f32base;
    __device__ __forceinline__ void operator()(const f32x4 (&acc)[2][2][4][2], const Unit& u, int wr, int wc, int fr, int fq) const {
        const int row0 = u.pm * BM + wr * 64 + fr, col0 = u.pn * BM + wc * 32 + 8 * fq;
        f32x4 gv[2][2];
#pragma unroll
        for (int bj = 0; bj < 2; ++bj)
#pragma unroll
            for (int n = 0; n < 2; ++n) gv[bj][n] = *(const f32x4*)(gate + (size_t)(u.pm >> 3) * 24576 + col0 + bj * HALF + n * 4);
        if (f32base) {
#pragma unroll
            for (int am = 0; am < 4; ++am) { const int ai = am >> 1, m0 = (am & 1) * 2;
                f32x4 bs[2][2][2];
#pragma unroll
                for (int m = 0; m < 2; ++m) { const float* bp = base_f + (size_t)(row0 + ai * HALF + (m0 + m) * 16) * 2048 + col0;
#pragma unroll
                    for (int bj = 0; bj < 2; ++bj)
#pragma unroll
                        for (int n = 0; n < 2; ++n) bs[m][bj][n] = *(const f32x4*)(bp + bj * HALF + n * 4); }
#pragma unroll
                for (int m = 0; m < 2; ++m) { bf16_t* xo = X + (size_t)(row0 + ai * HALF + (m0 + m) * 16) * 2048 + col0;
#pragma unroll
                    for (int bj = 0; bj < 2; ++bj) { const f32x4 v0 = bs[m][bj][0] + gv[bj][0] * acc[ai][bj][m0 + m][0], v1 = bs[m][bj][1] + gv[bj][1] * acc[ai][bj][m0 + m][1];
                        u32x4 w; w.x = pkbf(v0[0], v0[1]); w.y = pkbf(v0[2], v0[3]); w.z = pkbf(v1[0], v1[1]); w.w = pkbf(v1[2], v1[3]);
                        *(u32x4*)(xo + bj * HALF) = w; } }
                asm volatile("" ::: "memory"); }
        } else {
#pragma unroll
            for (int ai = 0; ai < 2; ++ai) {
                u32x4 bs[4][2];
#pragma unroll
                for (int m = 0; m < 4; ++m) { const bf16_t* bp = X + (size_t)(row0 + ai * HALF + m * 16) * 2048 + col0;
#pragma unroll
                    for (int bj = 0; bj < 2; ++bj) bs[m][bj] = *(const u32x4*)(bp + bj * HALF); }
#pragma unroll
                for (int m = 0; m < 4; ++m) { bf16_t* xo = X + (size_t)(row0 + ai * HALF + m * 16) * 2048 + col0;
#pragma unroll
                    for (int bj = 0; bj < 2; ++bj) { const u32x4 p = bs[m][bj]; const f32x4 a0 = acc[ai][bj][m][0], a1 = acc[ai][bj][m][1], g0 = gv[bj][0], g1 = gv[bj][1];
                        u32x4 w; w.x = pkbf(bflo(p.x) + g0[0] * a0[0], bfhi(p.x) + g0[1] * a0[1]); w.y = pkbf(bflo(p.y) + g0[2] * a0[2], bfhi(p.y) + g0[3] * a0[3]);
                        w.z = pkbf(bflo(p.z) + g1[0] * a1[0], bfhi(p.z) + g1[1] * a1[1]); w.w = pkbf(bflo(p.w) + g1[2] * a1[2], bfhi(p.w) + g1[3] * a1[3]);
                        *(u32x4*)(xo + bj * HALF) = w; } }
                asm volatile("" ::: "memory"); }
        }
    }
};
struct EpiUp {
    static constexpr bool PERM = true, AFTER_DRAIN = false, HAS_MID = false;
    bf16_t* UP; float* outp; float* outs;
    __device__ __forceinline__ void operator()(const f32x4 (&acc)[2][2][4][2], const Unit& u, int wr, int wc, int fr, int fq) const {
        const int row0 = u.pm * BM + wr * 64 + fr, col0 = u.pn * BM + wc * 32 + 8 * fq;
#pragma unroll
        for (int ai = 0; ai < 2; ++ai)
#pragma unroll
            for (int m = 0; m < 4; ++m) { const int row = row0 + ai * HALF + m * 16; bf16_t* rowp = UP + (size_t)row * 11264 + col0;
                float* fo = nullptr;
                if (row < 8192) { const int t = row & 2047; if (t >= 2046) fo = outp + (size_t)((row >> 11) * 2 + (t - 2046)) * 11264 + col0; }
                else { const int rr = row - 8192, t = rr & 7; if (t >= 6) fo = outs + (size_t)((rr >> 3) * 2 + (t - 6)) * 11264 + col0; }
#pragma unroll
                for (int bj = 0; bj < 2; ++bj) { const f32x4 v0 = acc[ai][bj][m][0], v1 = acc[ai][bj][m][1];
                    u32x4 w; w.x = pkbf(v0[0], v0[1]); w.y = pkbf(v0[2], v0[3]); w.z = pkbf(v1[0], v1[1]); w.w = pkbf(v1[2], v1[3]);
                    *(u32x4*)(rowp + bj * HALF) = w;
                    if (fo) { *(f32x4*)(fo + bj * HALF) = v0; *(f32x4*)(fo + bj * HALF + 4) = v1; } } }
    }
};

struct SplitOrder {
    static constexpr bool PARTS = true;
    int G, c, S, nkt_full;
    __device__ __forceinline__ void init(int K, int S_, int G_, int c_) { G = G_; c = c_; S = S_; nkt_full = K / BK; }
    __device__ __forceinline__ bool next(int i, Unit& u) const {
        const int rot = (G == 256) ? (((c & 7) * nkt_full) >> 3) & ~1 : 0, two = rot > 0 ? 1 : 0;
        const int io = (i == 0) ? 0 : i - two;
        const int L = io * G + c;
        if (L >= 256 + 32 * S) return false;
        const bool pr = L < 256;
        const int wgid = (L & 7) * 32 + ((L >> 3) & 31);
        const int sl = L - 256, tile = sl & 31, s = sl >> 5;
        const int base = (nkt_full / (2 * S)) * 2, rem = (nkt_full - base * S) / 2;
        u.pm = pr ? ((wgid >> 6) * 8 + (wgid & 7)) : 32 + (tile >> 3);
        u.pn = pr ? ((wgid & 63) >> 3) : (tile & 7);
        const bool first = two && i == 0, second = two && i == 1;
        u.kt0 = pr ? (first ? rot : 0) : s * base + 2 * (s < rem ? s : rem);
        u.nkt = pr ? (first ? nkt_full - rot : (second ? rot : nkt_full)) : base + (s < rem ? 2 : 0);
        u.aux = pr ? (first ? -2 : -1) : s;
        return true;
    }
    __device__ __forceinline__ void a_ready(const Unit&) const {}
    __device__ __forceinline__ void done(const Unit&) const {}
};
constexpr size_t SLAB_ELEMS = (size_t)1024 * 2048 + 2560;
template <class Full> struct EpiSplit {
    static constexpr bool PERM = Full::PERM, AFTER_DRAIN = false, HAS_MID = false;
    Full full; bf16_t* slab;
    __device__ __forceinline__ void operator()(const f32x4 (&acc)[2][2][4][2], const Unit& u, int wr, int wc, int fr, int fq) const {
        if (u.aux < 0) { full(acc, u, wr, wc, fr, fq); return; }
        bf16_t* P = slab + (size_t)u.aux * SLAB_ELEMS;
        const int row0 = (u.pm - 32) * BM + wr * 64 + fr, col0 = u.pn * BM + wc * 32 + (PERM ? 8 * fq : 4 * fq);
#pragma unroll
        for (int ai = 0; ai < 2; ++ai)
#pragma unroll
            for (int m = 0; m < 4; ++m) { bf16_t* rowp = P + (size_t)(row0 + ai * HALF + m * 16) * 2048 + col0;
#pragma unroll
                for (int bj = 0; bj < 2; ++bj) {
                    if (PERM) { const f32x4 v0 = acc[ai][bj][m][0], v1 = acc[ai][bj][m][1]; u32x4 w; w.x = pkbf(v0[0], v0[1]); w.y = pkbf(v0[2], v0[3]); w.z = pkbf(v1[0], v1[1]); w.w = pkbf(v1[2], v1[3]); *(u32x4*)(rowp + bj * HALF) = w; }
                    else {
#pragma unroll
                        for (int n = 0; n < 2; ++n) { const f32x4 v = acc[ai][bj][m][n]; u32x2 w; w.x = pkbf(v[0], v[1]); w.y = pkbf(v[2], v[3]); *(u32x2*)(rowp + bj * HALF + 16 * n) = w; } } } }
    }
};
struct UpOrder {
    static constexpr bool PARTS = false;
    StaticOrder P; int G, c;
    __device__ __forceinline__ void init(int G_, int c_) { P.init(8192, 11264, 2048, G_, c_); G = G_; c = c_; }
    __device__ __forceinline__ bool next(int i, Unit& u) const {
        const int L = i * G + c;
        if (L >= 1536 + 192) return false;
        Unit up; const bool inP = P.next(i, up);
        const int x = L - 1408, sl = L - 1536, tile = sl % 48, s = sl / 48;
        const bool smp = !inP && L < 1536;
        u.pm = inP ? up.pm : (smp ? 32 + (x & 3) : 32 + (tile & 3));
        u.pn = inP ? up.pn : (smp ? (x >> 2) : 32 + (tile >> 2));
        u.kt0 = (inP || smp) ? 0 : 8 * s; u.nkt = (inP || smp) ? 32 : 8; u.aux = (inP || smp) ? -1 : s;
        return true;
    }
    __device__ __forceinline__ void a_ready(const Unit&) const {}
    __device__ __forceinline__ void done(const Unit&) const {}
};
constexpr size_t UPSLAB_ELEMS = (size_t)1024 * 3072 + 2560;
struct EpiUpSplit {
    static constexpr bool PERM = true, AFTER_DRAIN = false, HAS_MID = false;
    EpiUp full; bf16_t* slab;
    __device__ __forceinline__ void operator()(const f32x4 (&acc)[2][2][4][2], const Unit& u, int wr, int wc, int fr, int fq) const {
        if (u.aux < 0) { full(acc, u, wr, wc, fr, fq); return; }
        bf16_t* P = slab + (size_t)u.aux * UPSLAB_ELEMS;
        const int row0 = (u.pm - 32) * BM + wr * 64 + fr, col0 = (u.pn - 32) * BM + wc * 32 + 8 * fq;
#pragma unroll
        for (int ai = 0; ai < 2; ++ai)
#pragma unroll
            for (int m = 0; m < 4; ++m) { bf16_t* rowp = P + (size_t)(row0 + ai * HALF + m * 16) * 3072 + col0;
#pragma unroll
                for (int bj = 0; bj < 2; ++bj) { const f32x4 v0 = acc[ai][bj][m][0], v1 = acc[ai][bj][m][1]; u32x4 w; w.x = pkbf(v0[0], v0[1]); w.y = pkbf(v0[2], v0[3]); w.z = pkbf(v1[0], v1[1]); w.w = pkbf(v1[2], v1[3]); *(u32x4*)(rowp + bj * HALF) = w; } }
    }
};
template <class Epi, class Sched, bool ALIGN_EPI = false, bool SP2 = false>
__device__ __forceinline__ void gemm_phase(PG8_LAS unsigned char* lds, const Gemm g, const Sched& S, const Epi& E, const int wv0) {
    int tid_ = wv0 * 64 + hw_lane(); asm volatile("" : "+v"(tid_));
    const int tid = tid_, wid = __builtin_amdgcn_readfirstlane(tid >> 6), lane = tid & 63, wr = wid >> 2, wc = wid & 3, fr = lane & 15, fq = lane >> 4;
    const int K = g.K;
    unsigned voffA[2], voffB[2];
#pragma unroll
    for (int i = 0; i < 2; ++i) { int R, C; stage_rc(tid * 16 + i * 8192, R, C); const int Rb = Epi::PERM ? ((R & ~31) + perm32(R & 31)) : R;
        voffA[i] = (unsigned)(R * K + C) * 2u; voffB[i] = (unsigned)(Rb * K + C) * 2u; }
    const size_t kstep = (size_t)(BK * 2);
    const size_t hstep = (size_t)HALF * K * 2;
    const size_t tstep = 2 * hstep;
    const unsigned ldsw = (unsigned)wid * 1024u;
    const int aoff = lds_byte(wr * 64 + fr, fq * 8), boff = lds_byte(wc * 32 + fr, fq * 8);
#define PG8_SA(b, h) (((b) * 2 + (h)) * HTB)
#define PG8_SB(b, h) ((4 + (b) * 2 + (h)) * HTB)
#define PG8_STAGE(bufoff, gbase, voff) do { _Pragma("unroll") for (int _i = 0; _i < 2; ++_i) \
        __builtin_amdgcn_global_load_lds((const unsigned*)((const char*)(gbase) + (voff)[_i]), (PG8_LAS unsigned*)(lds + (bufoff) + ldsw + _i * 8192), 16, 0, 0); } while (0)
#define PG8_LDA(dst, b, h) do { _Pragma("unroll") for (int m = 0; m < 4; ++m) _Pragma("unroll") for (int k = 0; k < 2; ++k) dst[m][k] = *(const PG8_LAS bf16x8*)(lds + PG8_SA(b, h) + aoff + m * 2048 + k * 1024); } while (0)
#define PG8_LDB(dst, b, h) do { _Pragma("unroll") for (int n = 0; n < 2; ++n) _Pragma("unroll") for (int k = 0; k < 2; ++k) dst[n][k] = *(const PG8_LAS bf16x8*)(lds + PG8_SB(b, h) + boff + n * 2048 + k * 1024); } while (0)
#define PG8_MMA(ai, bj, At, Bt) do { __builtin_amdgcn_s_setprio(1); _Pragma("unroll") for (int m = 0; m < 4; ++m) _Pragma("unroll") for (int n = 0; n < 2; ++n) _Pragma("unroll") for (int k = 0; k < 2; ++k) \
        acc[ai][bj][m][n] = __builtin_amdgcn_mfma_f32_16x16x32_bf16(Bt[n][k], At[m][k], acc[ai][bj][m][n], 0, 0, 0); __builtin_amdgcn_s_setprio(0); } while (0)
#define PG8_WAIT_V(n) asm volatile("s_waitcnt vmcnt(" #n ")" ::: "memory")
#define PG8_WAIT_L(n) asm volatile("s_waitcnt lgkmcnt(" #n ")" ::: "memory")
#define PG8_BAR __builtin_amdgcn_s_barrier()
#define PG8_SCHED __builtin_amdgcn_sched_barrier(0)
    Unit cur, nxt; int ui = 0;
    if (!S.next(0, cur)) return;
    f32x4 acc[2][2][4][2];
#pragma unroll
    for (int a = 0; a < 2; ++a)
#pragma unroll
        for (int b = 0; b < 2; ++b)
#pragma unroll
            for (int m = 0; m < 4; ++m)
#pragma unroll
                for (int n = 0; n < 2; ++n) acc[a][b][m][n] = (f32x4){0.f, 0.f, 0.f, 0.f};
    bf16x8 At[4][2], B0[2][2], B1[2][2];
    const char* cA = (const char*)g.A + (size_t)cur.pm * tstep + (size_t)cur.kt0 * kstep; const char* cB = (const char*)g.Bt + (size_t)cur.pn * tstep + (size_t)cur.kt0 * kstep;
    S.a_ready(cur);
    if constexpr (SP2) {
        PG8_STAGE(PG8_SB(0, 0), cB, voffB); PG8_STAGE(PG8_SB(0, 1), cB + hstep, voffB); PG8_STAGE(PG8_SA(0, 0), cA, voffA); PG8_STAGE(PG8_SA(0, 1), cA + hstep, voffA);
        if (wr == 1) PG8_BAR;
        PG8_WAIT_V(2); PG8_BAR;
        PG8_STAGE(PG8_SB(1, 0), cB + kstep, voffB); PG8_STAGE(PG8_SA(1, 0), cA + kstep, voffA); PG8_STAGE(PG8_SB(1, 1), cB + hstep + kstep, voffB);
        PG8_WAIT_V(6); PG8_BAR;
    } else {
        PG8_STAGE(PG8_SB(0, 0), cB, voffB); PG8_STAGE(PG8_SA(0, 0), cA, voffA); PG8_STAGE(PG8_SB(0, 1), cB + hstep, voffB); PG8_STAGE(PG8_SA(0, 1), cA + hstep, voffA);
        if (wr == 1) PG8_BAR;
        PG8_WAIT_V(4); PG8_BAR;
        PG8_STAGE(PG8_SB(1, 0), cB + kstep, voffB); PG8_STAGE(PG8_SA(1, 0), cA + kstep, voffA); PG8_STAGE(PG8_SB(1, 1), cB + hstep + kstep, voffB);
        PG8_WAIT_V(6); PG8_BAR;
    }
    for (;;) {
        const bool has_next = S.next(ui + 1, nxt);
        const char* nA = has_next ? (const char*)g.A + (size_t)nxt.pm * tstep + (size_t)nxt.kt0 * kstep : cA; const char* nB = has_next ? (const char*)g.Bt + (size_t)nxt.pn * tstep + (size_t)nxt.kt0 * kstep : cB;
        const int nt = cur.nkt;
        for (int t = 0; t < nt; t += 2) {
            if constexpr (Epi::HAS_MID) { if (t == E.tmid) E.mid(acc, cur, wr, wc, fr, fq); }
            const bool last = (t == nt - 2);
            const char* a1 = cA + (size_t)(t + 1) * kstep;
            const char* a2 = last ? nA : cA + (size_t)(t + 2) * kstep; const char* b2 = last ? nB : cB + (size_t)(t + 2) * kstep;
            const char* a3 = a2 + kstep; const char* b3 = b2 + kstep;
            if (last && has_next) S.a_ready(nxt);
            if constexpr (SP2) {
            PG8_LDB(B0, 0, 0); PG8_LDB(B1, 0, 1); PG8_SCHED; PG8_LDA(At, 0, 0); PG8_STAGE(PG8_SA(1, 1), a1 + hstep, voffA);
            PG8_WAIT_V(8); PG8_WAIT_L(0); PG8_BAR; PG8_MMA(0, 0, At, B0); PG8_MMA(0, 1, At, B1); PG8_BAR; PG8_SCHED;
            PG8_LDA(At, 0, 1); PG8_STAGE(PG8_SB(0, 0), b2, voffB); PG8_STAGE(PG8_SB(0, 1), b2 + hstep, voffB); PG8_STAGE(PG8_SA(0, 0), a2, voffA);
            PG8_WAIT_V(8); PG8_WAIT_L(0); PG8_BAR; PG8_MMA(1, 0, At, B0); PG8_MMA(1, 1, At, B1); PG8_BAR; PG8_SCHED;
            PG8_LDB(B0, 1, 0); PG8_LDB(B1, 1, 1); PG8_SCHED; PG8_LDA(At, 1, 0); PG8_STAGE(PG8_SA(0, 1), a2 + hstep, voffA);
            PG8_WAIT_V(8); PG8_WAIT_L(0); PG8_BAR; PG8_MMA(0, 0, At, B0); PG8_MMA(0, 1, At, B1); PG8_BAR; PG8_SCHED;
            PG8_LDA(At, 1, 1); PG8_STAGE(PG8_SB(1, 0), b3, voffB); PG8_STAGE(PG8_SB(1, 1), b3 + hstep, voffB); PG8_STAGE(PG8_SA(1, 0), a3, voffA);
            PG8_WAIT_V(8); PG8_WAIT_L(0); PG8_BAR; PG8_MMA(1, 0, At, B0); PG8_MMA(1, 1, At, B1); PG8_BAR; PG8_SCHED;
            } else {
            PG8_LDB(B0, 0, 0); PG8_SCHED; PG8_LDA(At, 0, 0); PG8_STAGE(PG8_SA(1, 1), a1 + hstep, voffA);
            PG8_WAIT_L(8); PG8_BAR; PG8_WAIT_L(0); PG8_MMA(0, 0, At, B0); PG8_BAR; PG8_SCHED;
            PG8_LDB(B1, 0, 1); PG8_STAGE(PG8_SB(0, 0), b2, voffB);
            PG8_BAR; PG8_WAIT_L(0); PG8_MMA(0, 1, At, B1); PG8_BAR;
            PG8_LDA(At, 0, 1); PG8_STAGE(PG8_SA(0, 0), a2, voffA);
            PG8_BAR; PG8_WAIT_L(0); PG8_MMA(1, 0, At, B0); PG8_BAR; PG8_SCHED;
            PG8_STAGE(PG8_SB(0, 1), b2 + hstep, voffB);
            PG8_WAIT_V(6); PG8_BAR; PG8_MMA(1, 1, At, B1); PG8_BAR;
            PG8_LDB(B0, 1, 0); PG8_SCHED; PG8_LDA(At, 1, 0); PG8_STAGE(PG8_SA(0, 1), a2 + hstep, voffA);
            PG8_WAIT_L(8); PG8_BAR; PG8_WAIT_L(0); PG8_MMA(0, 0, At, B0); PG8_BAR; PG8_SCHED;
            PG8_LDB(B1, 1, 1); PG8_STAGE(PG8_SB(1, 0), b3, voffB);
            PG8_BAR; PG8_WAIT_L(0); PG8_MMA(0, 1, At, B1); PG8_BAR;
            PG8_LDA(At, 1, 1); PG8_STAGE(PG8_SA(1, 0), a3, voffA);
            PG8_BAR; PG8_WAIT_L(0); PG8_MMA(1, 0, At, B0); PG8_BAR; PG8_SCHED;
            PG8_STAGE(PG8_SB(1, 1), b3 + hstep, voffB);
            PG8_WAIT_V(6); PG8_BAR; PG8_MMA(1, 1, At, B1); PG8_BAR;
            }
        }
        const bool part = Sched::PARTS && cur.aux == -2;
        if (!part) {
        if constexpr (ALIGN_EPI) { if (wr == 0) PG8_BAR; }
        if constexpr (!Epi::AFTER_DRAIN) { E(acc, cur, wr, wc, fr, fq); S.done(cur); }
        }
        if (!has_next) break;
        if (!part) {
#pragma unroll
        for (int a = 0; a < 2; ++a)
#pragma unroll
            for (int b = 0; b < 2; ++b)
#pragma unroll
                for (int m = 0; m < 4; ++m)
#pragma unroll
                    for (int n = 0; n < 2; ++n) acc[a][b][m][n] = (f32x4){0.f, 0.f, 0.f, 0.f};
        }
        cur = nxt; cA = nA; cB = nB; ++ui;
        if (!part) {
        if constexpr (ALIGN_EPI) { if (wr == 1) PG8_BAR; }
        }
    }
    PG8_WAIT_V(0);
    if constexpr (!ALIGN_EPI) { if (wr == 0) PG8_BAR; }
    PG8_BAR;
    if constexpr (Epi::AFTER_DRAIN) { E.fused(acc, cur, wr, wc, fr, fq, lds, wid, lane); S.done(cur); }
#undef PG8_SA
#undef PG8_SB
#undef PG8_STAGE
#undef PG8_LDA
#undef PG8_LDB
#undef PG8_MMA
#undef PG8_WAIT_V
#undef PG8_WAIT_L
#undef PG8_BAR
#undef PG8_SCHED
}
}
#define GAS __attribute__((address_space(1)))
#define LAS __attribute__((address_space(3)))
typedef unsigned short bf16;
typedef unsigned v4u __attribute__((ext_vector_type(4)));
typedef float f32x4 __attribute__((ext_vector_type(4)));
typedef short bf16x8 __attribute__((ext_vector_type(8)));
typedef GAS unsigned gu32;
typedef GAS unsigned long long gu64;
#define RLX_AGENT __ATOMIC_RELAXED, __HIP_MEMORY_SCOPE_AGENT
#define LDS_WAIT() asm volatile("s_waitcnt lgkmcnt(0)" ::: "memory")
#define VM_WAIT() asm volatile("s_waitcnt vmcnt(0)" ::: "memory")
__device__ __forceinline__ unsigned long long rt() { return __builtin_amdgcn_s_memrealtime(); }
__device__ __forceinline__ unsigned f2bf(float f) { unsigned u = __builtin_bit_cast(unsigned, f); return (u + 0x7fffu + ((u >> 16) & 1u)) >> 16; }
__device__ __forceinline__ unsigned pk2(float lo, float hi) { return f2bf(lo) | (f2bf(hi) << 16); }

#define XB_TMO      128
#define XB_XCNT(j)  (256  + 64 * (j))
#define XB_XSUB(j)  (1280 + 64 * (j))
#define XB_XGEN(j)  (2304 + 64 * (j))
#define XB_TOP      3328
#define XB_TOPGEN   3392
#define XCD_BAR_WORDS 3456
#define XB_SPIN_CAP (1u << 18)

__device__ __forceinline__ unsigned xb_ld(unsigned* p)              { return __hip_atomic_load(p, __ATOMIC_RELAXED, __HIP_MEMORY_SCOPE_AGENT); }
__device__ __forceinline__ unsigned xb_add(unsigned* p, unsigned v) { return __hip_atomic_fetch_add(p, v, __ATOMIC_RELAXED, __HIP_MEMORY_SCOPE_AGENT); }
__device__ __forceinline__ unsigned xb_xcc_id() { return (unsigned)__builtin_amdgcn_s_getreg((3 << 11) | 20) & 0xFu; }
#define XB_SPIN(cond, bar) do { unsigned _sp = 0; while (cond) { __builtin_amdgcn_s_sleep(1); \
    if ((++_sp & 255u) == 0u) { if (xb_ld(&(bar)[XB_TMO])) break; if (_sp > XB_SPIN_CAP) { atomicAdd(&(bar)[XB_TMO], 1u); break; } } } } while (0)

struct XcdBarrier {
    unsigned* bar; unsigned x; unsigned w0;
    volatile LAS unsigned* st;
};

__device__ __forceinline__ XcdBarrier xcd_barrier_post(unsigned* bar, volatile LAS unsigned* st, int wv0) {
    XcdBarrier b; b.bar = bar; b.x = xb_xcc_id(); b.st = st; b.w0 = (unsigned)wv0;
    if (wv0 == 0 && hw_lane() == 0) (void)xb_add(&bar[XB_XCNT(b.x)], 1u);
    return b;
}
__device__ __forceinline__ void xcd_barrier_complete(unsigned* bar, unsigned x, unsigned& nloc, unsigned& nx) {
    const unsigned G = gridDim.x * gridDim.y * gridDim.z;
    unsigned sum, cnt, mine, sp = 0u;
    for (;;) {
        sum = 0u; cnt = 0u; mine = 0u;
#pragma unroll
        for (unsigned j = 0; j < 16; ++j) { const unsigned c = xb_ld(&bar[XB_XCNT(j)]); sum += c; cnt |= (c > 0u) ? (1u << j) : 0u; mine = (j == x) ? c : mine; }
        if (sum == G) break;
        __builtin_amdgcn_s_sleep(1);
        if ((++sp & 255u) == 0u) { if (xb_ld(&bar[XB_TMO])) break; if (sp > XB_SPIN_CAP) { atomicAdd(&bar[XB_TMO], 1u); break; } }
    }
    nloc = mine > 0u ? mine : 1u; nx = cnt | (1u << x);
}

__device__ __forceinline__ void xcd_barrier(const XcdBarrier& b) {
    asm volatile("s_waitcnt vmcnt(0)" ::: "memory");
    __syncthreads();
    if (b.w0 == 0u) {
        unsigned* bar = b.bar; const int ln = hw_lane();
        unsigned gen = 0u, mask = 0u;
        if (ln == 0) {
            __builtin_amdgcn_s_waitcnt(0);
            unsigned nloc = b.st[0], nx = b.st[1];
            if (nloc == 0u) { xcd_barrier_complete(bar, b.x, nloc, nx); b.st[0] = nloc; b.st[1] = nx; }
            const unsigned old = xb_add(&bar[XB_XSUB(b.x)], 1u);
            gen = old / nloc; mask = nx;
            if (old + 1u == (gen + 1u) * nloc) {
                __builtin_amdgcn_fence(__ATOMIC_RELEASE, "agent");
                asm volatile("s_waitcnt vmcnt(0)" ::: "memory");
                xb_add(&bar[XB_XGEN(b.x)], 1u);
            }
        }
        gen = (unsigned)__builtin_amdgcn_readfirstlane((int)gen); mask = (unsigned)__builtin_amdgcn_readfirstlane((int)mask);
        { const bool mine = ln < 16 && ((mask >> ln) & 1u); unsigned sp = 0u;
          for (;;) {
              bool ok = true; if (mine) ok = xb_ld(&bar[XB_XGEN(ln)]) > gen;
              if (__builtin_amdgcn_ballot_w64(!ok) == 0ull) break;
              __builtin_amdgcn_s_sleep(1);
              if ((++sp & 255u) == 0u) { if (xb_ld(&bar[XB_TMO])) break; if (sp > XB_SPIN_CAP) { if (ln == 0) atomicAdd(&bar[XB_TMO], 1u); break; } } } }
        __builtin_amdgcn_fence(__ATOMIC_ACQUIRE, "agent");
        asm volatile("s_waitcnt vmcnt(0)" ::: "memory");
    }
    __syncthreads();
}

constexpr int NWAVES = 8;
constexpr int DM = 2048, MP = 8192, MS = 1024, MT = MP + MS;
constexpr int NIN = 14336, DFF = 5632, NUP = 2 * DFF, NCOND = 132, MODP = 24576;
constexpr int ZU = 0, ZV = 1024, ZQ = 2048, ZF = 4096, ZI = 6144, ZOG = 8192, ZGA = 10240, ZGB = 12288;
constexpr float EPS = 1e-6f, L2E = 1.44269504089f;
constexpr size_t O_YP = 0, O_YS = 16777216, O_HP = 18874368, O_HS = 20971520, O_CP = 88080384, O_CS = 88260608, O_VP = 94027776, O_VS = 95076352, O_END = 97173504;
constexpr size_t MiB = 1u << 20;
constexpr size_t WS_CTL = 0, CTL_ZERO_BYTES = 1 * MiB;
constexpr size_t WS_AC = 1 * MiB;
constexpr size_t WS_MOD = 2 * MiB;
constexpr size_t WS_ADAT = 26 * MiB;
constexpr size_t WS_WIN = 122 * MiB, SZ_WIN = 56 * MiB;
constexpr size_t WS_WBA = 234 * MiB, SZ_WBA = 4 * MiB;
constexpr size_t WS_WBB = 242 * MiB, SZ_WBB = 8 * MiB;
constexpr size_t WS_WOUT = 258 * MiB, SZ_WOUT = 8 * MiB;
constexpr size_t WS_WUP = 274 * MiB, SZ_WUP = 44 * MiB;
constexpr size_t WS_WDN = 362 * MiB, SZ_WDN = 22 * MiB;
constexpr size_t WS_X = 406 * MiB;
constexpr size_t WS_H = 478 * MiB;
constexpr size_t WS_Z = 514 * MiB;
constexpr size_t WS_YA = 766 * MiB;
constexpr size_t WS_O = 784 * MiB;
constexpr size_t WS_Y = 820 * MiB;
constexpr size_t WS_ACT = 856 * MiB;
constexpr size_t WS_SLAB = 955 * MiB;
constexpr size_t WS_END = 1051 * MiB;
constexpr int CW_BAR = 4096;
constexpr int RING_OFF = 0, RING_BYTES = 131072;
constexpr int LDSCTL_OFF = RING_BYTES, MISC_OFF = LDSCTL_OFF + 320;
constexpr int LDS_BYTES = 147456;

#define DI __device__ __forceinline__
typedef unsigned v2u __attribute__((ext_vector_type(2)));
using pg8::pkbf; using pg8::bflo; using pg8::bfhi; using pg8::sigm; using pg8::gelu_t;
DI float fexp2(float x) { return __builtin_amdgcn_exp2f(x); }
DI float flog2(float x) { return __builtin_amdgcn_logf(x); }
DI float frcp(float x) { return __builtin_amdgcn_rcpf(x); }
DI float frsq(float x) { return __builtin_amdgcn_rsqf(x); }
DI float lane_get(float x, int src_lane) { return __builtin_bit_cast(float, __builtin_amdgcn_ds_bpermute(src_lane << 2, __builtin_bit_cast(int, x))); }
DI float wave_sum(float v, int lane) {
#pragma unroll
    for (int o = 1; o < 64; o <<= 1) v += lane_get(v, lane ^ o);
    return v;
}
#define LDS_BARRIER() do { asm volatile("s_waitcnt lgkmcnt(0)" ::: "memory"); __builtin_amdgcn_s_barrier(); asm volatile("" ::: "memory"); } while (0)
#define MFMA16(a, b, c) __builtin_amdgcn_mfma_f32_16x16x32_bf16((a), (b), (c), 0, 0, 0)

struct Args { const float* in[24]; float* out; unsigned char* ws; };
DI const float* inp(const Args& a, int k) { asm volatile("" : "+s"(k)); return (const float*)(const GAS float*)a.in[k]; }
enum { I_XP = 0, I_XS, I_CP, I_CS, I_SH, I_SC, I_ADAW, I_ADAB, I_N1, I_N2, I_WIN, I_VG, I_WS, I_BS, I_WBA, I_LB, I_HNG, I_WBB, I_WOUT, I_WUP, I_CW, I_CB, I_WDN, I_FNG };

DI void p0_transpose_item(const float* W, int N, bf16* WT, int pitch, int col_off, LAS float* scr, int item, int lane) {
    asm volatile("" : "+v"(lane));
    const int nblk = N / 32, kb = item / nblk, nb = item % nblk, k0 = 64 * kb, n0 = 32 * nb;
    float v[32];
#pragma unroll
    for (int i = 0; i < 32; ++i) { const int kk = 2 * i + (lane >> 5); v[i] = __builtin_nontemporal_load(W + (size_t)(k0 + kk) * N + n0 + (lane & 31)); }
#pragma unroll
    for (int i = 0; i < 32; ++i) { const int kk = 2 * i + (lane >> 5); scr[kk * 33 + (lane & 31)] = v[i]; }
    LDS_WAIT(); asm volatile("" ::: "memory");
    const int c = lane & 7;
#pragma unroll
    for (int j = 0; j < 4; ++j) { const int n = (lane >> 3) + 8 * j; const LAS float* s = scr + (8 * c) * 33 + n;
        v4u o; o.x = pkbf(s[0 * 33], s[1 * 33]); o.y = pkbf(s[2 * 33], s[3 * 33]); o.z = pkbf(s[4 * 33], s[5 * 33]); o.w = pkbf(s[6 * 33], s[7 * 33]);
        *(GAS v4u*)(WT + (size_t)(n0 + n) * pitch + col_off + k0 + 8 * c) = o; }
    LDS_WAIT(); asm volatile("" ::: "memory");
}

template <bool FINAL>
DI void norm_rows(const void* xp, const void* xs, bool pbf, bool sbf  , const float* g, const float* modsh  , bf16* H, float* out, int gw, int NGW, int lane,
                  const bf16* slab  , const float* gate  , bf16* xs_out  , LAS unsigned char* lds) {
    asm volatile("" : "+v"(lane), "+s"(gw));
    const bool bal = (slab != nullptr) && (NGW == 2048);
    int srow = -1, r0, r1;
    if (bal) { if (gw < 1024) { srow = MP + gw; r0 = 2 * gw; r1 = r0 + 2; } else { r0 = 2048 + 6 * (gw - 1024); r1 = r0 + 6; } }
    else if (NGW == 2048) {
        if (gw < 1792) { r0 = (gw * MP) / 1792; r1 = ((gw + 1) * MP) / 1792; } else { r0 = MP + 4 * (gw - 1792); r1 = r0 + 4; } }
    else { unsigned n_ = (unsigned)NGW; asm volatile("" : "+s"(n_));
           r0 = (int)((unsigned)(gw * MT) / n_); r1 = (int)((unsigned)((gw + 1) * MT) / n_); }
    int cbc = -1; f32x4 wv[8], shv[8];
    auto params = [&](int row) {
        const int cb = row < MP ? (row >> 11) : 4 + ((row - MP) >> 3);
        if (cb == cbc) return;
        cbc = cb;
        if (FINAL) {
#pragma unroll
            for (int j = 0; j < 8; ++j) wv[j] = ((const GAS f32x4*)g)[lane + 64 * j];
        } else {
            const GAS f32x4* sh = (const GAS f32x4*)(modsh + (size_t)cb * MODP) + lane; const GAS f32x4* sc = sh + DM / 4;
#pragma unroll
            for (int j = 0; j < 8; ++j) { wv[j] = ((const GAS f32x4*)g)[lane + 64 * j] * (sc[64 * j] + 1.f); shv[j] = sh[64 * j]; }
        } };
    auto ldrow = [&](int row, f32x4 (&v)[8]) {
        const bool isb = row < MP ? pbf : sbf; const size_t roff = row < MP ? (size_t)row * DM : (size_t)(row - MP) * DM; const void* rbase = row < MP ? xp : xs;
        if (isb) { const GAS v2u* xr = (const GAS v2u*)((const bf16*)rbase + roff) + lane; v2u w[8];
#pragma unroll
            for (int j = 0; j < 8; ++j) w[j] = xr[64 * j];
#pragma unroll
            for (int j = 0; j < 8; ++j) v[j] = (f32x4){bflo(w[j].x), bfhi(w[j].x), bflo(w[j].y), bfhi(w[j].y)}; }
        else { const GAS f32x4* xr = (const GAS f32x4*)((const float*)rbase + roff) + lane;
#pragma unroll
            for (int j = 0; j < 8; ++j) v[j] = xr[64 * j]; } };
    auto fold = [&](int row, f32x4 (&v)[8], bool lgate = false) {
        const int cbs = 4 + ((row - MP) >> 3);
        const GAS f32x4* gp = (const GAS f32x4*)(gate + (size_t)cbs * MODP) + lane; const GAS v2u* sp = (const GAS v2u*)(slab + (size_t)(row - MP) * DM) + lane;
        f32x4 a[8], gq[8];
#pragma unroll
        for (int j = 0; j < 8; ++j) { a[j] = (f32x4){0.f, 0.f, 0.f, 0.f}; if (!lgate) gq[j] = gp[64 * j]; }
#pragma unroll 1
        for (int sh = 0; sh < 2; ++sh) {
#pragma unroll
            for (int j = 0; j < 8; ++j)
#pragma unroll
                for (int s = 0; s < 4; ++s) { const v2u w = sp[(size_t)(4 * sh + s) * (pg8::SLAB_ELEMS / 4) + 64 * j]; a[j] += (f32x4){bflo(w.x), bfhi(w.x), bflo(w.y), bfhi(w.y)}; } }
        if (lgate) {
#pragma unroll
            for (int j = 0; j < 8; ++j) gq[j] = *(const LAS f32x4*)(lds + (lane + 64 * j) * 16); }
#pragma unroll
        for (int j = 0; j < 8; ++j) v[j] += gq[j] * a[j];
        if (xs_out) { GAS v2u* xo = (GAS v2u*)(xs_out + (size_t)(row - MP) * DM) + lane;
#pragma unroll
            for (int j = 0; j < 8; ++j) { v2u w; w.x = pkbf(v[j].x, v[j].y); w.y = pkbf(v[j].z, v[j].w); xo[64 * j] = w; } } };
    auto finish = [&](int row, const f32x4 (&v)[8]) {
        float ss = 0.f;
#pragma unroll
        for (int j = 0; j < 8; ++j) ss += (v[j].x * v[j].x + v[j].y * v[j].y) + (v[j].z * v[j].z + v[j].w * v[j].w);
        const float rstd = frsq(wave_sum(ss, lane) * (1.f / DM) + EPS);
        if (FINAL) { GAS f32x4* o = (GAS f32x4*)(out + (size_t)row * DM) + lane;
#pragma unroll
            for (int j = 0; j < 8; ++j) o[64 * j] = v[j] * rstd * wv[j]; }
        else { GAS v2u* o = (GAS v2u*)(H + (size_t)row * DM) + lane;
#pragma unroll
            for (int j = 0; j < 8; ++j) { const f32x4 h = v[j] * rstd * wv[j] + shv[j]; v2u w; w.x = pkbf(h.x, h.y); w.y = pkbf(h.z, h.w); o[64 * j] = w; } } };
    if (srow >= 0) {
        const int cbs = 4 + ((srow - MP) >> 3); const int idx = (srow & 7) * 64 + lane;
        const f32x4 g4 = ((const GAS f32x4*)(gate + (size_t)cbs * MODP))[idx];
        f32x4 w4 = ((const GAS f32x4*)g)[idx], s4 = {0.f, 0.f, 0.f, 0.f};
        if (!FINAL) { const GAS f32x4* sh = (const GAS f32x4*)(modsh + (size_t)cbs * MODP); w4 = w4 * (sh[DM / 4 + idx] + 1.f); s4 = sh[idx]; }
        *(LAS f32x4*)(lds + idx * 16) = g4; *(LAS f32x4*)(lds + 8192 + idx * 16) = w4; *(LAS f32x4*)(lds + 16384 + idx * 16) = s4;
    }
    if (bal) { if (gw < 1024) LDS_BARRIER(); }
    if (srow >= 0) {
        v2u w2[2][8];
        const bool pre = pbf && (r1 - r0 == 2);
        if (pre) {
#pragma unroll
            for (int t = 0; t < 2; ++t) { const GAS v2u* xr = (const GAS v2u*)((const bf16*)xp + (size_t)(r0 + t) * DM) + lane;
#pragma unroll
                for (int j = 0; j < 8; ++j) w2[t][j] = xr[64 * j]; } }
        { f32x4 v[8]; ldrow(srow, v); fold(srow, v, true);
#pragma unroll
          for (int j = 0; j < 8; ++j) { wv[j] = *(const LAS f32x4*)(lds + 8192 + (lane + 64 * j) * 16); shv[j] = *(const LAS f32x4*)(lds + 16384 + (lane + 64 * j) * 16); }
          cbc = 4 + ((srow - MP) >> 3);
          finish(srow, v); }
        if (pre) { params(r0);
#pragma unroll
            for (int t = 0; t < 2; ++t) { f32x4 v[8];
#pragma unroll
                for (int j = 0; j < 8; ++j) v[j] = (f32x4){bflo(w2[t][j].x), bfhi(w2[t][j].x), bflo(w2[t][j].y), bfhi(w2[t][j].y)};
                finish(r0 + t, v); }
            r0 = r1; } }
    for (int row = r0; row < r1;) {
        asm volatile("" : "+v"(lane));
        const bool pair = (row + 1 < r1) && ((row + 1 < MP) ? ((row >> 11) == ((row + 1) >> 11)) : (row >= MP && slab == nullptr && (((row - MP) >> 3) == ((row + 1 - MP) >> 3))));
        if (pair) { f32x4 v0[8], v1[8]; ldrow(row, v0); ldrow(row + 1, v1); params(row); finish(row, v0); finish(row + 1, v1); row += 2; }
        else { f32x4 v[8]; ldrow(row, v); if (slab && row >= MP) fold(row, v); params(row); finish(row, v); row += 1; }
    }
}

constexpr int HP = 272, HPK = 144;
constexpr int HG_QT = 0, HG_KT = 64 * HP, HG_IVT = 2 * 64 * HP, HG_EAR = HG_IVT + 128 * HPK, HG_PART = HG_EAR + 512, HG_BUF0 = HG_PART + 2048;
constexpr int HG_KDT = HG_BUF0, HG_P = HG_KDT + 128 * HPK, HG_DEC = HG_P + 64 * HPK, HG_BUFSZ = 128 * HPK + 64 * HPK + 512, HG_END = HG_BUF0 + 2 * HG_BUFSZ;
static_assert(HG_END <= RING_BYTES, "hgrn lds");
struct HgRegs { v2u qt[4], kt[4], kd[4], iv[4]; f32x4 dec, ear; };
DI void hg_load(const bf16* Z, int rowb, int h, int k0, int tg, bool valid, v2u (&qw)[4], v2u (&fw)[4], v2u (&iw)[4]) {
#pragma unroll
    for (int j = 0; j < 4; ++j) {
        if (valid) { const bf16* zr = Z + (size_t)(rowb + 4 * tg + j) * NIN + h * 128 + k0;
            qw[j] = *(const v2u*)(zr + ZQ); fw[j] = *(const v2u*)(zr + ZF); iw[j] = *(const v2u*)(zr + ZI); }
        else { qw[j] = (v2u){0u, 0u}; fw[j] = (v2u){0u, 0u}; iw[j] = (v2u){0u, 0u}; }
    }
}
template <int NG>
DI void hg_elem(const v2u (&qw)[4], const v2u (&fw)[4], const v2u (&iw)[4], const float (&lb)[4], const float (&oml)[4], bool valid, int lane, int tg, int kql, HgRegs& R) {
#pragma unroll
    for (int cp = 0; cp < 2; ++cp) {
        float lf[4][2], kk[4][2];
#pragma unroll
        for (int j = 0; j < 4; ++j) { const unsigned w = cp ? fw[j].y : fw[j].x;
#pragma unroll
            for (int c = 0; c < 2; ++c) { const float fr = c ? bfhi(w) : bflo(w);
                const float e = fexp2(fminf(-L2E * fr, 60.f)), r = frcp(1.f + e);
                const float f = (1.f + lb[2 * cp + c] * e) * r;
                kk[j][c] = valid ? oml[2 * cp + c] * e * r : 0.f;
                lf[j][c] = valid ? flog2(f) : 0.f; } }
#pragma unroll
        for (int j = 1; j < 4; ++j) { lf[j][0] += lf[j - 1][0]; lf[j][1] += lf[j - 1][1]; }
        float before[2], aref[2], e2[2];
#pragma unroll
        for (int c = 0; c < 2; ++c) { float x = lf[3][c];
#pragma unroll
            for (int d = 1; d < 16; d <<= 1) { const float y = lane_get(x, (lane - 4 * d) & 63); if (tg >= d) x += y; }
            before[c] = x - lf[3][c]; aref[c] = lane_get(x, 4 * (NG / 2 - 1) + kql); const float al = lane_get(x, 4 * (NG - 1) + kql);
            e2[c] = fexp2(al - aref[c]); R.dec[2 * cp + c] = fexp2(al); R.ear[2 * cp + c] = fexp2(aref[c]); }
        float kd[4][2];
#pragma unroll
        for (int j = 0; j < 4; ++j) { const unsigned w = cp ? qw[j].y : qw[j].x; float qt[2], kt[2];
#pragma unroll
            for (int c = 0; c < 2; ++c) { const float qv = c ? bfhi(w) : bflo(w);
                const float d = before[c] + lf[j][c] - aref[c];
                qt[c] = qv * fexp2(fminf(d, 100.f)); kt[c] = kk[j][c] * fexp2(fminf(-d, 100.f)); kd[j][c] = kt[c] * e2[c]; }
            if (cp) { R.qt[j].y = pkbf(qt[0], qt[1]); R.kt[j].y = pkbf(kt[0], kt[1]); } else { R.qt[j].x = pkbf(qt[0], qt[1]); R.kt[j].x = pkbf(kt[0], kt[1]); } }
#pragma unroll
        for (int c = 0; c < 2; ++c) { R.kd[2 * cp + c] = (v2u){pkbf(kd[0][c], kd[1][c]), pkbf(kd[2][c], kd[3][c])};
            unsigned e0, e1, e2b, e3;
            if (cp == 0) { if (c == 0) { e0 = iw[0].x & 0xffffu; e1 = iw[1].x & 0xffffu; e2b = iw[2].x & 0xffffu; e3 = iw[3].x & 0xffffu; } else { e0 = iw[0].x >> 16; e1 = iw[1].x >> 16; e2b = iw[2].x >> 16; e3 = iw[3].x >> 16; } }
            else { if (c == 0) { e0 = iw[0].y & 0xffffu; e1 = iw[1].y & 0xffffu; e2b = iw[2].y & 0xffffu; e3 = iw[3].y & 0xffffu; } else { e0 = iw[0].y >> 16; e1 = iw[1].y >> 16; e2b = iw[2].y >> 16; e3 = iw[3].y >> 16; } }
            R.iv[2 * cp + c] = (v2u){e0 | (e1 << 16), e2b | (e3 << 16)}; }
        __builtin_amdgcn_sched_barrier(0);
    }
}
template <int TT> DI void hg_final(LAS unsigned char* lds, int wave, int lane, const f32x4 (&o)[TT], const v2u (&ogw)[TT], const f32x4 og4, bf16* OB, int rowb, int h);
template <int TT, bool DEFER = false>
DI void hg_stage1(LAS unsigned char* lds, int wave, int lane, const HgRegs& R, f32x4 (&S)[8], f32x4 (&o)[TT], v2u (&ogw)[TT], const bf16* Z, int rowb, int h,
                  int pb = 0  , bool have_prev = false, const f32x4 og4 = (f32x4){0.f, 0.f, 0.f, 0.f}, bf16* OB = nullptr) {
    constexpr int CS = (TT == 4) ? 64 : 32, NG = CS / 4;
    const int bo = pb * HG_BUFSZ;
    const int kql = lane & 3, tg = lane >> 2, k0 = 16 * wave + 4 * kql, i = lane & 15, q = lane >> 4;
    if (tg < NG) {
#pragma unroll
        for (int j = 0; j < 4; ++j) { const int ro = (4 * tg + j) * HP + k0 * 2; *(LAS v2u*)(lds + HG_QT + ro) = R.qt[j]; *(LAS v2u*)(lds + HG_KT + ro) = R.kt[j]; }
#pragma unroll
        for (int c = 0; c < 4; ++c) { *(LAS v2u*)(lds + HG_KDT + bo + (k0 + c) * HPK + 8 * tg) = R.kd[c]; *(LAS v2u*)(lds + HG_IVT + (k0 + c) * HPK + 8 * tg) = R.iv[c]; }
        if (tg == 0) { *(LAS f32x4*)(lds + HG_DEC + bo + k0 * 4) = R.dec; *(LAS f32x4*)(lds + HG_EAR + k0 * 4) = R.ear; }
    }
    LDS_BARRIER();
    if (DEFER && have_prev) hg_final<TT>(lds, wave, lane, o, ogw, og4, OB, rowb - 16 * TT, h);
#pragma unroll
    for (int it = 0; it < TT; ++it) ogw[it] = (TT == 4 || i < 8) ? *(const v2u*)(Z + (size_t)(rowb + 16 * it + i) * NIN + ZOG + h * 128 + 16 * wave + 4 * q) : (v2u){0u, 0u};
    if (TT == 4 || wave == 0) {
        const int it = (TT == 4) ? (wave >> 1) : 0;
#pragma unroll
        for (int is2 = 0; is2 < 2; ++is2) { const int is = ((TT == 4) ? 2 * (wave & 1) : 0) + is2;
            f32x4 sc = {0.f, 0.f, 0.f, 0.f};
#pragma unroll
            for (int ks = 0; ks < 4; ++ks) { const bf16x8 X = *(const LAS bf16x8*)(lds + HG_KT + (16 * is + i) * HP + (32 * ks + 8 * q) * 2), Y = *(const LAS bf16x8*)(lds + HG_QT + (16 * it + i) * HP + (32 * ks + 8 * q) * 2);
                sc = MFMA16(X, Y, sc); }
            const int t = 16 * it + i, s0 = 16 * is + 4 * q;
            *(LAS v2u*)(lds + HG_P + bo + t * HPK + s0 * 2) = (v2u){pkbf(s0 <= t ? sc[0] : 0.f, s0 + 1 <= t ? sc[1] : 0.f), pkbf(s0 + 2 <= t ? sc[2] : 0.f, s0 + 3 <= t ? sc[3] : 0.f)};
        }
    }
    {
        bf16x8 Sf[4];
#pragma unroll
        for (int ks = 0; ks < 4; ++ks) { const f32x4 e0 = *(const LAS f32x4*)(lds + HG_EAR + (32 * ks + 4 * q) * 4), e1 = *(const LAS f32x4*)(lds + HG_EAR + (32 * ks + 16 + 4 * q) * 4);
            const f32x4 a0 = S[2 * ks] * e0, a1 = S[2 * ks + 1] * e1;
            v4u p; p.x = pkbf(a0[0], a0[1]); p.y = pkbf(a0[2], a0[3]); p.z = pkbf(a1[0], a1[1]); p.w = pkbf(a1[2], a1[3]); Sf[ks] = __builtin_bit_cast(bf16x8, p); }
#pragma unroll
        for (int it = 0; it < TT; ++it) { o[it] = (f32x4){0.f, 0.f, 0.f, 0.f};
#pragma unroll
            for (int ks = 0; ks < 4; ++ks) { const v2u lo = *(const LAS v2u*)(lds + HG_QT + (16 * it + i) * HP + (32 * ks + 4 * q) * 2), hi = *(const LAS v2u*)(lds + HG_QT + (16 * it + i) * HP + (32 * ks + 16 + 4 * q) * 2);
                const v4u y = {lo.x, lo.y, hi.x, hi.y}; o[it] = MFMA16(Sf[ks], __builtin_bit_cast(bf16x8, y), o[it]); } }
    }
    bf16x8 IVf[CS / 32];
#pragma unroll
    for (int ss = 0; ss < CS / 32; ++ss) IVf[ss] = *(const LAS bf16x8*)(lds + HG_IVT + (16 * wave + i) * HPK + (32 * ss + 8 * q) * 2);
    LDS_BARRIER();
#pragma unroll
    for (int it = 0; it < TT; ++it)
#pragma unroll
        for (int ss = 0; ss < CS / 32; ++ss) if (TT != 4 || ss <= (it >> 1)) { const bf16x8 Y = *(const LAS bf16x8*)(lds + HG_P + bo + (16 * it + i) * HPK + (32 * ss + 8 * q) * 2); o[it] = MFMA16(IVf[ss], Y, o[it]); }
#pragma unroll
    for (int a = 0; a < 8; ++a) { const f32x4 d = *(const LAS f32x4*)(lds + HG_DEC + bo + (16 * a + 4 * q) * 4); S[a] *= d;
#pragma unroll
        for (int ss = 0; ss < CS / 32; ++ss) { const bf16x8 X = *(const LAS bf16x8*)(lds + HG_KDT + bo + (16 * a + i) * HPK + (32 * ss + 8 * q) * 2); S[a] = MFMA16(X, IVf[ss], S[a]); } }
#pragma unroll
    for (int it = 0; it < TT; ++it) { float p = (o[it][0] * o[it][0] + o[it][1] * o[it][1]) + (o[it][2] * o[it][2] + o[it][3] * o[it][3]); p += lane_get(p, lane ^ 16); p += lane_get(p, lane ^ 32);
        if (q == 0) *(LAS float*)(lds + HG_PART + (wave * 64 + 16 * it + i) * 4) = p; }
}
template <int TT>
DI void hg_final(LAS unsigned char* lds, int wave, int lane, const f32x4 (&o)[TT], const v2u (&ogw)[TT], const f32x4 og4, bf16* OB, int rowb, int h) {
    const int i = lane & 15, q = lane >> 4;
#pragma unroll
    for (int it = 0; it < TT; ++it) { float tot = 0.f;
#pragma unroll
        for (int w = 0; w < 8; ++w) tot += *(const LAS float*)(lds + HG_PART + (w * 64 + 16 * it + i) * 4);
        const float rstd = frsq(tot * (1.f / 128.f) + EPS);
        if (TT == 4 || i < 8) { const v2u g = ogw[it];
            const float r0 = o[it][0] * rstd * og4[0] * bflo(g.x), r1 = o[it][1] * rstd * og4[1] * bfhi(g.x), r2 = o[it][2] * rstd * og4[2] * bflo(g.y), r3 = o[it][3] * rstd * og4[3] * bfhi(g.y);
            *(v2u*)(OB + (size_t)(rowb + 16 * it + i) * 2048 + h * 128 + 16 * wave + 4 * q) = (v2u){pkbf(r0, r1), pkbf(r2, r3)}; } }
}
template <int TT>
DI void hg_stage2(LAS unsigned char* lds, int wave, int lane, const f32x4 (&o)[TT], const v2u (&ogw)[TT], const f32x4 og4, bf16* OB, int rowb, int h) {
    LDS_BARRIER();
    hg_final<TT>(lds, wave, lane, o, ogw, og4, OB, rowb, h);
}
DI void hgrn_prompt_unit(LAS unsigned char* lds, int tid, int wave, int lane, const bf16* Z, bf16* OB, float* s_out,
                         const float* ogain  , const float* lbp  , int l, int h, int row0, int nblk) {
    asm volatile("" : "+v"(tid), "+v"(lane), "+s"(wave));
    const int kql = lane & 3, tg = lane >> 2, k0 = 16 * wave + 4 * kql, i = lane & 15, q = lane >> 4;
    float lb[4], oml[4];
#pragma unroll
    for (int c = 0; c < 4; ++c) { lb[c] = (l == 0) ? 0.f : sigm(lbp[2048 + h * 128 + k0 + c] - lbp[h * 128 + k0 + c]); oml[c] = 1.f - lb[c]; }
    f32x4 S[8];
#pragma unroll
    for (int a = 0; a < 8; ++a) S[a] = (f32x4){0.f, 0.f, 0.f, 0.f};
    const f32x4 og4 = *(const f32x4*)(ogain + 16 * wave + 4 * q);
    v2u qw[4], fw[4], iw[4]; HgRegs R;
    hg_load(Z, row0, h, k0, tg, true, qw, fw, iw);
    hg_elem<16>(qw, fw, iw, lb, oml, true, lane, tg, kql, R);
    if (nblk > 1) hg_load(Z, row0 + 64, h, k0, tg, true, qw, fw, iw);
    f32x4 o[4]; v2u ogw[4];
#pragma unroll
    for (int it = 0; it < 4; ++it) { o[it] = (f32x4){0.f, 0.f, 0.f, 0.f}; ogw[it] = (v2u){0u, 0u}; }
    for (int blk = 0; blk < nblk; ++blk) {
        const int rowb = row0 + blk * 64;
        hg_stage1<4, true>(lds, wave, lane, R, S, o, ogw, Z, rowb, h, blk & 1, blk > 0, og4, OB);
        if (blk + 1 < nblk) { hg_elem<16>(qw, fw, iw, lb, oml, true, lane, tg, kql, R);
            if (blk + 2 < nblk) hg_load(Z, rowb + 128, h, k0, tg, true, qw, fw, iw); }
    }
    hg_stage2<4>(lds, wave, lane, o, ogw, og4, OB, row0 + (nblk - 1) * 64, h);
    { float* sp = s_out + (size_t)(4 * q) * 128 + 16 * wave + i;
#pragma unroll
      for (int a = 0; a < 8; ++a) {
#pragma unroll
          for (int r = 0; r < 4; ++r) __builtin_nontemporal_store(S[a][r], sp + r * 128);
          sp += 16 * 128; } }
    LDS_BARRIER();
}
DI void hgrn_sample_loop(LAS unsigned char* lds, int tid, int wave, int lane, const bf16* Z, bf16* OB, const float* st_in  , float* st_out,
                         const float* hng  , const float* lbp, int l, int su0, int step) {
    asm volatile("" : "+v"(tid), "+v"(lane), "+s"(wave));
    if (su0 >= 2048) return;
    const int kql = lane & 3, tg = lane >> 2, k0 = 16 * wave + 4 * kql, i = lane & 15, q = lane >> 4;
    const bool valid = tg < 2;
    const size_t lo = (size_t)(16 * 0 + 4 * q) * 128 + 16 * wave + i;
    f32x4 A[8], B[8];
    v2u qw[4], fw[4], iw[4]; HgRegs R;
    auto ldstate = [&](f32x4 (&T)[8], int su) { const float* sp = st_in + (size_t)su * 16384 + lo;
#pragma unroll
        for (int a = 0; a < 8; ++a)
#pragma unroll
            for (int r = 0; r < 4; ++r) T[a][r] = __builtin_nontemporal_load(sp + (16 * a + r) * 128); };
    auto unit = [&](int su, f32x4 (&T)[8]) {
        const int h = su & 15, rowb = MP + (su >> 4) * 8, nsu = su + step, n2 = su + 2 * step;
        float lb[4], oml[4];
#pragma unroll
        for (int c = 0; c < 4; ++c) { lb[c] = (l == 0) ? 0.f : sigm(lbp[2048 + h * 128 + k0 + c] - lbp[h * 128 + k0 + c]); oml[c] = 1.f - lb[c]; }
        const f32x4 og4 = *(const f32x4*)(hng + h * 128 + 16 * wave + 4 * q);
        hg_elem<8>(qw, fw, iw, lb, oml, valid, lane, tg, kql, R);
        if (nsu < 2048) hg_load(Z, MP + (nsu >> 4) * 8, nsu & 15, k0, tg, valid, qw, fw, iw);
        f32x4 o[1]; v2u ogw[1];
        hg_stage1<1>(lds, wave, lane, R, T, o, ogw, Z, rowb, h);
        { float* sp = st_out + (size_t)su * 16384 + lo;
#pragma unroll
          for (int a = 0; a < 8; ++a)
#pragma unroll
              for (int r = 0; r < 4; ++r) __builtin_nontemporal_store(T[a][r], sp + (16 * a + r) * 128); }
        if (n2 < 2048) ldstate(T, n2);
        hg_stage2<1>(lds, wave, lane, o, ogw, og4, OB, rowb, h); };
    ldstate(A, su0);
    hg_load(Z, MP + (su0 >> 4) * 8, su0 & 15, k0, tg, valid, qw, fw, iw);
    if (su0 + step < 2048) ldstate(B, su0 + step);
    for (int su = su0; su < 2048; su += 2 * step) {
        unit(su, A);
        if (su + step < 2048) unit(su + step, B);
    }
    LDS_BARRIER();
}

constexpr int MX_VNT = 0, MX_W = 128 * HP, MX_END = 2 * 128 * HP;
static_assert(MX_END <= RING_BYTES, "mixer lds");
DI void mixer_unit(LAS unsigned char* lds, int tid, int wave, int lane, int tt, int g, const bf16* Z, bf16* YA, const float* wsp  , const float* bsp  , const float* vgp  , float* vout  ) {
    asm volatile("" : "+v"(tid), "+v"(lane), "+s"(wave));
    const int r0 = tt * 128; const bool sample = tt >= 64;
    {
        const int cq = tid & 31, sg = tid >> 5, c0 = 4 * cq;
        const f32x4 vg4 = *(const f32x4*)(vgp + c0);
        float vn[8][4];
#pragma unroll
        for (int j = 0; j < 8; ++j) { const int s = 8 * sg + j; const v2u w = *(const v2u*)(Z + (size_t)(r0 + s) * NIN + ZV + g * 128 + c0);
            const float x0 = bflo(w.x), x1 = bfhi(w.x), x2 = bflo(w.y), x3 = bfhi(w.y);
            float ss = (x0 * x0 + x1 * x1) + (x2 * x2 + x3 * x3);
            ss += lane_get(ss, lane ^ 1); ss += lane_get(ss, lane ^ 2); ss += lane_get(ss, lane ^ 4); ss += lane_get(ss, lane ^ 8); ss += lane_get(ss, lane ^ 16);
            const float rstd = frsq(ss * (1.f / 128.f) + EPS);
            vn[j][0] = x0 * rstd * vg4[0]; vn[j][1] = x1 * rstd * vg4[1]; vn[j][2] = x2 * rstd * vg4[2]; vn[j][3] = x3 * rstd * vg4[3];
            if (vout) *(f32x4*)(vout + (size_t)s * 1024 + c0) = (f32x4){vn[j][0], vn[j][1], vn[j][2], vn[j][3]}; }
#pragma unroll
        for (int c = 0; c < 4; ++c) { v4u p; p.x = pkbf(vn[0][c], vn[1][c]); p.y = pkbf(vn[2][c], vn[3][c]); p.z = pkbf(vn[4][c], vn[5][c]); p.w = pkbf(vn[6][c], vn[7][c]);
            *(LAS v4u*)(lds + MX_VNT + (c0 + c) * HP + 16 * sg) = p; }
    }
    {
        const int t = tid >> 2, sq = tid & 3;
#pragma unroll
        for (int jj = 0; jj < 4; ++jj) { const int s0 = sq * 32 + 8 * jj; float x[8];
            if (!sample) { const f32x4 a = *(const f32x4*)(wsp + t * 128 + s0), b = *(const f32x4*)(wsp + t * 128 + s0 + 4);
                x[0] = a[0]; x[1] = a[1]; x[2] = a[2]; x[3] = a[3]; x[4] = b[0]; x[5] = b[1]; x[6] = b[2]; x[7] = b[3];
#pragma unroll
                for (int e = 0; e < 8; ++e) x[e] = (s0 + e <= t) ? x[e] : 0.f; }
            else {
#pragma unroll
                for (int e = 0; e < 8; ++e) { const int s = s0 + e; x[e] = ((s >> 3) == (t >> 3) && (s & 7) <= (t & 7)) ? wsp[(t & 7) * 128 + (s & 7)] : 0.f; } }
            v4u p; p.x = pkbf(x[0], x[1]); p.y = pkbf(x[2], x[3]); p.z = pkbf(x[4], x[5]); p.w = pkbf(x[6], x[7]);
            *(LAS v4u*)(lds + MX_W + t * HP + s0 * 2) = p; }
    }
    LDS_BARRIER();
    const int i = lane & 15, q = lane >> 4;
    f32x4 acc[8];
#pragma unroll
    for (int ct = 0; ct < 8; ++ct) acc[ct] = (f32x4){0.f, 0.f, 0.f, 0.f};
    const int nks = (wave >> 1) + 1;
    for (int ks = 0; ks < nks; ++ks) { const bf16x8 Y = *(const LAS bf16x8*)(lds + MX_W + (16 * wave + i) * HP + (32 * ks + 8 * q) * 2);
#pragma unroll
        for (int ct = 0; ct < 8; ++ct) { const bf16x8 X = *(const LAS bf16x8*)(lds + MX_VNT + (16 * ct + i) * HP + (32 * ks + 8 * q) * 2); acc[ct] = MFMA16(X, Y, acc[ct]); } }
    const int t = 16 * wave + i; const float bias = bsp[sample ? (t & 7) : t];
#pragma unroll
    for (int ct = 0; ct < 8; ++ct) { const int c = g * 128 + 16 * ct + 4 * q; const v2u uw = *(const v2u*)(Z + (size_t)(r0 + t) * NIN + ZU + c);
        const float y0 = bflo(uw.x) * (acc[ct][0] + bias), y1 = bfhi(uw.x) * (acc[ct][1] + bias), y2 = bflo(uw.y) * (acc[ct][2] + bias), y3 = bfhi(uw.y) * (acc[ct][3] + bias);
        *(v2u*)(YA + (size_t)(r0 + t) * 1024 + c) = (v2u){pkbf(y0, y1), pkbf(y2, y3)}; }
    LDS_BARRIER();
}

constexpr int MD_PITCH = 144, MD_WT = 0, MD_AS = 128 * MD_PITCH, MD_BUF = MD_AS + 144 * MD_PITCH;
static_assert(2 * MD_BUF <= RING_BYTES, "mod lds");
DI void mod_direct(LAS unsigned char* lds, int tid, int wave, int lane, int slab, const float* cp, const float* cs, const float* adaw, const float* adab, float* MOD) {
    asm volatile("" : "+v"(tid), "+v"(lane), "+s"(wave));
    const int n0g = slab * 128, l = n0g / 12288, n0 = n0g - l * 12288, i = lane & 15, q = lane >> 4;
    const int wn = tid & 127, wk = tid >> 7;
    const float* W = adaw + (size_t)l * 2048 * 12288 + n0 + wn + (size_t)(16 * wk) * 12288;
    float wv[2][16]; f32x4 av[2][5];
    f32x4 acc[9];
#pragma unroll
    for (int mt = 0; mt < 9; ++mt) acc[mt] = (f32x4){0.f, 0.f, 0.f, 0.f};
#define MD_LOAD(kc, B) do { \
        _Pragma("unroll") for (int kk = 0; kk < 16; ++kk) wv[B][kk] = __builtin_nontemporal_load(W + (size_t)(64 * (kc) + kk) * 12288); \
        _Pragma("unroll") for (int ii = 0; ii < 5; ++ii) { const int idx = tid + 512 * ii, row = idx >> 4, c4 = idx & 15; \
            av[B][ii] = (f32x4){0.f, 0.f, 0.f, 0.f}; \
            if (idx < 2304 && row < NCOND) av[B][ii] = *(const f32x4*)((row < 4 ? cp + (size_t)row * DM : cs + (size_t)(row - 4) * DM) + 64 * (kc) + 4 * c4); } } while (0)
#define MD_STEP(kc, B) do { \
        LAS unsigned char* buf = lds + ((kc) & 1) * MD_BUF; \
        { v4u p0, p1; p0.x = pkbf(wv[B][0], wv[B][1]); p0.y = pkbf(wv[B][2], wv[B][3]); p0.z = pkbf(wv[B][4], wv[B][5]); p0.w = pkbf(wv[B][6], wv[B][7]); \
          p1.x = pkbf(wv[B][8], wv[B][9]); p1.y = pkbf(wv[B][10], wv[B][11]); p1.z = pkbf(wv[B][12], wv[B][13]); p1.w = pkbf(wv[B][14], wv[B][15]); \
          *(LAS v4u*)(buf + MD_WT + wn * MD_PITCH + 32 * wk) = p0; *(LAS v4u*)(buf + MD_WT + wn * MD_PITCH + 32 * wk + 16) = p1; } \
        _Pragma("unroll") for (int ii = 0; ii < 5; ++ii) { const int idx = tid + 512 * ii, row = idx >> 4, c4 = idx & 15; \
            if (idx < 2304) { const f32x4 v = av[B][ii]; \
                *(LAS v2u*)(buf + MD_AS + row * MD_PITCH + 8 * c4) = (v2u){pkbf(v[0] * sigm(v[0]), v[1] * sigm(v[1])), pkbf(v[2] * sigm(v[2]), v[3] * sigm(v[3]))}; } } \
        if ((kc) + 2 < 32) MD_LOAD((kc) + 2, B); \
        LDS_BARRIER(); \
        { bf16x8 X[2]; \
          _Pragma("unroll") for (int ks = 0; ks < 2; ++ks) X[ks] = *(const LAS bf16x8*)(buf + MD_WT + (16 * wave + i) * MD_PITCH + (32 * ks + 8 * q) * 2); \
          _Pragma("unroll") for (int mt = 0; mt < 9; ++mt) \
              _Pragma("unroll") for (int ks = 0; ks < 2; ++ks) { const bf16x8 Y = *(const LAS bf16x8*)(buf + MD_AS + (16 * mt + i) * MD_PITCH + (32 * ks + 8 * q) * 2); acc[mt] = MFMA16(X[ks], Y, acc[mt]); } } } while (0)
    MD_LOAD(0, 0); MD_LOAD(1, 1);
    for (int kc = 0; kc < 32; kc += 2) { MD_STEP(kc, 0); MD_STEP(kc + 1, 1); }
#undef MD_STEP
#undef MD_LOAD
    { const int n = n0g + 16 * wave + 4 * q; const f32x4 bias = *(const f32x4*)(adab + n);
#pragma unroll
      for (int mt = 0; mt < 9; ++mt) { const int cb = 16 * mt + i; if (cb < NCOND) *(f32x4*)(MOD + (size_t)cb * MODP + n) = acc[mt] + bias; } }
    LDS_BARRIER();
}

__global__ void __launch_bounds__(NWAVES * 64, 2) mk_fwd(Args args) {
    extern __shared__ __attribute__((aligned(16))) unsigned char lds_raw[];
    LAS unsigned char* lds = (LAS unsigned char*)lds_raw;
    volatile LAS unsigned* MISC = (volatile LAS unsigned*)(lds + MISC_OFF);
    const int wv0 = __builtin_amdgcn_readfirstlane((int)(threadIdx.x >> 6));
#define IDS() int tid = wv0 * 64 + hw_lane(); asm volatile("" : "+v"(tid)); const int lane = tid & 63, wave = __builtin_amdgcn_readfirstlane(tid >> 6), gw = vcu * NWAVES + wave; (void)lane; (void)gw
    const int G = gridDim.x, bx = blockIdx.x;
    const int vcu = (G % 8 == 0) ? (bx % 8) * (G / 8) + bx / 8 : bx;
    const int NGW = G * NWAVES;
    unsigned char* ws = args.ws;
    gu32* ctl = (gu32*)(ws + WS_CTL);
    for (int u = wv0 * 64 + hw_lane(); u < (LDS_BYTES - LDSCTL_OFF) / 4; u += NWAVES * 64) ((LAS unsigned*)(lds + LDSCTL_OFF))[u] = 0u;
    __syncthreads();
    XcdBarrier bar = xcd_barrier_post((unsigned*)(ctl + CW_BAR), MISC + 8, wv0);
#define GRID_BAR() do { XcdBarrier b_ = bar; int z_ = 0; asm volatile("" : "+s"(z_), "+s"(b_.x)); b_.bar += z_; xcd_barrier(b_); } while (0)

    float* MOD = (float*)(ws + WS_MOD);
    bf16* X = (bf16*)(ws + WS_X); bf16* H = (bf16*)(ws + WS_H); bf16* Z = (bf16*)(ws + WS_Z); bf16* UP = Z;
    bf16* YA = (bf16*)(ws + WS_YA); bf16* OB = (bf16*)(ws + WS_O); bf16* Y = (bf16*)(ws + WS_Y); bf16* ACT = (bf16*)(ws + WS_ACT);
    float* out = args.out; bf16* SLAB = (bf16*)(ws + WS_SLAB); bf16* Xs = X + (size_t)MP * DM;

    {
        IDS();
        for (int slab = bx; slab < 192; slab += G) mod_direct(lds, tid, wave, lane, slab, inp(args, I_CP), inp(args, I_CS), inp(args, I_ADAW), inp(args, I_ADAB), MOD);
        LAS float* scr = (LAS float*)(lds + RING_OFF + wave * 16384);
        constexpr int IT_IN = 32 * 448, IT_BA = 16 * 64, IT_BB = 32 * 64, IT_OUT = 32 * 64, IT_UP = 32 * 352, IT_DN = 88 * 64;
        constexpr int IT_L = IT_IN + IT_BA + IT_BB + IT_OUT + IT_UP + IT_DN;
        for (int it = gw; it < 2 * IT_L; it += NGW) {
            const int l = it / IT_L; int r = it - l * IT_L;
            if (r < IT_IN) { p0_transpose_item(inp(args, I_WIN) + (size_t)l * 2048 * NIN, NIN, (bf16*)(ws + WS_WIN + l * SZ_WIN), 2048, 0, scr, r, lane); continue; } r -= IT_IN;
            if (r < IT_BA) { p0_transpose_item(inp(args, I_WBA) + (size_t)l * 1024 * 2048, 2048, (bf16*)(ws + WS_WBA + l * SZ_WBA), 1024, 0, scr, r, lane); continue; } r -= IT_BA;
            if (r < IT_BB) { p0_transpose_item(inp(args, I_WBB) + (size_t)l * 2048 * 2048, 2048, (bf16*)(ws + WS_WBB + l * SZ_WBB), 2048, 0, scr, r, lane); continue; } r -= IT_BB;
            if (r < IT_OUT) { p0_transpose_item(inp(args, I_WOUT) + (size_t)l * 2048 * 2048, 2048, (bf16*)(ws + WS_WOUT + l * SZ_WOUT), 2048, 0, scr, r, lane); continue; } r -= IT_OUT;
            if (r < IT_UP) { p0_transpose_item(inp(args, I_WUP) + (size_t)l * 2048 * NUP, NUP, (bf16*)(ws + WS_WUP + l * SZ_WUP), 2048, 0, scr, r, lane); continue; } r -= IT_UP;
            p0_transpose_item(inp(args, I_WDN) + (size_t)l * DFF * 2048, 2048, (bf16*)(ws + WS_WDN + l * SZ_WDN), DFF, 0, scr, r, lane);
        }
    }
    GRID_BAR();

    for (int l = 0; l < 2; ++l) {
        int bxl = blockIdx.x; asm volatile("" : "+s"(bxl));
        const float* modl = MOD + (size_t)l * 12288;
        const void* xin_p = (l == 0) ? (const void*)inp(args, I_XP) : (const void*)X; const void* xin_s = (l == 0) ? (const void*)inp(args, I_XS) : (const void*)Xs;
        { IDS(); norm_rows<false>(xin_p, xin_s, l != 0, l != 0, inp(args, I_N1) + l * DM, modl, H, nullptr, gw, NGW, lane, (l == 0) ? nullptr : SLAB, MOD + 5 * DM  , Xs, lds); }
        GRID_BAR();
        {
            pg8::Gemm g{H, (const bf16*)(ws + WS_WIN + l * SZ_WIN), MT, 40 * 256, DM}; pg8::StaticOrder S; S.init(MT, 40 * 256, DM, G, bxl);
            pg8::EpiZ E{Z, NIN, 0};
            pg8::gemm_phase<pg8::EpiZ, pg8::StaticOrder, true, true>(lds + RING_OFF, g, S, E, wv0);
        }
        GRID_BAR();
        {
            IDS();
            const float* hng = inp(args, I_HNG) + l * 2048; const float* lbp = inp(args, I_LB);
            for (int pu = bxl; pu < 64; pu += G) { const int b = pu >> 4, h = pu & 15;
                hgrn_prompt_unit(lds, tid, wave, lane, Z, OB, out + O_HP + ((size_t)(l * 4 + b) * 16 + h) * 16384, hng + h * 128, lbp, l, h, b * 2048, 32); }
            const int nb = (G > 64) ? G - 64 : G, jb = (G > 64) ? bxl - 64 : bxl;
            if (jb >= 0) for (int step = 0; step < 2; ++step) {
                if (((step ^ jb) & 1) == 0) {
                    pg8::Gemm g{H, (const bf16*)(ws + WS_WIN + l * SZ_WIN) + (size_t)40 * 256 * DM, MT, 16 * 256, DM}; pg8::StaticOrder S; S.init(MT, 16 * 256, DM, nb, jb);
                    pg8::EpiZ E{Z, NIN, 40};
                    pg8::gemm_phase<pg8::EpiZ, pg8::StaticOrder, true, true>(lds + RING_OFF, g, S, E, wv0);
                    continue;
                }
                hgrn_sample_loop(lds, tid, wave, lane, Z, OB, inp(args, I_SH) + (size_t)l * 2048 * 16384, out + O_HS + (size_t)l * 2048 * 16384, hng, lbp, l, jb, nb);
                for (int mu = jb; mu < 576; mu += nb) { const int tt = mu % 72, g = mu / 72;
                    float* vout = nullptr;
                    if (tt >= 64) vout = out + O_VS + ((size_t)l * 1024 + (size_t)(tt - 64) * 128) * 1024 + g * 128;
                    else if ((tt & 15) == 15) vout = out + O_VP + ((size_t)(l * 4 + (tt >> 4)) * 128) * 1024 + g * 128;
                    mixer_unit(lds, tid, wave, lane, tt, g, Z, YA, inp(args, I_WS) + (size_t)(l * 8 + g) * 16384, inp(args, I_BS) + (l * 8 + g) * 128, inp(args, I_VG) + l * 1024 + g * 128, vout); }
            }
        }
        GRID_BAR();
        {
            { pg8::SplitOrder S; S.init(1024, 4, G, bxl); pg8::Gemm g{YA, (const bf16*)(ws + WS_WBA + l * SZ_WBA), MT, DM, 1024};
              pg8::EpiSplit<pg8::EpiBranch<false>> E{{Z + ZGA, Y}, SLAB};
              pg8::gemm_phase<pg8::EpiSplit<pg8::EpiBranch<false>>, pg8::SplitOrder, true, true>(lds + RING_OFF, g, S, E, wv0); }
            { pg8::SplitOrder S; S.init(2048, 8, G, bxl); pg8::Gemm g{OB, (const bf16*)(ws + WS_WBB + l * SZ_WBB), MT, DM, 2048};
              pg8::EpiSplit<pg8::EpiBranch<true>> E{{Z + ZGB, Y}, SLAB + 4 * pg8::SLAB_ELEMS};
              pg8::gemm_phase<pg8::EpiSplit<pg8::EpiBranch<true>>, pg8::SplitOrder, true, true>(lds + RING_OFF, g, S, E, wv0); }
        }
        GRID_BAR();
        { IDS();
        for (int it = gw; it < 2 * MS; it += NGW) { const int r = it >> 1, c0 = (it & 1) * 1024 + 8 * lane;
            f32x4 a[2][2], b[2][2];
#pragma unroll
            for (int h = 0; h < 2; ++h) { a[h][0] = (f32x4){0.f, 0.f, 0.f, 0.f}; a[h][1] = a[h][0]; b[h][0] = a[h][0]; b[h][1] = a[h][0]; }
            v4u w[12][2];
#pragma unroll
            for (int s2 = 0; s2 < 12; ++s2)
#pragma unroll
                for (int h = 0; h < 2; ++h) w[s2][h] = *(const v4u*)(SLAB + (size_t)s2 * pg8::SLAB_ELEMS + (size_t)r * DM + c0 + 512 * h);
            const bf16* zr = Z + (size_t)(MP + r) * NIN + c0;
            v4u ga[2], gb[2];
#pragma unroll
            for (int h = 0; h < 2; ++h) { ga[h] = *(const v4u*)(zr + ZGA + 512 * h); gb[h] = *(const v4u*)(zr + ZGB + 512 * h); }
#pragma unroll
            for (int s2 = 0; s2 < 12; ++s2)
#pragma unroll
                for (int h = 0; h < 2; ++h) { const v4u x = w[s2][h]; const f32x4 lo = {bflo(x.x), bfhi(x.x), bflo(x.y), bfhi(x.y)}, hi = {bflo(x.z), bfhi(x.z), bflo(x.w), bfhi(x.w)};
                    if (s2 < 4) { a[h][0] += lo; a[h][1] += hi; } else { b[h][0] += lo; b[h][1] += hi; } }
#pragma unroll
            for (int h = 0; h < 2; ++h) { const v4u p = ga[h], q = gb[h];
                const f32x4 gal = {bflo(p.x), bfhi(p.x), bflo(p.y), bfhi(p.y)}, gah = {bflo(p.z), bfhi(p.z), bflo(p.w), bfhi(p.w)}, gbl = {bflo(q.x), bfhi(q.x), bflo(q.y), bfhi(q.y)}, gbh = {bflo(q.z), bfhi(q.z), bflo(q.w), bfhi(q.w)};
                const f32x4 yl = gal * a[h][0] + gbl * b[h][0], yh = gah * a[h][1] + gbh * b[h][1];
                v4u o; o.x = pkbf(yl.x, yl.y); o.y = pkbf(yl.z, yl.w); o.z = pkbf(yh.x, yh.y); o.w = pkbf(yh.z, yh.w);
                *(v4u*)(Y + (size_t)(MP + r) * DM + c0 + 512 * h) = o; } } }
        GRID_BAR();
        {
            pg8::SplitOrder S; S.init(DM, 8, G, bxl); pg8::Gemm g{Y, (const bf16*)(ws + WS_WOUT + l * SZ_WOUT), MT, DM, DM};
            pg8::EpiSplit<pg8::EpiResid> E{{(const float*)xin_p, X, modl + 2 * DM, l == 0}, SLAB};
            pg8::gemm_phase<pg8::EpiSplit<pg8::EpiResid>, pg8::SplitOrder, true, true>(lds + RING_OFF, g, S, E, wv0);
        }
        GRID_BAR();
        { IDS(); norm_rows<false>(X, xin_s, true, l != 0, inp(args, I_N2) + l * DM, modl + 3 * DM, H, nullptr, gw, NGW, lane, SLAB, modl + 2 * DM, Xs, lds); }
        GRID_BAR();
        {
            pg8::Gemm g{H, (const bf16*)(ws + WS_WUP + l * SZ_WUP), MT, NUP, DM}; pg8::UpOrder S; S.init(G, bxl);
            pg8::EpiUpSplit E{{UP, out + O_CP + (size_t)l * 4 * 2 * NUP, out + O_CS + (size_t)l * 128 * 2 * NUP}, SLAB};
            pg8::gemm_phase<pg8::EpiUpSplit, pg8::UpOrder, true, true>(lds + RING_OFF, g, S, E, wv0);
        }
        GRID_BAR();
        {
            const float* cw = inp(args, I_CW) + (size_t)l * 3 * NUP; const float* cbias = inp(args, I_CB) + (size_t)l * NUP; const float* cst = inp(args, I_SC) + (size_t)l * 128 * 2 * NUP;
            IDS();
            constexpr int NWC = DFF / 512, NRG = MT / 8, NSB = 4;
            const int nseg = NGW / NWC;
            if (gw < nseg * NWC) {
                const int wcb = gw % NWC, sg = gw / NWC, col = (wcb * 64 + lane) * 8;
                constexpr int NPR = MP / 8, NSR = MS / 8;
                const bool wdeal = nseg > NSR && 5 * NSR < NPR;
                const int pr0 = wdeal ? (sg < NSR ? 5 * sg : 5 * NSR + ((sg - NSR) * (NPR - 5 * NSR)) / (nseg - NSR)) : (sg * NPR) / nseg;
                const int pr1 = wdeal ? (sg < NSR ? 5 * sg + 5 : 5 * NSR + ((sg + 1 - NSR) * (NPR - 5 * NSR)) / (nseg - NSR)) : ((sg + 1) * NPR) / nseg;
                float wa[3][8], wb[3][8], ba[8], bb[8];
#pragma unroll
                for (int k = 0; k < 3; ++k) { const f32x4 a0 = *(const f32x4*)(cw + k * NUP + col), a1 = *(const f32x4*)(cw + k * NUP + col + 4), b0 = *(const f32x4*)(cw + k * NUP + DFF + col), b1 = *(const f32x4*)(cw + k * NUP + DFF + col + 4);
#pragma unroll
                    for (int e = 0; e < 4; ++e) { wa[k][e] = a0[e]; wa[k][4 + e] = a1[e]; wb[k][e] = b0[e]; wb[k][4 + e] = b1[e]; } }
                { const f32x4 a0 = *(const f32x4*)(cbias + col), a1 = *(const f32x4*)(cbias + col + 4), b0 = *(const f32x4*)(cbias + DFF + col), b1 = *(const f32x4*)(cbias + DFF + col + 4);
#pragma unroll
                  for (int e = 0; e < 4; ++e) { ba[e] = a0[e]; ba[4 + e] = a1[e]; bb[e] = b0[e]; bb[4 + e] = b1[e]; } }
                const bool slabcols = col >= 2560;
                for (int part = 0;; ++part) {
                int rg0 = pr0, rg1 = pr1;
                if (part > 0) { const int srg = sg + (part - 1) * nseg; if (srg >= NSR) break; rg0 = NPR + srg; rg1 = rg0 + 1; }
                for (int rs = rg0; rs < rg1;) {
                    float pa2[8], pa1[8], pb2[8], pb1[8];
                    const int rb = rs * 8;
                    int re = rs + 1;
                    if (rb >= MP) { const float* s0 = cst + (size_t)((rb - MP) >> 3) * 2 * NUP + col;
#pragma unroll
                        for (int e = 0; e < 8; ++e) { pa2[e] = s0[e]; pa1[e] = s0[NUP + e]; pb2[e] = s0[DFF + e]; pb1[e] = s0[NUP + DFF + e]; } }
                    else {
                        re = ((rs >> 8) + 1) << 8; re = re < rg1 ? re : rg1;
                        if ((rb & 2047) == 0) {
#pragma unroll
                            for (int e = 0; e < 8; ++e) { pa2[e] = 0.f; pa1[e] = 0.f; pb2[e] = 0.f; pb1[e] = 0.f; } }
                        else { const v4u a2 = *(const v4u*)(UP + (size_t)(rb - 2) * NUP + col), a1 = *(const v4u*)(UP + (size_t)(rb - 1) * NUP + col), b2 = *(const v4u*)(UP + (size_t)(rb - 2) * NUP + DFF + col), b1 = *(const v4u*)(UP + (size_t)(rb - 1) * NUP + DFF + col);
#pragma unroll
                            for (int e = 0; e < 4; ++e) { pa2[2 * e] = bflo(a2[e]); pa2[2 * e + 1] = bfhi(a2[e]); pa1[2 * e] = bflo(a1[e]); pa1[2 * e + 1] = bfhi(a1[e]);
                                pb2[2 * e] = bflo(b2[e]); pb2[2 * e + 1] = bfhi(b2[e]); pb1[2 * e] = bflo(b1[e]); pb1[2 * e + 1] = bfhi(b1[e]); } } }
                    for (int rg = rs; rg < re; ++rg) {
                    const int r0 = rg * 8;
                    const bool fromslab = (r0 >= MP) && slabcols;
                    if (!fromslab) {
#pragma unroll
                        for (int jb = 0; jb < 8; jb += 8) {
                        v4u avr[8], bvr[8];
#pragma unroll
                        for (int j = 0; j < 8; ++j) { avr[j] = *(const v4u*)(UP + (size_t)(r0 + jb + j) * NUP + col); bvr[j] = *(const v4u*)(UP + (size_t)(r0 + jb + j) * NUP + DFF + col); }
#pragma unroll
                        for (int jj = 0; jj < 8; ++jj) { const int j = jb + jj; float ca[8], cb2[8], res[8];
#pragma unroll
                            for (int e = 0; e < 4; ++e) { ca[2 * e] = bflo(avr[jj][e]); ca[2 * e + 1] = bfhi(avr[jj][e]); cb2[2 * e] = bflo(bvr[jj][e]); cb2[2 * e + 1] = bfhi(bvr[jj][e]); }
#pragma unroll
                            for (int e = 0; e < 8; ++e) { const float a = ba[e] + wa[0][e] * pa2[e] + wa[1][e] * pa1[e] + wa[2][e] * ca[e]; const float b = bb[e] + wb[0][e] * pb2[e] + wb[1][e] * pb1[e] + wb[2][e] * cb2[e];
                                res[e] = gelu_t(a) * b; pa2[e] = pa1[e]; pa1[e] = ca[e]; pb2[e] = pb1[e]; pb1[e] = cb2[e]; }
                            v4u w; w.x = pkbf(res[0], res[1]); w.y = pkbf(res[2], res[3]); w.z = pkbf(res[4], res[5]); w.w = pkbf(res[6], res[7]);
                            *(v4u*)(ACT + (size_t)(r0 + j) * DFF + col) = w; }
                        asm volatile("" ::: "memory"); }
                    } else
#pragma unroll
                    for (int jb = 0; jb < 8; jb += NSB) {
                        v4u avs[NSB], sls[NSB][4];
#pragma unroll
                        for (int jj = 0; jj < NSB; ++jj) { avs[jj] = *(const v4u*)(UP + (size_t)(r0 + jb + jj) * NUP + col);
                            const bf16* sp = SLAB + (size_t)(r0 - MP + jb + jj) * 3072 + (col - 2560);
#pragma unroll
                            for (int q = 0; q < 4; ++q) sls[jj][q] = *(const v4u*)(sp + q * pg8::UPSLAB_ELEMS); }
#pragma unroll
                        for (int jj = 0; jj < NSB; ++jj) { const int j = jb + jj; const v4u av = avs[jj];
                        float ca[8], cb2[8], res[8];
#pragma unroll
                        for (int e = 0; e < 4; ++e) { ca[2 * e] = bflo(av[e]); ca[2 * e + 1] = bfhi(av[e]); }
                        { f32x4 s0 = {0.f, 0.f, 0.f, 0.f}, s1 = s0;
#pragma unroll
                          for (int q = 0; q < 4; ++q) { const v4u w = sls[jj][q]; s0 += (f32x4){bflo(w.x), bfhi(w.x), bflo(w.y), bfhi(w.y)}; s1 += (f32x4){bflo(w.z), bfhi(w.z), bflo(w.w), bfhi(w.w)}; }
#pragma unroll
                          for (int e = 0; e < 4; ++e) { cb2[e] = s0[e]; cb2[4 + e] = s1[e]; }
                          if (j >= 6) { float* fo = out + O_CS + (size_t)l * 128 * 2 * NUP + (size_t)(((r0 - MP) >> 3) * 2 + (j - 6)) * NUP + DFF + col; *(f32x4*)fo = s0; *(f32x4*)(fo + 4) = s1; } }
#pragma unroll
                        for (int e = 0; e < 8; ++e) { const float a = ba[e] + wa[0][e] * pa2[e] + wa[1][e] * pa1[e] + wa[2][e] * ca[e]; const float b = bb[e] + wb[0][e] * pb2[e] + wb[1][e] * pb1[e] + wb[2][e] * cb2[e];
                            res[e] = gelu_t(a) * b; pa2[e] = pa1[e]; pa1[e] = ca[e]; pb2[e] = pb1[e]; pb1[e] = cb2[e]; }
                        v4u w; w.x = pkbf(res[0], res[1]); w.y = pkbf(res[2], res[3]); w.z = pkbf(res[4], res[5]); w.w = pkbf(res[6], res[7]);
                        *(v4u*)(ACT + (size_t)(r0 + j) * DFF + col) = w; }
                        asm volatile("" ::: "memory"); }
                    }
                    rs = re;
                }
                }
            }
        }
        GRID_BAR();
        {
            pg8::Gemm g{ACT, (const bf16*)(ws + WS_WDN + l * SZ_WDN), MT, DM, DFF}; pg8::SplitOrder S; S.init(DFF, 8, G, bxl);
            pg8::EpiSplit<pg8::EpiResid> E{{nullptr, X, modl + 5 * DM, false}, SLAB};
            pg8::gemm_phase<pg8::EpiSplit<pg8::EpiResid>, pg8::SplitOrder, true, true>(lds + RING_OFF, g, S, E, wv0);
        }
        GRID_BAR();
    }
    { IDS(); norm_rows<true>(X, Xs, true, true, inp(args, I_FNG), nullptr, nullptr, out, gw, NGW, lane, SLAB, MOD + 12288 + 5 * DM  , nullptr, lds); }
}

extern "C" void kernel_launch(void* const* d_in, const int* in_sizes, int n_in, void* d_out, int out_size, void* d_ws, size_t ws_size, hipStream_t stream) {
    static int grid = 0;
    if (grid == 0) {
        if (n_in != 24 || (size_t)out_size != O_END || ws_size < WS_END) { fprintf(stderr, "kernel_launch: unexpected shapes (n_in %d, out %d, ws %zu); nothing launched\n", n_in, out_size, ws_size); grid = -1; return; }
        int dev = 0, cus = 0, per_cu = 0;
        if (hipGetDevice(&dev) != hipSuccess || hipDeviceGetAttribute(&cus, hipDeviceAttributeMultiprocessorCount, dev) != hipSuccess) { grid = -1; return; }
        if (hipFuncSetAttribute((const void*)mk_fwd, hipFuncAttributeMaxDynamicSharedMemorySize, LDS_BYTES) != hipSuccess) { fprintf(stderr, "kernel_launch: hipFuncSetAttribute failed\n"); grid = -1; return; }
        if (hipOccupancyMaxActiveBlocksPerMultiprocessor(&per_cu, (const void*)mk_fwd, NWAVES * 64, LDS_BYTES) != hipSuccess || per_cu < 1) { fprintf(stderr, "kernel_launch: occupancy query reports %d blocks per CU\n", per_cu); }
        (void)hipGetLastError();
        grid = cus;
    }
    if (grid < 0) return;
    if (hipMemsetAsync((char*)d_ws + WS_CTL, 0, CTL_ZERO_BYTES, stream) != hipSuccess) return;
    Args a{};
    for (int i = 0; i < 24; ++i) a.in[i] = (const float*)d_in[i];
    a.out = (float*)d_out; a.ws = (unsigned char*)d_ws;
    hipLaunchKernelGGL(mk_fwd, dim3(grid), dim3(NWAVES * 64), LDS_BYTES, stream, a);
}
```

```cpp
#include <hip/hip_runtime.h>
#include <cstdio>
#include <cstdint>
__device__ __forceinline__ int hw_lane() { int l; asm volatile("v_mbcnt_lo_u32_b32 %0, -1, 0\n\tv_mbcnt_hi_u32_b32 %0, -1, %0" : "=v"(l)); return l; }
namespace pg8 {
#define PG8_LAS __attribute__((address_space(3)))
typedef unsigned short bf16_t;
typedef short bf16x8 __attribute__((ext_vector_type(8)));
typedef float f32x4 __attribute__((ext_vector_type(4)));
typedef unsigned u32x4 __attribute__((ext_vector_type(4)));
constexpr int BM = 256, BK = 64, HALF = 128, HTB = HALF * BK * 2  , STAGE_BYTES = 8 * HTB, NXCD = 8, WGM = 4;

__host__ __device__ __forceinline__ int lds_byte(int r, int c) { const int st = (r >> 4) * 2 + (c >> 5), rr = r & 15, cc = c & 31, ob = rr * 64 + cc * 2; return st * 1024 + (ob ^ (((ob >> 9) & 1) << 5)); }
__host__ __device__ __forceinline__ void stage_rc(int b, int& R, int& C) { const int st = b / 1024, sb = b % 1024, swz = sb ^ (((sb >> 9) & 1) << 5); R = (st >> 1) * 16 + swz / 64; C = (st & 1) * 32 + (swz % 64) / 2; }
__host__ __device__ __forceinline__ int perm32(int rho) { const int n = rho >> 4, i = rho & 15; return 8 * (i >> 2) + 4 * n + (i & 3); }

struct Unit { int pm, pn, kt0, nkt, aux; };
struct Gemm { const bf16_t* A; const bf16_t* Bt; int M, N, K; };

struct StaticOrder {
    static constexpr bool PARTS = false;
    int nM, nN, nwg, G, c, nkt;
    __host__ __device__ __forceinline__ void init(int M, int N, int K, int G_, int c_) { nM = M / BM; nN = N / BM; nwg = nM * nN; G = G_; c = c_; nkt = K / BK; }
    __host__ __device__ __forceinline__ bool next(int i, Unit& u) const {
        const long L = (long)i * G + c; if (L >= nwg) return false;
        int wgid = (int)L; { const int q = nwg / NXCD, r = nwg % NXCD, xcd = wgid % NXCD, off = wgid / NXCD; wgid = (xcd < r ? xcd * (q + 1) : r * (q + 1) + (xcd - r) * q) + off; }
        const int nig = WGM * nN, gid = wgid / nig, fm = gid * WGM, gsz = (nM - fm) < WGM ? (nM - fm) : WGM;
        u.pm = fm + ((wgid % nig) % gsz); u.pn = (wgid % nig) / gsz; u.kt0 = 0; u.nkt = nkt; u.aux = -1; return true;
    }
    __device__ __forceinline__ void a_ready(const Unit&) const {}
    __device__ __forceinline__ void done(const Unit&) const {}
};

__device__ __forceinline__ unsigned cvt_pk_bf16(float lo, float hi) { unsigned r; asm volatile("v_cvt_pk_bf16_f32 %0, %1, %2" : "=v"(r) : "v"(lo), "v"(hi)); return r; }
typedef float f32x2 __attribute__((ext_vector_type(2)));
typedef unsigned u32x2 __attribute__((ext_vector_type(2)));
typedef float f32x2 __attribute__((ext_vector_type(2)));
typedef __bf16 bf2_t __attribute__((ext_vector_type(2)));
__device__ __forceinline__ unsigned pkbf(float lo, float hi) { f32x2 v = {lo, hi}; return __builtin_bit_cast(unsigned, __builtin_convertvector(v, bf2_t)); }
__device__ __forceinline__ float bflo(unsigned w) { return __builtin_bit_cast(float, w << 16); }
__device__ __forceinline__ float bfhi(unsigned w) { return __builtin_bit_cast(float, w & 0xffff0000u); }
__device__ __forceinline__ float sigm(float x) { return __builtin_amdgcn_rcpf(1.f + __builtin_amdgcn_exp2f(-1.44269504089f * x)); }
__device__ __forceinline__ float gelu_t(float x) { const float u = x * (1.f + 0.044715f * x * x); return x * sigm(1.59576912161f * u); }

struct EpiF32 {
    static constexpr bool PERM = false, AFTER_DRAIN = false, HAS_MID = false;
    float* C; int ldc; const float* bias;
    __device__ __forceinline__ void operator()(const f32x4 (&acc)[2][2][4][2], const Unit& u, int wr, int wc, int fr, int fq) const {
        const int row0 = u.pm * BM + wr * 64 + fr, col0 = u.pn * BM + wc * 32 + 4 * fq;
        f32x4 bv[2][2];
#pragma unroll
        for (int bj = 0; bj < 2; ++bj)
#pragma unroll
            for (int n = 0; n < 2; ++n) bv[bj][n] = *(const f32x4*)(bias + col0 + bj * HALF + n * 16);
#pragma unroll
        for (int ai = 0; ai < 2; ++ai)
#pragma unroll
            for (int m = 0; m < 4; ++m) { float* rowp = C + (size_t)(row0 + ai * HALF + m * 16) * ldc + col0;
#pragma unroll
                for (int bj = 0; bj < 2; ++bj)
#pragma unroll
                    for (int n = 0; n < 2; ++n) *(f32x4*)(rowp + bj * HALF + n * 16) = acc[ai][bj][m][n] + bv[bj][n]; }
    }
};
template <int MODE> __device__ __forceinline__ float zact(float x) {
    if (MODE == 0) return gelu_t(x);
    if (MODE == 1) return x * sigm(x) * 0.08838834764831845f;
    if (MODE == 2) return x;
    if (MODE == 3) return x * sigm(x);
    return sigm(x);
}
struct EpiZ {
    static constexpr bool PERM = true, AFTER_DRAIN = false, HAS_MID = false;
    bf16_t* Z; int ldc; int pn_off;
    template <int MODE> __device__ __forceinline__ void run(const f32x4 (&acc)[2][2][4][2], const Unit& u, int wr, int wc, int fr, int fq) const {
        const int row0 = u.pm * BM + wr * 64 + fr, col0 = (u.pn + pn_off) * BM + wc * 32 + 8 * fq;
#pragma unroll
        for (int ai = 0; ai < 2; ++ai)
#pragma unroll
            for (int m = 0; m < 4; ++m) { bf16_t* rowp = Z + (size_t)(row0 + ai * HALF + m * 16) * ldc + col0;
#pragma unroll
                for (int bj = 0; bj < 2; ++bj) { const f32x4 v0 = acc[ai][bj][m][0], v1 = acc[ai][bj][m][1];
                    u32x4 w; w.x = pkbf(zact<MODE>(v0[0]), zact<MODE>(v0[1])); w.y = pkbf(zact<MODE>(v0[2]), zact<MODE>(v0[3]));
                    w.z = pkbf(zact<MODE>(v1[0]), zact<MODE>(v1[1])); w.w = pkbf(zact<MODE>(v1[2]), zact<MODE>(v1[3]));
                    *(u32x4*)(rowp + bj * HALF) = w; } }
    }
    __device__ __forceinline__ void operator()(const f32x4 (&acc)[2][2][4][2], const Unit& u, int wr, int wc, int fr, int fq) const {
        const int pn = u.pn + pn_off;
        if (pn < 8) run<0>(acc, u, wr, wc, fr, fq);
        else if (pn < 16) run<1>(acc, u, wr, wc, fr, fq);
        else if (pn < 32) run<2>(acc, u, wr, wc, fr, fq);
        else if (pn < 40) run<3>(acc, u, wr, wc, fr, fq);
        else run<4>(acc, u, wr, wc, fr, fq);
    }
};
template <bool SECOND> struct EpiBranch {
    static constexpr bool PERM = true, AFTER_DRAIN = false, HAS_MID = false;
    const bf16_t* Zg; bf16_t* Y;
    __device__ __forceinline__ void operator()(const f32x4 (&acc)[2][2][4][2], const Unit& u, int wr, int wc, int fr, int fq) const {
        const int row0 = u.pm * BM + wr * 64 + fr, col0 = u.pn * BM + wc * 32 + 8 * fq;
#pragma unroll
        for (int ai = 0; ai < 2; ++ai) {
            u32x4 gt[4][2], pv[4][2];
#pragma unroll
            for (int m = 0; m < 4; ++m) { const size_t row = (size_t)(row0 + ai * HALF + m * 16);
#pragma unroll
                for (int bj = 0; bj < 2; ++bj) { gt[m][bj] = *(const u32x4*)(Zg + row * 14336 + col0 + bj * HALF); if (SECOND) pv[m][bj] = *(const u32x4*)(Y + row * 2048 + col0 + bj * HALF); } }
#pragma unroll
            for (int m = 0; m < 4; ++m) { bf16_t* yr = Y + (size_t)(row0 + ai * HALF + m * 16) * 2048 + col0;
#pragma unroll
                for (int bj = 0; bj < 2; ++bj) { const u32x4 g = gt[m][bj]; const f32x4 v0 = acc[ai][bj][m][0], v1 = acc[ai][bj][m][1];
                    float r[8] = {v0[0] * bflo(g.x), v0[1] * bfhi(g.x), v0[2] * bflo(g.y), v0[3] * bfhi(g.y), v1[0] * bflo(g.z), v1[1] * bfhi(g.z), v1[2] * bflo(g.w), v1[3] * bfhi(g.w)};
                    if (SECOND) { const u32x4 p = pv[m][bj];
                        r[0] += bflo(p.x); r[1] += bfhi(p.x); r[2] += bflo(p.y); r[3] += bfhi(p.y); r[4] += bflo(p.z); r[5] += bfhi(p.z); r[6] += bflo(p.w); r[7] += bfhi(p.w); }
                    u32x4 w; w.x = pkbf(r[0], r[1]); w.y = pkbf(r[2], r[3]); w.z = pkbf(r[4], r[5]); w.w = pkbf(r[6], r[7]);
                    *(u32x4*)(yr + bj * HALF) = w; } }
            asm volatile("" ::: "memory"); }
    }
};
struct EpiResid {
    static constexpr bool PERM = true, AFTER_DRAIN = false, HAS_MID = false;
    const float* base_f; bf16_t* X; const float* gate; bool f32base;
    __device__ __forceinline__ void operator()(const f32x4 (&acc)[2][2][4][2], const Unit& u, int wr, int wc, int fr, int fq) const {
        const int row0 = u.pm * BM + wr * 64 + fr, col0 = u.pn * BM + wc * 32 + 8 * fq;
        f32x4 gv[2][2];
#pragma unroll
        for (int bj = 0; bj < 2; ++bj)
#pragma unroll
            for (int n = 0; n < 2; ++n) gv[bj][n] = *(const f32x4*)(gate + (size_t)(u.pm >> 3) * 24576 + col0 + bj * HALF + n * 4);
        if (f32base) {
#pragma unroll
            for (int am = 0; am < 4; ++am) { const int ai = am >> 1, m0 = (am & 1) * 2;
                f32x4 bs[2][2][2];
#pragma unroll
                for (int m = 0; m < 2; ++m) { const float* bp = base_f + (size_t)(row0 + ai * HALF + (m0 + m) * 16) * 2048 + col0;
#pragma unroll
                    for (int bj = 0; bj < 2; ++bj)
#pragma unroll
                        for (int n = 0; n < 2; ++n) bs[m][bj][n] = *(const f32x4*)(bp + bj * HALF + n * 4); }
#pragma unroll
                for (int m = 0; m < 2; ++m) { bf16_t* xo = X + (size_t)(row0 + ai * HALF + (m0 + m) * 16) * 2048 + col0;
#pragma unroll
                    for (int bj = 0; bj < 2; ++bj) { const f32x4 v0 = bs[m][bj][0] + gv[bj][0] * acc[ai][bj][m0 + m][0], v1 = bs[m][bj][1] + gv[bj][1] * acc[ai][bj][m0 + m][1];
                        u32x4 w; w.x = pkbf(v0[0], v0[1]); w.y = pkbf(v0[2], v0[3]); w.z = pkbf(v1[0], v1[1]); w.w = pkbf(v1[2], v1[3]);
                        *(u32x4*)(xo + bj * HALF) = w; } }
                asm volatile("" ::: "memory"); }
        } else {
#pragma unroll
            for (int ai = 0; ai < 2; ++ai) {
                u32x4 bs[4][2];
#pragma unroll
                for (int m = 0; m < 4; ++m) { const bf16_t* bp = X + (size_t)(row0 + ai * HALF + m * 16) * 2048 + col0;
#pragma unroll
                    for (int bj = 0; bj < 2; ++bj) bs[m][bj] = *(const u32x4*)(bp + bj * HALF); }
#pragma unroll
                for (int m = 0; m < 4; ++m) { bf16_t* xo = X + (size_t)(row0 + ai * HALF + m * 16) * 2048 + col0;
#pragma unroll
                    for (int bj = 0; bj < 2; ++bj) { const u32x4 p = bs[m][bj]; const f32x4 a0 = acc[ai][bj][m][0], a1 = acc[ai][bj][m][1], g0 = gv[bj][0], g1 = gv[bj][1];
                        u32x4 w; w.x = pkbf(bflo(p.x) + g0[0] * a0[0], bfhi(p.x) + g0[1] * a0[1]); w.y = pkbf(bflo(p.y) + g0[2] * a0[2], bfhi(p.y) + g0[3] * a0[3]);
                        w.z = pkbf(bflo(p.z) + g1[0] * a1[0], bfhi(p.z) + g1[1] * a1[1]); w.w = pkbf(bflo(p.w) + g1[2] * a1[2], bfhi(p.w) + g1[3] * a1[3]);
                        *(u32x4*)(xo + bj * HALF) = w; } }
                asm volatile("" ::: "memory"); }
        }
    }
};
struct EpiUp {
    static constexpr bool PERM = true, AFTER_DRAIN = false, HAS_MID = false;
    bf16_t* UP; float* outp; float* outs;
    __device__ __forceinline__ void operator()(const f32x4 (&acc)[2][2][4][2], const Unit& u, int wr, int wc, int fr, int fq) const {
        const int row0 = u.pm * BM + wr * 64 + fr, col0 = u.pn * BM + wc * 32 + 8 * fq;
#pragma unroll
        for (int ai = 0; ai < 2; ++ai)
#pragma unroll
            for (int m = 0; m < 4; ++m) { const int row = row0 + ai * HALF + m * 16; bf16_t* rowp = UP + (size_t)row * 11264 + col0;
                float* fo = nullptr;
                if (row < 8192) { const int t = row & 2047; if (t >= 2046) fo = outp + (size_t)((row >> 11) * 2 + (t - 2046)) * 11264 + col0; }
                else { const int rr = row - 8192, t = rr & 7; if (t >= 6) fo = outs + (size_t)((rr >> 3) * 2 + (t - 6)) * 11264 + col0; }
#pragma unroll
                for (int bj = 0; bj < 2; ++bj) { const f32x4 v0 = acc[ai][bj][m][0], v1 = acc[ai][bj][m][1];
                    u32x4 w; w.x = pkbf(v0[0], v0[1]); w.y = pkbf(v0[2], v0[3]); w.z = pkbf(v1[0], v1[1]); w.w = pkbf(v1[2], v1[3]);
                    *(u32x4*)(rowp + bj * HALF) = w;
                    if (fo) { *(f32x4*)(fo + bj * HALF) = v0; *(f32x4*)(fo + bj * HALF + 4) = v1; } } }
    }
};

struct SplitOrder {
    static constexpr bool PARTS = true;
    int G, c, S, nkt_full;
    __device__ __forceinline__ void init(int K, int S_, int G_, int c_) { G = G_; c = c_; S = S_; nkt_full = K / BK; }
    __device__ __forceinline__ bool next(int i, Unit& u) const {
        const int rot = (G == 256) ? (((c & 7) * nkt_full) >> 3) & ~1 : 0, two = rot > 0 ? 1 : 0;
        const int io = (i == 0) ? 0 : i - two;
        const int L = io * G + c;
        if (L >= 256 + 32 * S) return false;
        const bool pr = L < 256;
        const int wgid = (L & 7) * 32 + ((L >> 3) & 31);
        const int sl = L - 256, tile = sl & 31, s = sl >> 5;
        const int base = (nkt_full / (2 * S)) * 2, rem = (nkt_full - base * S) / 2;
        u.pm = pr ? ((wgid >> 6) * 8 + (wgid & 7)) : 32 + (tile >> 3);
        u.pn = pr ? ((wgid & 63) >> 3) : (tile & 7);
        const bool first = two && i == 0, second = two && i == 1;
        u.kt0 = pr ? (first ? rot : 0) : s * base + 2 * (s < rem ? s : rem);
        u.nkt = pr ? (first ? nkt_full - rot : (second ? rot : nkt_full)) : base + (s < rem ? 2 : 0);
        u.aux = pr ? (first ? -2 : -1) : s;
        return true;
    }
    __device__ __forceinline__ void a_ready(const Unit&) const {}
    __device__ __forceinline__ void done(const Unit&) const {}
};
constexpr size_t SLAB_ELEMS = (size_t)1024 * 2048 + 2560;
template <class Full> struct EpiSplit {
    static constexpr bool PERM = Full::PERM, AFTER_DRAIN = false, HAS_MID = false;
    Full full; bf16_t* slab;
    __device__ __forceinline__ void operator()(const f32x4 (&acc)[2][2][4][2], const Unit& u, int wr, int wc, int fr, int fq) const {
        if (u.aux < 0) { full(acc, u, wr, wc, fr, fq); return; }
        bf16_t* P = slab + (size_t)u.aux * SLAB_ELEMS;
        const int row0 = (u.pm - 32) * BM + wr * 64 + fr, col0 = u.pn * BM + wc * 32 + (PERM ? 8 * fq : 4 * fq);
#pragma unroll
        for (int ai = 0; ai < 2; ++ai)
#pragma unroll
            for (int m = 0; m < 4; ++m) { bf16_t* rowp = P + (size_t)(row0 + ai * HALF + m * 16) * 2048 + col0;
#pragma unroll
                for (int bj = 0; bj < 2; ++bj) {
                    if (PERM) { const f32x4 v0 = acc[ai][bj][m][0], v1 = acc[ai][bj][m][1]; u32x4 w; w.x = pkbf(v0[0], v0[1]); w.y = pkbf(v0[2], v0[3]); w.z = pkbf(v1[0], v1[1]); w.w = pkbf(v1[2], v1[3]); *(u32x4*)(rowp + bj * HALF) = w; }
                    else {
#pragma unroll
                        for (int n = 0; n < 2; ++n) { const f32x4 v = acc[ai][bj][m][n]; u32x2 w; w.x = pkbf(v[0], v[1]); w.y = pkbf(v[2], v[3]); *(u32x2*)(rowp + bj * HALF + 16 * n) = w; } } } }
    }
};
struct UpOrder {
    static constexpr bool PARTS = false;
    StaticOrder P; int G, c;
    __device__ __forceinline__ void init(int G_, int c_) { P.init(8192, 11264, 2048, G_, c_); G = G_; c = c_; }
    __device__ __forceinline__ bool next(int i, Unit& u) const {
        const int L = i * G + c;
        if (L >= 1536 + 192) return false;
        Unit up; const bool inP = P.next(i, up);
        const int x = L - 1408, sl = L - 1536, tile = sl % 48, s = sl / 48;
        const bool smp = !inP && L < 1536;
        u.pm = inP ? up.pm : (smp ? 32 + (x & 3) : 32 + (tile & 3));
        u.pn = inP ? up.pn : (smp ? (x >> 2) : 32 + (tile >> 2));
        u.kt0 = (inP || smp) ? 0 : 8 * s; u.nkt = (inP || smp) ? 32 : 8; u.aux = (inP || smp) ? -1 : s;
        return true;
    }
    __device__ __forceinline__ void a_ready(const Unit&) const {}
    __device__ __forceinline__ void done(const Unit&) const {}
};
constexpr size_t UPSLAB_ELEMS = (size_t)1024 * 3072 + 2560;
struct EpiUpSplit {
    static constexpr bool PERM = true, AFTER_DRAIN = false, HAS_MID = false;
    EpiUp full; bf16_t* slab;
    __device__ __forceinline__ void operator()(const f32x4 (&acc)[2][2][4][2], const Unit& u, int wr, int wc, int fr, int fq) const {
        if (u.aux < 0) { full(acc, u, wr, wc, fr, fq); return; }
        bf16_t* P = slab + (size_t)u.aux * UPSLAB_ELEMS;
        const int row0 = (u.pm - 32) * BM + wr * 64 + fr, col0 = (u.pn - 32) * BM + wc * 32 + 8 * fq;
#pragma unroll
        for (int ai = 0; ai < 2; ++ai)
#pragma unroll
            for (int m = 0; m < 4; ++m) { bf16_t* rowp = P + (size_t)(row0 + ai * HALF + m * 16) * 3072 + col0;
#pragma unroll
                for (int bj = 0; bj < 2; ++bj) { const f32x4 v0 = acc[ai][bj][m][0], v1 = acc[ai][bj][m][1]; u32x4 w; w.x = pkbf(v0[0], v0[1]); w.y = pkbf(v0[2], v0[3]); w.z = pkbf(v1[0], v1[1]); w.w = pkbf(v1[2], v1[3]); *(u32x4*)(rowp + bj * HALF) = w; } }
    }
};
template <class Epi, class Sched, bool ALIGN_EPI = false, bool SP2 = false>
__device__ __forceinline__ void gemm_phase(PG8_LAS unsigned char* lds, const Gemm g, const Sched& S, const Epi& E, const int wv0) {
    int tid_ = wv0 * 64 + hw_lane(); asm volatile("" : "+v"(tid_));
    const int tid = tid_, wid = __builtin_amdgcn_readfirstlane(tid >> 6), lane = tid & 63, wr = wid >> 2, wc = wid & 3, fr = lane & 15, fq = lane >> 4;
    const int K = g.K;
    unsigned voffA[2], voffB[2];
#pragma unroll
    for (int i = 0; i < 2; ++i) { int R, C; stage_rc(tid * 16 + i * 8192, R, C); const int Rb = Epi::PERM ? ((R & ~31) + perm32(R & 31)) : R;
        voffA[i] = (unsigned)(R * K + C) * 2u; voffB[i] = (unsigned)(Rb * K + C) * 2u; }
    const size_t kstep = (size_t)(BK * 2);
    const size_t hstep = (size_t)HALF * K * 2;
    const size_t tstep = 2 * hstep;
    const unsigned ldsw = (unsigned)wid * 1024u;
    const int aoff = lds_byte(wr * 64 + fr, fq * 8), boff = lds_byte(wc * 32 + fr, fq * 8);
#define PG8_SA(b, h) (((b) * 2 + (h)) * HTB)
#define PG8_SB(b, h) ((4 + (b) * 2 + (h)) * HTB)
#define PG8_STAGE(bufoff, gbase, voff) do { _Pragma("unroll") for (int _i = 0; _i < 2; ++_i) \
        __builtin_amdgcn_global_load_lds((const unsigned*)((const char*)(gbase) + (voff)[_i]), (PG8_LAS unsigned*)(lds + (bufoff) + ldsw + _i * 8192), 16, 0, 0); } while (0)
#define PG8_LDA(dst, b, h) do { _Pragma("unroll") for (int m = 0; m < 4; ++m) _Pragma("unroll") for (int k = 0; k < 2; ++k) dst[m][k] = *(const PG8_LAS bf16x8*)(lds + PG8_SA(b, h) + aoff + m * 2048 + k * 1024); } while (0)
#define PG8_LDB(dst, b, h) do { _Pragma("unroll") for (int n = 0; n < 2; ++n) _Pragma("unroll") for (int k = 0; k < 2; ++k) dst[n][k] = *(const PG8_LAS bf16x8*)(lds + PG8_SB(b, h) + boff + n * 2048 + k * 1024); } while (0)
#define PG8_MMA(ai, bj, At, Bt) do { __builtin_amdgcn_s_setprio(1); _Pragma("unroll") for (int m = 0; m < 4; ++m) _Pragma("unroll") for (int n = 0; n < 2; ++n) _Pragma("unroll") for (int k = 0; k < 2; ++k) \
        acc[ai][bj][m][n] = __builtin_amdgcn_mfma_f32_16x16x32_bf16(Bt[n][k], At[m][k], acc[ai][bj][m][n], 0, 0, 0); __builtin_amdgcn_s_setprio(0); } while (0)
#define PG8_WAIT_V(n) asm volatile("s_waitcnt vmcnt(" #n ")" ::: "memory")
#define PG8_WAIT_L(n) asm volatile("s_waitcnt lgkmcnt(" #n ")" ::: "memory")
#define PG8_BAR __builtin_amdgcn_s_barrier()
#define PG8_SCHED __builtin_amdgcn_sched_barrier(0)
    Unit cur, nxt; int ui = 0;
    if (!S.next(0, cur)) return;
    f32x4 acc[2][2][4][2];
#pragma unroll
    for (int a = 0; a < 2; ++a)
#pragma unroll
        for (int b = 0; b < 2; ++b)
#pragma unroll
            for (int m = 0; m < 4; ++m)
#pragma unroll
                for (int n = 0; n < 2; ++n) acc[a][b][m][n] = (f32x4){0.f, 0.f, 0.f, 0.f};
    bf16x8 At[4][2], B0[2][2], B1[2][2];
    const char* cA = (const char*)g.A + (size_t)cur.pm * tstep + (size_t)cur.kt0 * kstep; const char* cB = (const char*)g.Bt + (size_t)cur.pn * tstep + (size_t)cur.kt0 * kstep;
    S.a_ready(cur);
    if constexpr (SP2) {
        PG8_STAGE(PG8_SB(0, 0), cB, voffB); PG8_STAGE(PG8_SB(0, 1), cB + hstep, voffB); PG8_STAGE(PG8_SA(0, 0), cA, voffA); PG8_STAGE(PG8_SA(0, 1), cA + hstep, voffA);
        if (wr == 1) PG8_BAR;
        PG8_WAIT_V(2); PG8_BAR;
        PG8_STAGE(PG8_SB(1, 0), cB + kstep, voffB); PG8_STAGE(PG8_SA(1, 0), cA + kstep, voffA); PG8_STAGE(PG8_SB(1, 1), cB + hstep + kstep, voffB);
        PG8_WAIT_V(6); PG8_BAR;
    } else {
        PG8_STAGE(PG8_SB(0, 0), cB, voffB); PG8_STAGE(PG8_SA(0, 0), cA, voffA); PG8_STAGE(PG8_SB(0, 1), cB + hstep, voffB); PG8_STAGE(PG8_SA(0, 1), cA + hstep, voffA);
        if (wr == 1) PG8_BAR;
        PG8_WAIT_V(4); PG8_BAR;
        PG8_STAGE(PG8_SB(1, 0), cB + kstep, voffB); PG8_STAGE(PG8_SA(1, 0), cA + kstep, voffA); PG8_STAGE(PG8_SB(1, 1), cB + hstep + kstep, voffB);
        PG8_WAIT_V(6); PG8_BAR;
    }
    for (;;) {
        const bool has_next = S.next(ui + 1, nxt);
        const char* nA = has_next ? (const char*)g.A + (size_t)nxt.pm * tstep + (size_t)nxt.kt0 * kstep : cA; const char* nB = has_next ? (const char*)g.Bt + (size_t)nxt.pn * tstep + (size_t)nxt.kt0 * kstep : cB;
        const int nt = cur.nkt;
        for (int t = 0; t < nt; t += 2) {
            if constexpr (Epi::HAS_MID) { if (t == E.tmid) E.mid(acc, cur, wr, wc, fr, fq); }
            const bool last = (t == nt - 2);
            const char* a1 = cA + (size_t)(t + 1) * kstep;
            const char* a2 = last ? nA : cA + (size_t)(t + 2) * kstep; const char* b2 = last ? nB : cB + (size_t)(t + 2) * kstep;
            const char* a3 = a2 + kstep; const char* b3 = b2 + kstep;
            if (last && has_next) S.a_ready(nxt);
            if constexpr (SP2) {
            PG8_LDB(B0, 0, 0); PG8_LDB(B1, 0, 1); PG8_SCHED; PG8_LDA(At, 0, 0); PG8_STAGE(PG8_SA(1, 1), a1 + hstep, voffA);
            PG8_WAIT_V(8); PG8_WAIT_L(0); PG8_BAR; PG8_MMA(0, 0, At, B0); PG8_MMA(0, 1, At, B1); PG8_BAR; PG8_SCHED;
            PG8_LDA(At, 0, 1); PG8_STAGE(PG8_SB(0, 0), b2, voffB); PG8_STAGE(PG8_SB(0, 1), b2 + hstep, voffB); PG8_STAGE(PG8_SA(0, 0), a2, voffA);
            PG8_WAIT_V(8); PG8_WAIT_L(0); PG8_BAR; PG8_MMA(1, 0, At, B0); PG8_MMA(1, 1, At, B1); PG8_BAR; PG8_SCHED;
            PG8_LDB(B0, 1, 0); PG8_LDB(B1, 1, 1); PG8_SCHED; PG8_LDA(At, 1, 0); PG8_STAGE(PG8_SA(0, 1), a2 + hstep, voffA);
            PG8_WAIT_V(8); PG8_WAIT_L(0); PG8_BAR; PG8_MMA(0, 0, At, B0); PG8_MMA(0, 1, At, B1); PG8_BAR; PG8_SCHED;
            PG8_LDA(At, 1, 1); PG8_STAGE(PG8_SB(1, 0), b3, voffB); PG8_STAGE(PG8_SB(1, 1), b3 + hstep, voffB); PG8_STAGE(PG8_SA(1, 0), a3, voffA);
            PG8_WAIT_V(8); PG8_WAIT_L(0); PG8_BAR; PG8_MMA(1, 0, At, B0); PG8_MMA(1, 1, At, B1); PG8_BAR; PG8_SCHED;
            } else {
            PG8_LDB(B0, 0, 0); PG8_SCHED; PG8_LDA(At, 0, 0); PG8_STAGE(PG8_SA(1, 1), a1 + hstep, voffA);
            PG8_WAIT_L(8); PG8_BAR; PG8_WAIT_L(0); PG8_MMA(0, 0, At, B0); PG8_BAR; PG8_SCHED;
            PG8_LDB(B1, 0, 1); PG8_STAGE(PG8_SB(0, 0), b2, voffB);
            PG8_BAR; PG8_WAIT_L(0); PG8_MMA(0, 1, At, B1); PG8_BAR;
            PG8_LDA(At, 0, 1); PG8_STAGE(PG8_SA(0, 0), a2, voffA);
            PG8_BAR; PG8_WAIT_L(0); PG8_MMA(1, 0, At, B0); PG8_BAR; PG8_SCHED;
            PG8_STAGE(PG8_SB(0, 1), b2 + hstep, voffB);
            PG8_WAIT_V(6); PG8_BAR; PG8_MMA(1, 1, At, B1); PG8_BAR;
            PG8_LDB(B0, 1, 0); PG8_SCHED; PG8_LDA(At, 1, 0); PG8_STAGE(PG8_SA(0, 1), a2 + hstep, voffA);
            PG8_WAIT_L(8); PG8_BAR; PG8_WAIT_L(0); PG8_MMA(0, 0, At, B0); PG8_BAR; PG8_SCHED;
            PG8_LDB(B1, 1, 1); PG8_STAGE(PG8_SB(1, 0), b3, voffB);
            PG8_BAR; PG8_WAIT_L(0); PG8_MMA(0, 1, At, B1); PG8_BAR;
            PG8_LDA(At, 1, 1); PG8_STAGE(PG8_SA(1, 0), a3, voffA);
            PG8_BAR; PG8_WAIT_L(0); PG8_MMA(1, 0, At, B0); PG8_BAR; PG8_SCHED;
            PG8_STAGE(PG8_SB(1, 1), b3 + hstep, voffB);
            PG8_WAIT_V(6); PG8_BAR; PG8_MMA(1, 1, At, B1); PG8_BAR;
            }
        }
        const bool part = Sched::PARTS && cur.aux == -2;
        if (!part) {
        if constexpr (ALIGN_EPI) { if (wr == 0) PG8_BAR; }
        if constexpr (!Epi::AFTER_DRAIN) { E(acc, cur, wr, wc, fr, fq); S.done(cur); }
        }
        if (!has_next) break;
        if (!part) {
#pragma unroll
        for (int a = 0; a < 2; ++a)
#pragma unroll
            for (int b = 0; b < 2; ++b)
#pragma unroll
                for (int m = 0; m < 4; ++m)
#pragma unroll
                    for (int n = 0; n < 2; ++n) acc[a][b][m][n] = (f32x4){0.f, 0.f, 0.f, 0.f};
        }
        cur = nxt; cA = nA; cB = nB; ++ui;
        if (!part) {
        if constexpr (ALIGN_EPI) { if (wr == 1) PG8_BAR; }
        }
    }
    PG8_WAIT_V(0);
    if constexpr (!ALIGN_EPI) { if (wr == 0) PG8_BAR; }
    PG8_BAR;
    if constexpr (Epi::AFTER_DRAIN) { E.fused(acc, cur, wr, wc, fr, fq, lds, wid, lane); S.done(cur); }
#undef PG8_SA
#undef PG8_SB
#undef PG8_STAGE
#undef PG8_LDA
#undef PG8_LDB
#undef PG8_MMA
#undef PG8_WAIT_V
#undef PG8_WAIT_L
#undef PG8_BAR
#undef PG8_SCHED
}
}
#define GAS __attribute__((address_space(1)))
#define LAS __attribute__((address_space(3)))
typedef unsigned short bf16;
typedef unsigned v4u __attribute__((ext_vector_type(4)));
typedef float f32x4 __attribute__((ext_vector_type(4)));
typedef short bf16x8 __attribute__((ext_vector_type(8)));
typedef GAS unsigned gu32;
typedef GAS unsigned long long gu64;
#define RLX_AGENT __ATOMIC_RELAXED, __HIP_MEMORY_SCOPE_AGENT
#define LDS_WAIT() asm volatile("s_waitcnt lgkmcnt(0)" ::: "memory")
#define VM_WAIT() asm volatile("s_waitcnt vmcnt(0)" ::: "memory")
__device__ __forceinline__ unsigned long long rt() { return __builtin_amdgcn_s_memrealtime(); }
__device__ __forceinline__ unsigned f2bf(float f) { unsigned u = __builtin_bit_cast(unsigned, f); return (u + 0x7fffu + ((u >> 16) & 1u)) >> 16; }
__device__ __forceinline__ unsigned pk2(float lo, float hi) { return f2bf(lo) | (f2bf(hi) << 16); }

#define XB_TMO      128
#define XB_XCNT(j)  (256  + 64 * (j))
#define XB_XSUB(j)  (1280 + 64 * (j))
#define XB_XGEN(j)  (2304 + 64 * (j))
#define XB_TOP      3328
#define XB_TOPGEN   3392
#define XCD_BAR_WORDS 3456
#define XB_SPIN_CAP (1u << 18)

__device__ __forceinline__ unsigned xb_ld(unsigned* p)              { return __hip_atomic_load(p, __ATOMIC_RELAXED, __HIP_MEMORY_SCOPE_AGENT); }
__device__ __forceinline__ unsigned xb_add(unsigned* p, unsigned v) { return __hip_atomic_fetch_add(p, v, __ATOMIC_RELAXED, __HIP_MEMORY_SCOPE_AGENT); }
__device__ __forceinline__ unsigned xb_xcc_id() { return (unsigned)__builtin_amdgcn_s_getreg((3 << 11) | 20) & 0xFu; }
#define XB_SPIN(cond, bar) do { unsigned _sp = 0; while (cond) { __builtin_amdgcn_s_sleep(1); \
    if ((++_sp & 255u) == 0u) { if (xb_ld(&(bar)[XB_TMO])) break; if (_sp > XB_SPIN_CAP) { atomicAdd(&(bar)[XB_TMO], 1u); break; } } } } while (0)

struct XcdBarrier {
    unsigned* bar; unsigned x; unsigned w0;
    volatile LAS unsigned* st;
};

__device__ __forceinline__ XcdBarrier xcd_barrier_post(unsigned* bar, volatile LAS unsigned* st, int wv0) {
    XcdBarrier b; b.bar = bar; b.x = xb_xcc_id(); b.st = st; b.w0 = (unsigned)wv0;
    if (wv0 == 0 && hw_lane() == 0) (void)xb_add(&bar[XB_XCNT(b.x)], 1u);
    return b;
}
__device__ __forceinline__ void xcd_barrier_complete(unsigned* bar, unsigned x, unsigned& nloc, unsigned& nx) {
    const unsigned G = gridDim.x * gridDim.y * gridDim.z;
    unsigned sum, cnt, mine, sp = 0u;
    for (;;) {
        sum = 0u; cnt = 0u; mine = 0u;
#pragma unroll
        for (unsigned j = 0; j < 16; ++j) { const unsigned c = xb_ld(&bar[XB_XCNT(j)]); sum += c; cnt |= (c > 0u) ? (1u << j) : 0u; mine = (j == x) ? c : mine; }
        if (sum == G) break;
        __builtin_amdgcn_s_sleep(1);
        if ((++sp & 255u) == 0u) { if (xb_ld(&bar[XB_TMO])) break; if (sp > XB_SPIN_CAP) { atomicAdd(&bar[XB_TMO], 1u); break; } }
    }
    nloc = mine > 0u ? mine : 1u; nx = cnt | (1u << x);
}

__device__ __forceinline__ void xcd_barrier(const XcdBarrier& b) {
    asm volatile("s_waitcnt vmcnt(0)" ::: "memory");
    __syncthreads();
    if (b.w0 == 0u) {
        unsigned* bar = b.bar; const int ln = hw_lane();
        unsigned gen = 0u, mask = 0u;
        if (ln == 0) {
            __builtin_amdgcn_s_waitcnt(0);
            unsigned nloc = b.st[0], nx = b.st[1];
            if (nloc == 0u) { xcd_barrier_complete(bar, b.x, nloc, nx); b.st[0] = nloc; b.st[1] = nx; }
            const unsigned old = xb_add(&bar[XB_XSUB(b.x)], 1u);
            gen = old / nloc; mask = nx;
            if (old + 1u == (gen + 1u) * nloc) {
                __builtin_amdgcn_fence(__ATOMIC_RELEASE, "agent");
                asm volatile("s_waitcnt vmcnt(0)" ::: "memory");
                xb_add(&bar[XB_XGEN(b.x)], 1u);
            }
        }
        gen = (unsigned)__builtin_amdgcn_readfirstlane((int)gen); mask = (unsigned)__builtin_amdgcn_readfirstlane((int)mask);
        { const bool mine = ln < 16 && ((mask >> ln) & 1u); unsigned sp = 0u;
          for (;;) {
              bool ok = true; if (mine) ok = xb_ld(&bar[XB_XGEN(ln)]) > gen;
              if (__builtin_amdgcn_ballot_w64(!ok) == 0ull) break;
              __builtin_amdgcn_s_sleep(1);
              if ((++sp & 255u) == 0u) { if (xb_ld(&bar[XB_TMO])) break; if (sp > XB_SPIN_CAP) { if (ln == 0) atomicAdd(&bar[XB_TMO], 1u); break; } } } }
        __builtin_amdgcn_fence(__ATOMIC_ACQUIRE, "agent");
        asm volatile("s_waitcnt vmcnt(0)" ::: "memory");
    }
    __syncthreads();
}

constexpr int NWAVES = 8;
constexpr int DM = 2048, MP = 8192, MS = 1024, MT = MP + MS;
constexpr int NIN = 14336, DFF = 5632, NUP = 2 * DFF, NCOND = 132, MODP = 24576;
constexpr int ZU = 0, ZV = 1024, ZQ = 2048, ZF = 4096, ZI = 6144, ZOG = 8192, ZGA = 10240, ZGB = 12288;
constexpr float EPS = 1e-6f, L2E = 1.44269504089f;
constexpr size_t O_YP = 0, O_YS = 16777216, O_HP = 18874368, O_HS = 20971520, O_CP = 88080384, O_CS = 88260608, O_VP = 94027776, O_VS = 95076352, O_END = 97173504;
constexpr size_t MiB = 1u << 20;
constexpr size_t WS_CTL = 0, CTL_ZERO_BYTES = 1 * MiB;
constexpr size_t WS_AC = 1 * MiB;
constexpr size_t WS_MOD = 2 * MiB;
constexpr size_t WS_ADAT = 26 * MiB;
constexpr size_t WS_WIN = 122 * MiB, SZ_WIN = 56 * MiB;
constexpr size_t WS_WBA = 234 * MiB, SZ_WBA = 4 * MiB;
constexpr size_t WS_WBB = 242 * MiB, SZ_WBB = 8 * MiB;
constexpr size_t WS_WOUT = 258 * MiB, SZ_WOUT = 8 * MiB;
constexpr size_t WS_WUP = 274 * MiB, SZ_WUP = 44 * MiB;
constexpr size_t WS_WDN = 362 * MiB, SZ_WDN = 22 * MiB;
constexpr size_t WS_X = 406 * MiB;
constexpr size_t WS_H = 478 * MiB;
constexpr size_t WS_Z = 514 * MiB;
constexpr size_t WS_YA = 766 * MiB;
constexpr size_t WS_O = 784 * MiB;
constexpr size_t WS_Y = 820 * MiB;
constexpr size_t WS_ACT = 856 * MiB;
constexpr size_t WS_SLAB = 955 * MiB;
constexpr size_t WS_END = 1051 * MiB;
constexpr int CW_BAR = 4096;
constexpr int RING_OFF = 0, RING_BYTES = 131072;
constexpr int LDSCTL_OFF = RING_BYTES, MISC_OFF = LDSCTL_OFF + 320;
constexpr int LDS_BYTES = 147456;

#define DI __device__ __forceinline__
typedef unsigned v2u __attribute__((ext_vector_type(2)));
using pg8::pkbf; using pg8::bflo; using pg8::bfhi; using pg8::sigm; using pg8::gelu_t;
DI float fexp2(float x) { return __builtin_amdgcn_exp2f(x); }
DI float flog2(float x) { return __builtin_amdgcn_logf(x); }
DI float frcp(float x) { return __builtin_amdgcn_rcpf(x); }
DI float frsq(float x) { return __builtin_amdgcn_rsqf(x); }
DI float lane_get(float x, int src_lane) { return __builtin_bit_cast(float, __builtin_amdgcn_ds_bpermute(src_lane << 2, __builtin_bit_cast(int, x))); }
DI float wave_sum(float v, int lane) {
#pragma unroll
    for (int o = 1; o < 64; o <<= 1) v += lane_get(v, lane ^ o);
    return v;
}
#define LDS_BARRIER() do { asm volatile("s_waitcnt lgkmcnt(0)" ::: "memory"); __builtin_amdgcn_s_barrier(); asm volatile("" ::: "memory"); } while (0)
#define MFMA16(a, b, c) __builtin_amdgcn_mfma_f32_16x16x32_bf16((a), (b), (c), 0, 0, 0)

struct Args { const float* in[24]; float* out; unsigned char* ws; };
DI const float* inp(const Args& a, int k) { asm volatile("" : "+s"(k)); return (const float*)(const GAS float*)a.in[k]; }
enum { I_XP = 0, I_XS, I_CP, I_CS, I_SH, I_SC, I_ADAW, I_ADAB, I_N1, I_N2, I_WIN, I_VG, I_WS, I_BS, I_WBA, I_LB, I_HNG, I_WBB, I_WOUT, I_WUP, I_CW, I_CB, I_WDN, I_FNG };

struct P0It { const float* W; int N; bf16* WT; int pitch; int item; };
DI void p0_item_load(const P0It& d, int lane, float (&v)[32]) {
    const int nblk = d.N / 32, kb = d.item / nblk, nb = d.item % nblk, k0 = 64 * kb, n0 = 32 * nb;
#pragma unroll
    for (int i = 0; i < 32; ++i) { const int kk = 2 * i + (lane >> 5); v[i] = __builtin_nontemporal_load(d.W + (size_t)(k0 + kk) * d.N + n0 + (lane & 31)); }
}
DI void p0_item_store(const P0It& d, LAS float* scr, int lane, const float (&v)[32]) {
    const int nblk = d.N / 32, kb = d.item / nblk, nb = d.item % nblk, k0 = 64 * kb, n0 = 32 * nb;
#pragma unroll
    for (int i = 0; i < 32; ++i) { const int kk = 2 * i + (lane >> 5); scr[kk * 33 + (lane & 31)] = v[i]; }
    LDS_WAIT(); asm volatile("" ::: "memory");
    const int c = lane & 7;
#pragma unroll
    for (int j = 0; j < 4; ++j) { const int n = (lane >> 3) + 8 * j; const LAS float* sp = scr + (8 * c) * 33 + n;
        v4u o; o.x = pkbf(sp[0 * 33], sp[1 * 33]); o.y = pkbf(sp[2 * 33], sp[3 * 33]); o.z = pkbf(sp[4 * 33], sp[5 * 33]); o.w = pkbf(sp[6 * 33], sp[7 * 33]);
        *(GAS v4u*)(d.WT + (size_t)(n0 + n) * d.pitch + k0 + 8 * c) = o; }
    LDS_WAIT(); asm volatile("" ::: "memory");
}

template <bool FINAL>
DI void norm_rows(const void* xp, const void* xs, bool pbf, bool sbf  , const float* g, const float* modsh  , bf16* H, float* out, int gw, int NGW, int lane,
                  const bf16* slab  , const float* gate  , bf16* xs_out  , LAS unsigned char* lds) {
    asm volatile("" : "+v"(lane), "+s"(gw));
    const bool bal = (slab != nullptr) && (NGW == 2048);
    int srow = -1, r0, r1;
    if (bal) { if (gw < 1024) { srow = MP + gw; r0 = 2 * gw; r1 = r0 + 2; } else { r0 = 2048 + 6 * (gw - 1024); r1 = r0 + 6; } }
    else { unsigned n_ = (unsigned)NGW; asm volatile("" : "+s"(n_));
           r0 = (int)((unsigned)(gw * MT) / n_); r1 = (int)((unsigned)((gw + 1) * MT) / n_); }
    int cbc = -1; f32x4 wv[8], shv[8];
    auto params = [&](int row) {
        const int cb = row < MP ? (row >> 11) : 4 + ((row - MP) >> 3);
        if (cb == cbc) return;
        cbc = cb;
        if (FINAL) {
#pragma unroll
            for (int j = 0; j < 8; ++j) wv[j] = ((const GAS f32x4*)g)[lane + 64 * j];
        } else {
            const GAS f32x4* sh = (const GAS f32x4*)(modsh + (size_t)cb * MODP) + lane; const GAS f32x4* sc = sh + DM / 4;
#pragma unroll
            for (int j = 0; j < 8; ++j) { wv[j] = ((const GAS f32x4*)g)[lane + 64 * j] * (sc[64 * j] + 1.f); shv[j] = sh[64 * j]; }
        } };
    auto ldrow = [&](int row, f32x4 (&v)[8]) {
        const bool isb = row < MP ? pbf : sbf; const size_t roff = row < MP ? (size_t)row * DM : (size_t)(row - MP) * DM; const void* rbase = row < MP ? xp : xs;
        if (isb) { const GAS v2u* xr = (const GAS v2u*)((const bf16*)rbase + roff) + lane; v2u w[8];
#pragma unroll
            for (int j = 0; j < 8; ++j) w[j] = xr[64 * j];
#pragma unroll
            for (int j = 0; j < 8; ++j) v[j] = (f32x4){bflo(w[j].x), bfhi(w[j].x), bflo(w[j].y), bfhi(w[j].y)}; }
        else { const GAS f32x4* xr = (const GAS f32x4*)((const float*)rbase + roff) + lane;
#pragma unroll
            for (int j = 0; j < 8; ++j) v[j] = xr[64 * j]; } };
    auto fold = [&](int row, f32x4 (&v)[8], bool lgate = false) {
        const int cbs = 4 + ((row - MP) >> 3);
        const GAS f32x4* gp = (const GAS f32x4*)(gate + (size_t)cbs * MODP) + lane; const GAS v2u* sp = (const GAS v2u*)(slab + (size_t)(row - MP) * DM) + lane;
        f32x4 a[8], gq[8];
#pragma unroll
        for (int j = 0; j < 8; ++j) { a[j] = (f32x4){0.f, 0.f, 0.f, 0.f}; if (!lgate) gq[j] = gp[64 * j]; }
#pragma unroll 1
        for (int sh = 0; sh < 2; ++sh) {
#pragma unroll
            for (int j = 0; j < 8; ++j)
#pragma unroll
                for (int s = 0; s < 4; ++s) { const v2u w = sp[(size_t)(4 * sh + s) * (pg8::SLAB_ELEMS / 4) + 64 * j]; a[j] += (f32x4){bflo(w.x), bfhi(w.x), bflo(w.y), bfhi(w.y)}; } }
        if (lgate) {
#pragma unroll
            for (int j = 0; j < 8; ++j) gq[j] = *(const LAS f32x4*)(lds + (lane + 64 * j) * 16); }
#pragma unroll
        for (int j = 0; j < 8; ++j) v[j] += gq[j] * a[j];
        if (xs_out) { GAS v2u* xo = (GAS v2u*)(xs_out + (size_t)(row - MP) * DM) + lane;
#pragma unroll
            for (int j = 0; j < 8; ++j) { v2u w; w.x = pkbf(v[j].x, v[j].y); w.y = pkbf(v[j].z, v[j].w); xo[64 * j] = w; } } };
    auto finish = [&](int row, const f32x4 (&v)[8]) {
        float ss = 0.f;
#pragma unroll
        for (int j = 0; j < 8; ++j) ss += (v[j].x * v[j].x + v[j].y * v[j].y) + (v[j].z * v[j].z + v[j].w * v[j].w);
        const float rstd = frsq(wave_sum(ss, lane) * (1.f / DM) + EPS);
        if (FINAL) { GAS f32x4* o = (GAS f32x4*)(out + (size_t)row * DM) + lane;
#pragma unroll
            for (int j = 0; j < 8; ++j) o[64 * j] = v[j] * rstd * wv[j]; }
        else { GAS v2u* o = (GAS v2u*)(H + (size_t)row * DM) + lane;
#pragma unroll
            for (int j = 0; j < 8; ++j) { const f32x4 h = v[j] * rstd * wv[j] + shv[j]; v2u w; w.x = pkbf(h.x, h.y); w.y = pkbf(h.z, h.w); o[64 * j] = w; } } };
    if (srow >= 0) {
        const int cbs = 4 + ((srow - MP) >> 3); const int idx = (srow & 7) * 64 + lane;
        const f32x4 g4 = ((const GAS f32x4*)(gate + (size_t)cbs * MODP))[idx];
        f32x4 w4 = ((const GAS f32x4*)g)[idx], s4 = {0.f, 0.f, 0.f, 0.f};
        if (!FINAL) { const GAS f32x4* sh = (const GAS f32x4*)(modsh + (size_t)cbs * MODP); w4 = w4 * (sh[DM / 4 + idx] + 1.f); s4 = sh[idx]; }
        *(LAS f32x4*)(lds + idx * 16) = g4; *(LAS f32x4*)(lds + 8192 + idx * 16) = w4; *(LAS f32x4*)(lds + 16384 + idx * 16) = s4;
    }
    if (bal) { if (gw < 1024) LDS_BARRIER(); }
    if (srow >= 0) {
        v2u w2[2][8];
        const bool pre = pbf && (r1 - r0 == 2);
        if (pre) {
#pragma unroll
            for (int t = 0; t < 2; ++t) { const GAS v2u* xr = (const GAS v2u*)((const bf16*)xp + (size_t)(r0 + t) * DM) + lane;
#pragma unroll
                for (int j = 0; j < 8; ++j) w2[t][j] = xr[64 * j]; } }
        { f32x4 v[8]; ldrow(srow, v); fold(srow, v, true);
#pragma unroll
          for (int j = 0; j < 8; ++j) { wv[j] = *(const LAS f32x4*)(lds + 8192 + (lane + 64 * j) * 16); shv[j] = *(const LAS f32x4*)(lds + 16384 + (lane + 64 * j) * 16); }
          cbc = 4 + ((srow - MP) >> 3);
          finish(srow, v); }
        if (pre) { params(r0);
#pragma unroll
            for (int t = 0; t < 2; ++t) { f32x4 v[8];
#pragma unroll
                for (int j = 0; j < 8; ++j) v[j] = (f32x4){bflo(w2[t][j].x), bfhi(w2[t][j].x), bflo(w2[t][j].y), bfhi(w2[t][j].y)};
                finish(r0 + t, v); }
            r0 = r1; } }
    for (int row = r0; row < r1;) {
        asm volatile("" : "+v"(lane));
        const bool pair = (row + 1 < r1) && (row + 1 < MP) && ((row >> 11) == ((row + 1) >> 11));
        if (pair) { f32x4 v0[8], v1[8]; ldrow(row, v0); ldrow(row + 1, v1); params(row); finish(row, v0); finish(row + 1, v1); row += 2; }
        else { f32x4 v[8]; ldrow(row, v); if (slab && row >= MP) fold(row, v); params(row); finish(row, v); row += 1; }
    }
}

constexpr int HP = 272, HPK = 144;
constexpr int HG_QT = 0, HG_KT = 64 * HP, HG_IVT = 2 * 64 * HP, HG_EAR = HG_IVT + 128 * HPK, HG_PART = HG_EAR + 512, HG_BUF0 = HG_PART + 2048;
constexpr int HG_KDT = HG_BUF0, HG_P = HG_KDT + 128 * HPK, HG_DEC = HG_P + 64 * HPK, HG_BUFSZ = 128 * HPK + 64 * HPK + 512, HG_END = HG_BUF0 + 2 * HG_BUFSZ;
static_assert(HG_END <= RING_BYTES, "hgrn lds");
struct HgRegs { v2u qt[4], kt[4], kd[4], iv[4]; f32x4 dec, ear; };
DI void hg_load(const bf16* Z, int rowb, int h, int k0, int tg, bool valid, v2u (&qw)[4], v2u (&fw)[4], v2u (&iw)[4]) {
#pragma unroll
    for (int j = 0; j < 4; ++j) {
        if (valid) { const bf16* zr = Z + (size_t)(rowb + 4 * tg + j) * NIN + h * 128 + k0;
            qw[j] = *(const v2u*)(zr + ZQ); fw[j] = *(const v2u*)(zr + ZF); iw[j] = *(const v2u*)(zr + ZI); }
        else { qw[j] = (v2u){0u, 0u}; fw[j] = (v2u){0u, 0u}; iw[j] = (v2u){0u, 0u}; }
    }
}
template <int NG>
DI void hg_elem(const v2u (&qw)[4], const v2u (&fw)[4], const v2u (&iw)[4], const float (&lb)[4], const float (&oml)[4], bool valid, int lane, int tg, int kql, HgRegs& R) {
#pragma unroll
    for (int cp = 0; cp < 2; ++cp) {
        float lf[4][2], kk[4][2];
#pragma unroll
        for (int j = 0; j < 4; ++j) { const unsigned w = cp ? fw[j].y : fw[j].x;
#pragma unroll
            for (int c = 0; c < 2; ++c) { const float fr = c ? bfhi(w) : bflo(w);
                const float e = fexp2(fminf(-L2E * fr, 60.f)), r = frcp(1.f + e);
                const float f = (1.f + lb[2 * cp + c] * e) * r;
                kk[j][c] = valid ? oml[2 * cp + c] * e * r : 0.f;
                lf[j][c] = valid ? flog2(f) : 0.f; } }
#pragma unroll
        for (int j = 1; j < 4; ++j) { lf[j][0] += lf[j - 1][0]; lf[j][1] += lf[j - 1][1]; }
        float before[2], aref[2], e2[2];
#pragma unroll
        for (int c = 0; c < 2; ++c) { float x = lf[3][c];
#pragma unroll
            for (int d = 1; d < 16; d <<= 1) { const float y = lane_get(x, (lane - 4 * d) & 63); if (tg >= d) x += y; }
            before[c] = x - lf[3][c]; aref[c] = lane_get(x, 4 * (NG / 2 - 1) + kql); const float al = lane_get(x, 4 * (NG - 1) + kql);
            e2[c] = fexp2(al - aref[c]); R.dec[2 * cp + c] = fexp2(al); R.ear[2 * cp + c] = fexp2(aref[c]); }
        float kd[4][2];
#pragma unroll
        for (int j = 0; j < 4; ++j) { const unsigned w = cp ? qw[j].y : qw[j].x; float qt[2], kt[2];
#pragma unroll
            for (int c = 0; c < 2; ++c) { const float qv = c ? bfhi(w) : bflo(w);
                const float d = before[c] + lf[j][c] - aref[c];
                qt[c] = qv * fexp2(fminf(d, 100.f)); kt[c] = kk[j][c] * fexp2(fminf(-d, 100.f)); kd[j][c] = kt[c] * e2[c]; }
            if (cp) { R.qt[j].y = pkbf(qt[0], qt[1]); R.kt[j].y = pkbf(kt[0], kt[1]); } else { R.qt[j].x = pkbf(qt[0], qt[1]); R.kt[j].x = pkbf(kt[0], kt[1]); } }
#pragma unroll
        for (int c = 0; c < 2; ++c) { R.kd[2 * cp + c] = (v2u){pkbf(kd[0][c], kd[1][c]), pkbf(kd[2][c], kd[3][c])};
            unsigned e0, e1, e2b, e3;
            if (cp == 0) { if (c == 0) { e0 = iw[0].x & 0xffffu; e1 = iw[1].x & 0xffffu; e2b = iw[2].x & 0xffffu; e3 = iw[3].x & 0xffffu; } else { e0 = iw[0].x >> 16; e1 = iw[1].x >> 16; e2b = iw[2].x >> 16; e3 = iw[3].x >> 16; } }
            else { if (c == 0) { e0 = iw[0].y & 0xffffu; e1 = iw[1].y & 0xffffu; e2b = iw[2].y & 0xffffu; e3 = iw[3].y & 0xffffu; } else { e0 = iw[0].y >> 16; e1 = iw[1].y >> 16; e2b = iw[2].y >> 16; e3 = iw[3].y >> 16; } }
            R.iv[2 * cp + c] = (v2u){e0 | (e1 << 16), e2b | (e3 << 16)}; }
        __builtin_amdgcn_sched_barrier(0);
    }
}
template <int TT> DI void hg_final(LAS unsigned char* lds, int wave, int lane, const f32x4 (&o)[TT], const v2u (&ogw)[TT], const f32x4 og4, bf16* OB, int rowb, int h);
template <int TT, bool DEFER = false>
DI void hg_stage1(LAS unsigned char* lds, int wave, int lane, const HgRegs& R, f32x4 (&S)[8], f32x4 (&o)[TT], v2u (&ogw)[TT], const bf16* Z, int rowb, int h,
                  int pb = 0  , bool have_prev = false, const f32x4 og4 = (f32x4){0.f, 0.f, 0.f, 0.f}, bf16* OB = nullptr) {
    constexpr int CS = (TT == 4) ? 64 : 32, NG = CS / 4;
    const int bo = pb * HG_BUFSZ;
    const int kql = lane & 3, tg = lane >> 2, k0 = 16 * wave + 4 * kql, i = lane & 15, q = lane >> 4;
    if (tg < NG) {
#pragma unroll
        for (int j = 0; j < 4; ++j) { const int ro = (4 * tg + j) * HP + k0 * 2; *(LAS v2u*)(lds + HG_QT + ro) = R.qt[j]; *(LAS v2u*)(lds + HG_KT + ro) = R.kt[j]; }
#pragma unroll
        for (int c = 0; c < 4; ++c) { *(LAS v2u*)(lds + HG_KDT + bo + (k0 + c) * HPK + 8 * tg) = R.kd[c]; *(LAS v2u*)(lds + HG_IVT + (k0 + c) * HPK + 8 * tg) = R.iv[c]; }
        if (tg == 0) { *(LAS f32x4*)(lds + HG_DEC + bo + k0 * 4) = R.dec; *(LAS f32x4*)(lds + HG_EAR + k0 * 4) = R.ear; }
    }
    LDS_BARRIER();
    if (DEFER && have_prev) hg_final<TT>(lds, wave, lane, o, ogw, og4, OB, rowb - 16 * TT, h);
#pragma unroll
    for (int it = 0; it < TT; ++it) ogw[it] = (TT == 4 || i < 8) ? *(const v2u*)(Z + (size_t)(rowb + 16 * it + i) * NIN + ZOG + h * 128 + 16 * wave + 4 * q) : (v2u){0u, 0u};
    if (TT == 4 || wave == 0) {
        const int it = (TT == 4) ? (wave >> 1) : 0;
#pragma unroll
        for (int is2 = 0; is2 < 2; ++is2) { const int is = ((TT == 4) ? 2 * (wave & 1) : 0) + is2;
            f32x4 sc = {0.f, 0.f, 0.f, 0.f};
#pragma unroll
            for (int ks = 0; ks < 4; ++ks) { const bf16x8 X = *(const LAS bf16x8*)(lds + HG_KT + (16 * is + i) * HP + (32 * ks + 8 * q) * 2), Y = *(const LAS bf16x8*)(lds + HG_QT + (16 * it + i) * HP + (32 * ks + 8 * q) * 2);
                sc = MFMA16(X, Y, sc); }
            const int t = 16 * it + i, s0 = 16 * is + 4 * q;
            *(LAS v2u*)(lds + HG_P + bo + t * HPK + s0 * 2) = (v2u){pkbf(s0 <= t ? sc[0] : 0.f, s0 + 1 <= t ? sc[1] : 0.f), pkbf(s0 + 2 <= t ? sc[2] : 0.f, s0 + 3 <= t ? sc[3] : 0.f)};
        }
    }
    {
        bf16x8 Sf[4];
#pragma unroll
        for (int ks = 0; ks < 4; ++ks) { const f32x4 e0 = *(const LAS f32x4*)(lds + HG_EAR + (32 * ks + 4 * q) * 4), e1 = *(const LAS f32x4*)(lds + HG_EAR + (32 * ks + 16 + 4 * q) * 4);
            const f32x4 a0 = S[2 * ks] * e0, a1 = S[2 * ks + 1] * e1;
            v4u p; p.x = pkbf(a0[0], a0[1]); p.y = pkbf(a0[2], a0[3]); p.z = pkbf(a1[0], a1[1]); p.w = pkbf(a1[2], a1[3]); Sf[ks] = __builtin_bit_cast(bf16x8, p); }
#pragma unroll
        for (int it = 0; it < TT; ++it) { o[it] = (f32x4){0.f, 0.f, 0.f, 0.f};
#pragma unroll
            for (int ks = 0; ks < 4; ++ks) { const v2u lo = *(const LAS v2u*)(lds + HG_QT + (16 * it + i) * HP + (32 * ks + 4 * q) * 2), hi = *(const LAS v2u*)(lds + HG_QT + (16 * it + i) * HP + (32 * ks + 16 + 4 * q) * 2);
                const v4u y = {lo.x, lo.y, hi.x, hi.y}; o[it] = MFMA16(Sf[ks], __builtin_bit_cast(bf16x8, y), o[it]); } }
    }
    bf16x8 IVf[CS / 32];
#pragma unroll
    for (int ss = 0; ss < CS / 32; ++ss) IVf[ss] = *(const LAS bf16x8*)(lds + HG_IVT + (16 * wave + i) * HPK + (32 * ss + 8 * q) * 2);
    LDS_BARRIER();
#pragma unroll
    for (int it = 0; it < TT; ++it)
#pragma unroll
        for (int ss = 0; ss < CS / 32; ++ss) if (TT != 4 || ss <= (it >> 1)) { const bf16x8 Y = *(const LAS bf16x8*)(lds + HG_P + bo + (16 * it + i) * HPK + (32 * ss + 8 * q) * 2); o[it] = MFMA16(IVf[ss], Y, o[it]); }
#pragma unroll
    for (int a = 0; a < 8; ++a) { const f32x4 d = *(const LAS f32x4*)(lds + HG_DEC + bo + (16 * a + 4 * q) * 4); S[a] *= d;
#pragma unroll
        for (int ss = 0; ss < CS / 32; ++ss) { const bf16x8 X = *(const LAS bf16x8*)(lds + HG_KDT + bo + (16 * a + i) * HPK + (32 * ss + 8 * q) * 2); S[a] = MFMA16(X, IVf[ss], S[a]); } }
#pragma unroll
    for (int it = 0; it < TT; ++it) { float p = (o[it][0] * o[it][0] + o[it][1] * o[it][1]) + (o[it][2] * o[it][2] + o[it][3] * o[it][3]); p += lane_get(p, lane ^ 16); p += lane_get(p, lane ^ 32);
        if (q == 0) *(LAS float*)(lds + HG_PART + (wave * 64 + 16 * it + i) * 4) = p; }
}
template <int TT>
DI void hg_final(LAS unsigned char* lds, int wave, int lane, const f32x4 (&o)[TT], const v2u (&ogw)[TT], const f32x4 og4, bf16* OB, int rowb, int h) {
    const int i = lane & 15, q = lane >> 4;
#pragma unroll
    for (int it = 0; it < TT; ++it) { float tot = 0.f;
#pragma unroll
        for (int w = 0; w < 8; ++w) tot += *(const LAS float*)(lds + HG_PART + (w * 64 + 16 * it + i) * 4);
        const float rstd = frsq(tot * (1.f / 128.f) + EPS);
        if (TT == 4 || i < 8) { const v2u g = ogw[it];
            const float r0 = o[it][0] * rstd * og4[0] * bflo(g.x), r1 = o[it][1] * rstd * og4[1] * bfhi(g.x), r2 = o[it][2] * rstd * og4[2] * bflo(g.y), r3 = o[it][3] * rstd * og4[3] * bfhi(g.y);
            *(v2u*)(OB + (size_t)(rowb + 16 * it + i) * 2048 + h * 128 + 16 * wave + 4 * q) = (v2u){pkbf(r0, r1), pkbf(r2, r3)}; } }
}
template <int TT>
DI void hg_stage2(LAS unsigned char* lds, int wave, int lane, const f32x4 (&o)[TT], const v2u (&ogw)[TT], const f32x4 og4, bf16* OB, int rowb, int h) {
    LDS_BARRIER();
    hg_final<TT>(lds, wave, lane, o, ogw, og4, OB, rowb, h);
}
DI void hgrn_prompt_unit(LAS unsigned char* lds, int tid, int wave, int lane, const bf16* Z, bf16* OB, float* s_out,
                         const float* ogain  , const float* lbp  , int l, int h, int row0, int nblk) {
    asm volatile("" : "+v"(tid), "+v"(lane), "+s"(wave));
    const int kql = lane & 3, tg = lane >> 2, k0 = 16 * wave + 4 * kql, i = lane & 15, q = lane >> 4;
    float lb[4], oml[4];
#pragma unroll
    for (int c = 0; c < 4; ++c) { lb[c] = (l == 0) ? 0.f : sigm(lbp[2048 + h * 128 + k0 + c] - lbp[h * 128 + k0 + c]); oml[c] = 1.f - lb[c]; }
    f32x4 S[8];
#pragma unroll
    for (int a = 0; a < 8; ++a) S[a] = (f32x4){0.f, 0.f, 0.f, 0.f};
    const f32x4 og4 = *(const f32x4*)(ogain + 16 * wave + 4 * q);
    v2u qw[4], fw[4], iw[4]; HgRegs R;
    hg_load(Z, row0, h, k0, tg, true, qw, fw, iw);
    hg_elem<16>(qw, fw, iw, lb, oml, true, lane, tg, kql, R);
    if (nblk > 1) hg_load(Z, row0 + 64, h, k0, tg, true, qw, fw, iw);
    f32x4 o[4]; v2u ogw[4];
#pragma unroll
    for (int it = 0; it < 4; ++it) { o[it] = (f32x4){0.f, 0.f, 0.f, 0.f}; ogw[it] = (v2u){0u, 0u}; }
    for (int blk = 0; blk < nblk; ++blk) {
        const int rowb = row0 + blk * 64;
        hg_stage1<4, true>(lds, wave, lane, R, S, o, ogw, Z, rowb, h, blk & 1, blk > 0, og4, OB);
        if (blk + 1 < nblk) { hg_elem<16>(qw, fw, iw, lb, oml, true, lane, tg, kql, R);
            if (blk + 2 < nblk) hg_load(Z, rowb + 128, h, k0, tg, true, qw, fw, iw); }
    }
    hg_stage2<4>(lds, wave, lane, o, ogw, og4, OB, row0 + (nblk - 1) * 64, h);
    { float* sp = s_out + (size_t)(4 * q) * 128 + 16 * wave + i;
#pragma unroll
      for (int a = 0; a < 8; ++a) {
#pragma unroll
          for (int r = 0; r < 4; ++r) __builtin_nontemporal_store(S[a][r], sp + r * 128);
          sp += 16 * 128; } }
    LDS_BARRIER();
}
DI void hgrn_sample_loop(LAS unsigned char* lds, int tid, int wave, int lane, const bf16* Z, bf16* OB, const float* st_in  , float* st_out,
                         const float* hng  , const float* lbp, int l, int su0, int step) {
    asm volatile("" : "+v"(tid), "+v"(lane), "+s"(wave));
    if (su0 >= 2048) return;
    const int kql = lane & 3, tg = lane >> 2, k0 = 16 * wave + 4 * kql, i = lane & 15, q = lane >> 4;
    const bool valid = tg < 2;
    const size_t lo = (size_t)(16 * 0 + 4 * q) * 128 + 16 * wave + i;
    f32x4 A[8], B[8];
    v2u qw[4], fw[4], iw[4]; HgRegs R;
    auto ldstate = [&](f32x4 (&T)[8], int su) { const float* sp = st_in + (size_t)su * 16384 + lo;
#pragma unroll
        for (int a = 0; a < 8; ++a)
#pragma unroll
            for (int r = 0; r < 4; ++r) T[a][r] = __builtin_nontemporal_load(sp + (16 * a + r) * 128); };
    auto unit = [&](int su, f32x4 (&T)[8]) {
        const int h = su & 15, rowb = MP + (su >> 4) * 8, nsu = su + step, n2 = su + 2 * step;
        float lb[4], oml[4];
#pragma unroll
        for (int c = 0; c < 4; ++c) { lb[c] = (l == 0) ? 0.f : sigm(lbp[2048 + h * 128 + k0 + c] - lbp[h * 128 + k0 + c]); oml[c] = 1.f - lb[c]; }
        const f32x4 og4 = *(const f32x4*)(hng + h * 128 + 16 * wave + 4 * q);
        hg_elem<8>(qw, fw, iw, lb, oml, valid, lane, tg, kql, R);
        if (nsu < 2048) hg_load(Z, MP + (nsu >> 4) * 8, nsu & 15, k0, tg, valid, qw, fw, iw);
        f32x4 o[1]; v2u ogw[1];
        hg_stage1<1>(lds, wave, lane, R, T, o, ogw, Z, rowb, h);
        { float* sp = st_out + (size_t)su * 16384 + lo;
#pragma unroll
          for (int a = 0; a < 8; ++a)
#pragma unroll
              for (int r = 0; r < 4; ++r) __builtin_nontemporal_store(T[a][r], sp + (16 * a + r) * 128); }
        if (n2 < 2048) ldstate(T, n2);
        hg_stage2<1>(lds, wave, lane, o, ogw, og4, OB, rowb, h); };
    ldstate(A, su0);
    hg_load(Z, MP + (su0 >> 4) * 8, su0 & 15, k0, tg, valid, qw, fw, iw);
    if (su0 + step < 2048) ldstate(B, su0 + step);
    for (int su = su0; su < 2048; su += 2 * step) {
        unit(su, A);
        if (su + step < 2048) unit(su + step, B);
    }
    LDS_BARRIER();
}

constexpr int MX_VNT = 0, MX_W = 128 * HP, MX_END = 2 * 128 * HP;
static_assert(MX_END <= RING_BYTES, "mixer lds");
DI void mixer_unit(LAS unsigned char* lds, int tid, int wave, int lane, int tt, int g, const bf16* Z, bf16* YA, const float* wsp  , const float* bsp  , const float* vgp  , float* vout  ) {
    asm volatile("" : "+v"(tid), "+v"(lane), "+s"(wave));
    const int r0 = tt * 128; const bool sample = tt >= 64;
    {
        const int cq = tid & 31, sg = tid >> 5, c0 = 4 * cq;
        const f32x4 vg4 = *(const f32x4*)(vgp + c0);
        float vn[8][4];
#pragma unroll
        for (int j = 0; j < 8; ++j) { const int s = 8 * sg + j; const v2u w = *(const v2u*)(Z + (size_t)(r0 + s) * NIN + ZV + g * 128 + c0);
            const float x0 = bflo(w.x), x1 = bfhi(w.x), x2 = bflo(w.y), x3 = bfhi(w.y);
            float ss = (x0 * x0 + x1 * x1) + (x2 * x2 + x3 * x3);
            ss += lane_get(ss, lane ^ 1); ss += lane_get(ss, lane ^ 2); ss += lane_get(ss, lane ^ 4); ss += lane_get(ss, lane ^ 8); ss += lane_get(ss, lane ^ 16);
            const float rstd = frsq(ss * (1.f / 128.f) + EPS);
            vn[j][0] = x0 * rstd * vg4[0]; vn[j][1] = x1 * rstd * vg4[1]; vn[j][2] = x2 * rstd * vg4[2]; vn[j][3] = x3 * rstd * vg4[3];
            if (vout) *(f32x4*)(vout + (size_t)s * 1024 + c0) = (f32x4){vn[j][0], vn[j][1], vn[j][2], vn[j][3]}; }
#pragma unroll
        for (int c = 0; c < 4; ++c) { v4u p; p.x = pkbf(vn[0][c], vn[1][c]); p.y = pkbf(vn[2][c], vn[3][c]); p.z = pkbf(vn[4][c], vn[5][c]); p.w = pkbf(vn[6][c], vn[7][c]);
            *(LAS v4u*)(lds + MX_VNT + (c0 + c) * HP + 16 * sg) = p; }
    }
    {
        const int t = tid >> 2, sq = tid & 3;
#pragma unroll
        for (int jj = 0; jj < 4; ++jj) { const int s0 = sq * 32 + 8 * jj; float x[8];
            if (!sample) { const f32x4 a = *(const f32x4*)(wsp + t * 128 + s0), b = *(const f32x4*)(wsp + t * 128 + s0 + 4);
                x[0] = a[0]; x[1] = a[1]; x[2] = a[2]; x[3] = a[3]; x[4] = b[0]; x[5] = b[1]; x[6] = b[2]; x[7] = b[3];
#pragma unroll
                for (int e = 0; e < 8; ++e) x[e] = (s0 + e <= t) ? x[e] : 0.f; }
            else {
#pragma unroll
                for (int e = 0; e < 8; ++e) { const int s = s0 + e; x[e] = ((s >> 3) == (t >> 3) && (s & 7) <= (t & 7)) ? wsp[(t & 7) * 128 + (s & 7)] : 0.f; } }
            v4u p; p.x = pkbf(x[0], x[1]); p.y = pkbf(x[2], x[3]); p.z = pkbf(x[4], x[5]); p.w = pkbf(x[6], x[7]);
            *(LAS v4u*)(lds + MX_W + t * HP + s0 * 2) = p; }
    }
    LDS_BARRIER();
    const int i = lane & 15, q = lane >> 4;
    f32x4 acc[8];
#pragma unroll
    for (int ct = 0; ct < 8; ++ct) acc[ct] = (f32x4){0.f, 0.f, 0.f, 0.f};
    const int nks = (wave >> 1) + 1;
    for (int ks = 0; ks < nks; ++ks) { const bf16x8 Y = *(const LAS bf16x8*)(lds + MX_W + (16 * wave + i) * HP + (32 * ks + 8 * q) * 2);
#pragma unroll
        for (int ct = 0; ct < 8; ++ct) { const bf16x8 X = *(const LAS bf16x8*)(lds + MX_VNT + (16 * ct + i) * HP + (32 * ks + 8 * q) * 2); acc[ct] = MFMA16(X, Y, acc[ct]); } }
    const int t = 16 * wave + i; const float bias = bsp[sample ? (t & 7) : t];
#pragma unroll
    for (int ct = 0; ct < 8; ++ct) { const int c = g * 128 + 16 * ct + 4 * q; const v2u uw = *(const v2u*)(Z + (size_t)(r0 + t) * NIN + ZU + c);
        const float y0 = bflo(uw.x) * (acc[ct][0] + bias), y1 = bfhi(uw.x) * (acc[ct][1] + bias), y2 = bflo(uw.y) * (acc[ct][2] + bias), y3 = bfhi(uw.y) * (acc[ct][3] + bias);
        *(v2u*)(YA + (size_t)(r0 + t) * 1024 + c) = (v2u){pkbf(y0, y1), pkbf(y2, y3)}; }
    LDS_BARRIER();
}

constexpr int MD_PITCH = 144, MD_WT = 0, MD_AS = 128 * MD_PITCH, MD_BUF = MD_AS + 144 * MD_PITCH;
static_assert(2 * MD_BUF <= RING_BYTES, "mod lds");
DI void mod_direct(LAS unsigned char* lds, int tid, int wave, int lane, int slab, const float* cp, const float* cs, const float* adaw, const float* adab, float* MOD) {
    asm volatile("" : "+v"(tid), "+v"(lane), "+s"(wave));
    const int n0g = slab * 128, l = n0g / 12288, n0 = n0g - l * 12288, i = lane & 15, q = lane >> 4;
    const int wn = tid & 127, wk = tid >> 7;
    const float* W = adaw + (size_t)l * 2048 * 12288 + n0 + wn + (size_t)(16 * wk) * 12288;
    float wv[2][16]; f32x4 av[2][5];
    f32x4 acc[9];
#pragma unroll
    for (int mt = 0; mt < 9; ++mt) acc[mt] = (f32x4){0.f, 0.f, 0.f, 0.f};
#define MD_LOAD(kc, B) do { \
        _Pragma("unroll") for (int kk = 0; kk < 16; ++kk) wv[B][kk] = __builtin_nontemporal_load(W + (size_t)(64 * (kc) + kk) * 12288); \
        _Pragma("unroll") for (int ii = 0; ii < 5; ++ii) { const int idx = tid + 512 * ii, row = idx >> 4, c4 = idx & 15; \
            av[B][ii] = (f32x4){0.f, 0.f, 0.f, 0.f}; \
            if (idx < 2304 && row < NCOND) av[B][ii] = *(const f32x4*)((row < 4 ? cp + (size_t)row * DM : cs + (size_t)(row - 4) * DM) + 64 * (kc) + 4 * c4); } } while (0)
#define MD_STEP(kc, B) do { \
        LAS unsigned char* buf = lds + ((kc) & 1) * MD_BUF; \
        { v4u p0, p1; p0.x = pkbf(wv[B][0], wv[B][1]); p0.y = pkbf(wv[B][2], wv[B][3]); p0.z = pkbf(wv[B][4], wv[B][5]); p0.w = pkbf(wv[B][6], wv[B][7]); \
          p1.x = pkbf(wv[B][8], wv[B][9]); p1.y = pkbf(wv[B][10], wv[B][11]); p1.z = pkbf(wv[B][12], wv[B][13]); p1.w = pkbf(wv[B][14], wv[B][15]); \
          *(LAS v4u*)(buf + MD_WT + wn * MD_PITCH + 32 * wk) = p0; *(LAS v4u*)(buf + MD_WT + wn * MD_PITCH + 32 * wk + 16) = p1; } \
        _Pragma("unroll") for (int ii = 0; ii < 5; ++ii) { const int idx = tid + 512 * ii, row = idx >> 4, c4 = idx & 15; \
            if (idx < 2304) { const f32x4 v = av[B][ii]; \
                *(LAS v2u*)(buf + MD_AS + row * MD_PITCH + 8 * c4) = (v2u){pkbf(v[0] * sigm(v[0]), v[1] * sigm(v[1])), pkbf(v[2] * sigm(v[2]), v[3] * sigm(v[3]))}; } } \
        if ((kc) + 2 < 32) MD_LOAD((kc) + 2, B); \
        LDS_BARRIER(); \
        { bf16x8 X[2]; \
          _Pragma("unroll") for (int ks = 0; ks < 2; ++ks) X[ks] = *(const LAS bf16x8*)(buf + MD_WT + (16 * wave + i) * MD_PITCH + (32 * ks + 8 * q) * 2); \
          _Pragma("unroll") for (int mt = 0; mt < 9; ++mt) \
              _Pragma("unroll") for (int ks = 0; ks < 2; ++ks) { const bf16x8 Y = *(const LAS bf16x8*)(buf + MD_AS + (16 * mt + i) * MD_PITCH + (32 * ks + 8 * q) * 2); acc[mt] = MFMA16(X[ks], Y, acc[mt]); } } } while (0)
    MD_LOAD(0, 0); MD_LOAD(1, 1);
    for (int kc = 0; kc < 32; kc += 2) { MD_STEP(kc, 0); MD_STEP(kc + 1, 1); }
#undef MD_STEP
#undef MD_LOAD
    { const int n = n0g + 16 * wave + 4 * q; const f32x4 bias = *(const f32x4*)(adab + n);
#pragma unroll
      for (int mt = 0; mt < 9; ++mt) { const int cb = 16 * mt + i; if (cb < NCOND) *(f32x4*)(MOD + (size_t)cb * MODP + n) = acc[mt] + bias; } }
    LDS_BARRIER();
}

__global__ void __launch_bounds__(NWAVES * 64, 2) mk_fwd(Args args) {
    extern __shared__ __attribute__((aligned(16))) unsigned char lds_raw[];
    LAS unsigned char* lds = (LAS unsigned char*)lds_raw;
    volatile LAS unsigned* MISC = (volatile LAS unsigned*)(lds + MISC_OFF);
    const int wv0 = __builtin_amdgcn_readfirstlane((int)(threadIdx.x >> 6));
#define IDS() int tid = wv0 * 64 + hw_lane(); asm volatile("" : "+v"(tid)); const int lane = tid & 63, wave = __builtin_amdgcn_readfirstlane(tid >> 6), gw = vcu * NWAVES + wave; (void)lane; (void)gw
    const int G = gridDim.x, bx = blockIdx.x;
    const int vcu = (G % 8 == 0) ? (bx % 8) * (G / 8) + bx / 8 : bx;
    const int NGW = G * NWAVES;
    unsigned char* ws = args.ws;
    gu32* ctl = (gu32*)(ws + WS_CTL);
    for (int u = wv0 * 64 + hw_lane(); u < (LDS_BYTES - LDSCTL_OFF) / 4; u += NWAVES * 64) ((LAS unsigned*)(lds + LDSCTL_OFF))[u] = 0u;
    __syncthreads();
    XcdBarrier bar = xcd_barrier_post((unsigned*)(ctl + CW_BAR), MISC + 8, wv0);
#define GRID_BAR() do { XcdBarrier b_ = bar; int z_ = 0; asm volatile("" : "+s"(z_), "+s"(b_.x)); b_.bar += z_; xcd_barrier(b_); } while (0)

    float* MOD = (float*)(ws + WS_MOD);
    bf16* X = (bf16*)(ws + WS_X); bf16* H = (bf16*)(ws + WS_H); bf16* Z = (bf16*)(ws + WS_Z); bf16* UP = Z;
    bf16* YA = (bf16*)(ws + WS_YA); bf16* OB = (bf16*)(ws + WS_O); bf16* Y = (bf16*)(ws + WS_Y); bf16* ACT = (bf16*)(ws + WS_ACT);
    float* out = args.out; bf16* SLAB = (bf16*)(ws + WS_SLAB); bf16* Xs = X + (size_t)MP * DM;

    {
        IDS();
        for (int slab = bx; slab < 192; slab += G) mod_direct(lds, tid, wave, lane, slab, inp(args, I_CP), inp(args, I_CS), inp(args, I_ADAW), inp(args, I_ADAB), MOD);
        LAS float* scr = (LAS float*)(lds + RING_OFF + wave * 16384);
        constexpr int IT_IN = 32 * 448, IT_BA = 16 * 64, IT_BB = 32 * 64, IT_OUT = 32 * 64, IT_UP = 32 * 352, IT_DN = 88 * 64;
        constexpr int IT_L = IT_IN + IT_BA + IT_BB + IT_OUT + IT_UP + IT_DN;
        auto decode = [&](int it, P0It& d) {
            const int l = it / IT_L; int r = it - l * IT_L;
            if (r < IT_IN) { d = P0It{inp(args, I_WIN) + (size_t)l * 2048 * NIN, NIN, (bf16*)(ws + WS_WIN + l * SZ_WIN), 2048, r}; return; } r -= IT_IN;
            if (r < IT_BA) { d = P0It{inp(args, I_WBA) + (size_t)l * 1024 * 2048, 2048, (bf16*)(ws + WS_WBA + l * SZ_WBA), 1024, r}; return; } r -= IT_BA;
            if (r < IT_BB) { d = P0It{inp(args, I_WBB) + (size_t)l * 2048 * 2048, 2048, (bf16*)(ws + WS_WBB + l * SZ_WBB), 2048, r}; return; } r -= IT_BB;
            if (r < IT_OUT) { d = P0It{inp(args, I_WOUT) + (size_t)l * 2048 * 2048, 2048, (bf16*)(ws + WS_WOUT + l * SZ_WOUT), 2048, r}; return; } r -= IT_OUT;
            if (r < IT_UP) { d = P0It{inp(args, I_WUP) + (size_t)l * 2048 * NUP, NUP, (bf16*)(ws + WS_WUP + l * SZ_WUP), 2048, r}; return; } r -= IT_UP;
            d = P0It{inp(args, I_WDN) + (size_t)l * DFF * 2048, 2048, (bf16*)(ws + WS_WDN + l * SZ_WDN), DFF, r}; };
        { P0It da, db; float va[32], vb[32]; int it = gw;
          if (it < 2 * IT_L) { decode(it, da); p0_item_load(da, lane, va); }
          while (it < 2 * IT_L) {
              int itn = it + NGW; if (itn < 2 * IT_L) { decode(itn, db); p0_item_load(db, lane, vb); }
              p0_item_store(da, scr, lane, va);
              it = itn; if (it >= 2 * IT_L) break;
              itn = it + NGW; if (itn < 2 * IT_L) { decode(itn, da); p0_item_load(da, lane, va); }
              p0_item_store(db, scr, lane, vb);
              it = itn; } }
    }
    GRID_BAR();

    for (int l = 0; l < 2; ++l) {
        int bxl = blockIdx.x; asm volatile("" : "+s"(bxl));
        const float* modl = MOD + (size_t)l * 12288;
        const void* xin_p = (l == 0) ? (const void*)inp(args, I_XP) : (const void*)X; const void* xin_s = (l == 0) ? (const void*)inp(args, I_XS) : (const void*)Xs;
        { IDS(); norm_rows<false>(xin_p, xin_s, l != 0, l != 0, inp(args, I_N1) + l * DM, modl, H, nullptr, gw, NGW, lane, (l == 0) ? nullptr : SLAB, MOD + 5 * DM  , Xs, lds); }
        GRID_BAR();
        {
            pg8::Gemm g{H, (const bf16*)(ws + WS_WIN + l * SZ_WIN), MT, 40 * 256, DM}; pg8::StaticOrder S; S.init(MT, 40 * 256, DM, G, bxl);
            pg8::EpiZ E{Z, NIN, 0};
            pg8::gemm_phase<pg8::EpiZ, pg8::StaticOrder, true, true>(lds + RING_OFF, g, S, E, wv0);
        }
        GRID_BAR();
        {
            IDS();
            const float* hng = inp(args, I_HNG) + l * 2048; const float* lbp = inp(args, I_LB);
            for (int pu = bxl; pu < 64; pu += G) { const int b = pu >> 4, h = pu & 15;
                hgrn_prompt_unit(lds, tid, wave, lane, Z, OB, out + O_HP + ((size_t)(l * 4 + b) * 16 + h) * 16384, hng + h * 128, lbp, l, h, b * 2048, 32); }
            const int nb = (G > 64) ? G - 64 : G, jb = (G > 64) ? bxl - 64 : bxl;
            if (jb >= 0) for (int step = 0; step < 2; ++step) {
                if (((step ^ jb) & 1) == 0) {
                    pg8::Gemm g{H, (const bf16*)(ws + WS_WIN + l * SZ_WIN) + (size_t)40 * 256 * DM, MT, 16 * 256, DM}; pg8::StaticOrder S; S.init(MT, 16 * 256, DM, nb, jb);
                    pg8::EpiZ E{Z, NIN, 40};
                    pg8::gemm_phase<pg8::EpiZ, pg8::StaticOrder, true, true>(lds + RING_OFF, g, S, E, wv0);
                    continue;
                }
                hgrn_sample_loop(lds, tid, wave, lane, Z, OB, inp(args, I_SH) + (size_t)l * 2048 * 16384, out + O_HS + (size_t)l * 2048 * 16384, hng, lbp, l, jb, nb);
                for (int mu = jb; mu < 576; mu += nb) { const int tt = mu % 72, g = mu / 72;
                    float* vout = nullptr;
                    if (tt >= 64) vout = out + O_VS + ((size_t)l * 1024 + (size_t)(tt - 64) * 128) * 1024 + g * 128;
                    else if ((tt & 15) == 15) vout = out + O_VP + ((size_t)(l * 4 + (tt >> 4)) * 128) * 1024 + g * 128;
                    mixer_unit(lds, tid, wave, lane, tt, g, Z, YA, inp(args, I_WS) + (size_t)(l * 8 + g) * 16384, inp(args, I_BS) + (l * 8 + g) * 128, inp(args, I_VG) + l * 1024 + g * 128, vout); }
            }
        }
        GRID_BAR();
        {
            { pg8::SplitOrder S; S.init(1024, 4, G, bxl); pg8::Gemm g{YA, (const bf16*)(ws + WS_WBA + l * SZ_WBA), MT, DM, 1024};
              pg8::EpiSplit<pg8::EpiBranch<false>> E{{Z + ZGA, Y}, SLAB};
              pg8::gemm_phase<pg8::EpiSplit<pg8::EpiBranch<false>>, pg8::SplitOrder, true, true>(lds + RING_OFF, g, S, E, wv0); }
            { pg8::SplitOrder S; S.init(2048, 8, G, bxl); pg8::Gemm g{OB, (const bf16*)(ws + WS_WBB + l * SZ_WBB), MT, DM, 2048};
              pg8::EpiSplit<pg8::EpiBranch<true>> E{{Z + ZGB, Y}, SLAB + 4 * pg8::SLAB_ELEMS};
              pg8::gemm_phase<pg8::EpiSplit<pg8::EpiBranch<true>>, pg8::SplitOrder, true, true>(lds + RING_OFF, g, S, E, wv0); }
        }
        GRID_BAR();
        { IDS();
        for (int it = gw; it < 2 * MS; it += NGW) { const int r = it >> 1, c0 = (it & 1) * 1024 + 8 * lane;
            f32x4 a[2][2], b[2][2];
#pragma unroll
            for (int h = 0; h < 2; ++h) { a[h][0] = (f32x4){0.f, 0.f, 0.f, 0.f}; a[h][1] = a[h][0]; b[h][0] = a[h][0]; b[h][1] = a[h][0]; }
            v4u w[12][2];
#pragma unroll
            for (int s2 = 0; s2 < 12; ++s2)
#pragma unroll
                for (int h = 0; h < 2; ++h) w[s2][h] = *(const v4u*)(SLAB + (size_t)s2 * pg8::SLAB_ELEMS + (size_t)r * DM + c0 + 512 * h);
            const bf16* zr = Z + (size_t)(MP + r) * NIN + c0;
            v4u ga[2], gb[2];
#pragma unroll
            for (int h = 0; h < 2; ++h) { ga[h] = *(const v4u*)(zr + ZGA + 512 * h); gb[h] = *(const v4u*)(zr + ZGB + 512 * h); }
#pragma unroll
            for (int s2 = 0; s2 < 12; ++s2)
#pragma unroll
                for (int h = 0; h < 2; ++h) { const v4u x = w[s2][h]; const f32x4 lo = {bflo(x.x), bfhi(x.x), bflo(x.y), bfhi(x.y)}, hi = {bflo(x.z), bfhi(x.z), bflo(x.w), bfhi(x.w)};
                    if (s2 < 4) { a[h][0] += lo; a[h][1] += hi; } else { b[h][0] += lo; b[h][1] += hi; } }
#pragma unroll
            for (int h = 0; h < 2; ++h) { const v4u p = ga[h], q = gb[h];
                const f32x4 gal = {bflo(p.x), bfhi(p.x), bflo(p.y), bfhi(p.y)}, gah = {bflo(p.z), bfhi(p.z), bflo(p.w), bfhi(p.w)}, gbl = {bflo(q.x), bfhi(q.x), bflo(q.y), bfhi(q.y)}, gbh = {bflo(q.z), bfhi(q.z), bflo(q.w), bfhi(q.w)};
                const f32x4 yl = gal * a[h][0] + gbl * b[h][0], yh = gah * a[h][1] + gbh * b[h][1];
                v4u o; o.x = pkbf(yl.x, yl.y); o.y = pkbf(yl.z, yl.w); o.z = pkbf(yh.x, yh.y); o.w = pkbf(yh.z, yh.w);
                *(v4u*)(Y + (size_t)(MP + r) * DM + c0 + 512 * h) = o; } } }
        GRID_BAR();
        {
            pg8::SplitOrder S; S.init(DM, 8, G, bxl); pg8::Gemm g{Y, (const bf16*)(ws + WS_WOUT + l * SZ_WOUT), MT, DM, DM};
            pg8::EpiSplit<pg8::EpiResid> E{{(const float*)xin_p, X, modl + 2 * DM, l == 0}, SLAB};
            pg8::gemm_phase<pg8::EpiSplit<pg8::EpiResid>, pg8::SplitOrder, true, true>(lds + RING_OFF, g, S, E, wv0);
        }
        GRID_BAR();
        { IDS(); norm_rows<false>(X, xin_s, true, l != 0, inp(args, I_N2) + l * DM, modl + 3 * DM, H, nullptr, gw, NGW, lane, SLAB, modl + 2 * DM, Xs, lds); }
        GRID_BAR();
        {
            pg8::Gemm g{H, (const bf16*)(ws + WS_WUP + l * SZ_WUP), MT, NUP, DM}; pg8::UpOrder S; S.init(G, bxl);
            pg8::EpiUpSplit E{{UP, out + O_CP + (size_t)l * 4 * 2 * NUP, out + O_CS + (size_t)l * 128 * 2 * NUP}, SLAB};
            pg8::gemm_phase<pg8::EpiUpSplit, pg8::UpOrder, true, true>(lds + RING_OFF, g, S, E, wv0);
        }
        GRID_BAR();
        {
            const float* cw = inp(args, I_CW) + (size_t)l * 3 * NUP; const float* cbias = inp(args, I_CB) + (size_t)l * NUP; const float* cst = inp(args, I_SC) + (size_t)l * 128 * 2 * NUP;
            IDS();
            constexpr int NWC = DFF / 512, NRG = MT / 8, NSB = 4;
            const int nseg = NGW / NWC;
            if (gw < nseg * NWC) {
                const int wcb = gw % NWC, sg = gw / NWC, col = (wcb * 64 + lane) * 8;
                constexpr int NPR = MP / 8, NSR = MS / 8;
                const bool wdeal = nseg > NSR && 5 * NSR < NPR;
                const int pr0 = wdeal ? (sg < NSR ? 5 * sg : 5 * NSR + ((sg - NSR) * (NPR - 5 * NSR)) / (nseg - NSR)) : (sg * NPR) / nseg;
                const int pr1 = wdeal ? (sg < NSR ? 5 * sg + 5 : 5 * NSR + ((sg + 1 - NSR) * (NPR - 5 * NSR)) / (nseg - NSR)) : ((sg + 1) * NPR) / nseg;
                float wa[3][8], wb[3][8], ba[8], bb[8];
#pragma unroll
                for (int k = 0; k < 3; ++k) { const f32x4 a0 = *(const f32x4*)(cw + k * NUP + col), a1 = *(const f32x4*)(cw + k * NUP + col + 4), b0 = *(const f32x4*)(cw + k * NUP + DFF + col), b1 = *(const f32x4*)(cw + k * NUP + DFF + col + 4);
#pragma unroll
                    for (int e = 0; e < 4; ++e) { wa[k][e] = a0[e]; wa[k][4 + e] = a1[e]; wb[k][e] = b0[e]; wb[k][4 + e] = b1[e]; } }
                { const f32x4 a0 = *(const f32x4*)(cbias + col), a1 = *(const f32x4*)(cbias + col + 4), b0 = *(const f32x4*)(cbias + DFF + col), b1 = *(const f32x4*)(cbias + DFF + col + 4);
#pragma unroll
                  for (int e = 0; e < 4; ++e) { ba[e] = a0[e]; ba[4 + e] = a1[e]; bb[e] = b0[e]; bb[4 + e] = b1[e]; } }
                const bool slabcols = col >= 2560;
                for (int part = 0;; ++part) {
                int rg0 = pr0, rg1 = pr1;
                if (part > 0) { const int srg = sg + (part - 1) * nseg; if (srg >= NSR) break; rg0 = NPR + srg; rg1 = rg0 + 1; }
                for (int rs = rg0; rs < rg1;) {
                    float pa2[8], pa1[8], pb2[8], pb1[8];
                    const int rb = rs * 8;
                    int re = rs + 1;
                    if (rb >= MP) { const float* s0 = cst + (size_t)((rb - MP) >> 3) * 2 * NUP + col;
#pragma unroll
                        for (int e = 0; e < 8; ++e) { pa2[e] = s0[e]; pa1[e] = s0[NUP + e]; pb2[e] = s0[DFF + e]; pb1[e] = s0[NUP + DFF + e]; } }
                    else {
                        re = ((rs >> 8) + 1) << 8; re = re < rg1 ? re : rg1;
                        if ((rb & 2047) == 0) {
#pragma unroll
                            for (int e = 0; e < 8; ++e) { pa2[e] = 0.f; pa1[e] = 0.f; pb2[e] = 0.f; pb1[e] = 0.f; } }
                        else { const v4u a2 = *(const v4u*)(UP + (size_t)(rb - 2) * NUP + col), a1 = *(const v4u*)(UP + (size_t)(rb - 1) * NUP + col), b2 = *(const v4u*)(UP + (size_t)(rb - 2) * NUP + DFF + col), b1 = *(const v4u*)(UP + (size_t)(rb - 1) * NUP + DFF + col);
#pragma unroll
                            for (int e = 0; e < 4; ++e) { pa2[2 * e] = bflo(a2[e]); pa2[2 * e + 1] = bfhi(a2[e]); pa1[2 * e] = bflo(a1[e]); pa1[2 * e + 1] = bfhi(a1[e]);
                                pb2[2 * e] = bflo(b2[e]); pb2[2 * e + 1] = bfhi(b2[e]); pb1[2 * e] = bflo(b1[e]); pb1[2 * e + 1] = bfhi(b1[e]); } } }
                    for (int rg = rs; rg < re; ++rg) {
                    const int r0 = rg * 8;
                    const bool fromslab = (r0 >= MP) && slabcols;
                    if (!fromslab) {
#pragma unroll
                        for (int jb = 0; jb < 8; jb += 8) {
                        v4u avr[8], bvr[8];
#pragma unroll
                        for (int j = 0; j < 8; ++j) { avr[j] = *(const v4u*)(UP + (size_t)(r0 + jb + j) * NUP + col); bvr[j] = *(const v4u*)(UP + (size_t)(r0 + jb + j) * NUP + DFF + col); }
#pragma unroll
                        for (int jj = 0; jj < 8; ++jj) { const int j = jb + jj; float ca[8], cb2[8], res[8];
#pragma unroll
                            for (int e = 0; e < 4; ++e) { ca[2 * e] = bflo(avr[jj][e]); ca[2 * e + 1] = bfhi(avr[jj][e]); cb2[2 * e] = bflo(bvr[jj][e]); cb2[2 * e + 1] = bfhi(bvr[jj][e]); }
#pragma unroll
                            for (int e = 0; e < 8; ++e) { const float a = ba[e] + wa[0][e] * pa2[e] + wa[1][e] * pa1[e] + wa[2][e] * ca[e]; const float b = bb[e] + wb[0][e] * pb2[e] + wb[1][e] * pb1[e] + wb[2][e] * cb2[e];
                                res[e] = gelu_t(a) * b; pa2[e] = pa1[e]; pa1[e] = ca[e]; pb2[e] = pb1[e]; pb1[e] = cb2[e]; }
                            v4u w; w.x = pkbf(res[0], res[1]); w.y = pkbf(res[2], res[3]); w.z = pkbf(res[4], res[5]); w.w = pkbf(res[6], res[7]);
                            *(v4u*)(ACT + (size_t)(r0 + j) * DFF + col) = w; }
                        asm volatile("" ::: "memory"); }
                    } else
#pragma unroll
                    for (int jb = 0; jb < 8; jb += NSB) {
                        v4u avs[NSB], sls[NSB][4];
#pragma unroll
                        for (int jj = 0; jj < NSB; ++jj) { avs[jj] = *(const v4u*)(UP + (size_t)(r0 + jb + jj) * NUP + col);
                            const bf16* sp = SLAB + (size_t)(r0 - MP + jb + jj) * 3072 + (col - 2560);
#pragma unroll
                            for (int q = 0; q < 4; ++q) sls[jj][q] = *(const v4u*)(sp + q * pg8::UPSLAB_ELEMS); }
#pragma unroll
                        for (int jj = 0; jj < NSB; ++jj) { const int j = jb + jj; const v4u av = avs[jj];
                        float ca[8], cb2[8], res[8];
#pragma unroll
                        for (int e = 0; e < 4; ++e) { ca[2 * e] = bflo(av[e]); ca[2 * e + 1] = bfhi(av[e]); }
                        { f32x4 s0 = {0.f, 0.f, 0.f, 0.f}, s1 = s0;
#pragma unroll
                          for (int q = 0; q < 4; ++q) { const v4u w = sls[jj][q]; s0 += (f32x4){bflo(w.x), bfhi(w.x), bflo(w.y), bfhi(w.y)}; s1 += (f32x4){bflo(w.z), bfhi(w.z), bflo(w.w), bfhi(w.w)}; }
#pragma unroll
                          for (int e = 0; e < 4; ++e) { cb2[e] = s0[e]; cb2[4 + e] = s1[e]; }
                          if (j >= 6) { float* fo = out + O_CS + (size_t)l * 128 * 2 * NUP + (size_t)(((r0 - MP) >> 3) * 2 + (j - 6)) * NUP + DFF + col; *(f32x4*)fo = s0; *(f32x4*)(fo + 4) = s1; } }
#pragma unroll
                        for (int e = 0; e < 8; ++e) { const float a = ba[e] + wa[0][e] * pa2[e] + wa[1][e] * pa1[e] + wa[2][e] * ca[e]; const float b = bb[e] + wb[0][e] * pb2[e] + wb[1][e] * pb1[e] + wb[2][e] * cb2[e];
                            res[e] = gelu_t(a) * b; pa2[e] = pa1[e]; pa1[e] = ca[e]; pb2[e] = pb1[e]; pb1[e] = cb2[e]; }
                        v4u w; w.x = pkbf(res[0], res[1]); w.y = pkbf(res[2], res[3]); w.z = pkbf(res[4], res[5]); w.w = pkbf(res[6], res[7]);
                        *(v4u*)(ACT + (size_t)(r0 + j) * DFF + col) = w; }
                        asm volatile("" ::: "memory"); }
                    }
                    rs = re;
                }
                }
            }
        }
        GRID_BAR();
        {
            pg8::Gemm g{ACT, (const bf16*)(ws + WS_WDN + l * SZ_WDN), MT, DM, DFF}; pg8::SplitOrder S; S.init(DFF, 8, G, bxl);
            pg8::EpiSplit<pg8::EpiResid> E{{nullptr, X, modl + 5 * DM, false}, SLAB};
            pg8::gemm_phase<pg8::EpiSplit<pg8::EpiResid>, pg8::SplitOrder, true, true>(lds + RING_OFF, g, S, E, wv0);
        }
        GRID_BAR();
    }
    { IDS(); norm_rows<true>(X, Xs, true, true, inp(args, I_FNG), nullptr, nullptr, out, gw, NGW, lane, SLAB, MOD + 12288 + 5 * DM  , nullptr, lds); }
}

extern "C" void kernel_launch(void* const* d_in, const int* in_sizes, int n_in, void* d_out, int out_size, void* d_ws, size_t ws_size, hipStream_t stream) {
    static int grid = 0;
    if (grid == 0) {
        if (n_in != 24 || (size_t)out_size != O_END || ws_size < WS_END) { fprintf(stderr, "kernel_launch: unexpected shapes (n_in %d, out %d, ws %zu); nothing launched\n", n_in, out_size, ws_size); grid = -1; return; }
        int dev = 0, cus = 0, per_cu = 0;
        if (hipGetDevice(&dev) != hipSuccess || hipDeviceGetAttribute(&cus, hipDeviceAttributeMultiprocessorCount, dev) != hipSuccess) { grid = -1; return; }
        if (hipFuncSetAttribute((const void*)mk_fwd, hipFuncAttributeMaxDynamicSharedMemorySize, LDS_BYTES) != hipSuccess) { fprintf(stderr, "kernel_launch: hipFuncSetAttribute failed\n"); grid = -1; return; }
        if (hipOccupancyMaxActiveBlocksPerMultiprocessor(&per_cu, (const void*)mk_fwd, NWAVES * 64, LDS_BYTES) != hipSuccess || per_cu < 1) { fprintf(stderr, "kernel_launch: occupancy query reports %d blocks per CU\n", per_cu); }
        (void)hipGetLastError();
        grid = cus;
    }
    if (grid < 0) return;
    if (hipMemsetAsync((char*)d_ws + WS_CTL, 0, CTL_ZERO_BYTES, stream) != hipSuccess) return;
    Args a{};
    for (int i = 0; i < 24; ++i) a.in[i] = (const float*)d_in[i];
    a.out = (float*)d_out; a.ws = (unsigned char*)d_ws;
    hipLaunchKernelGGL(mk_fwd, dim3(grid), dim3(NWAVES * 64), LDS_BYTES, stream, a);
}
```

```cpp
#include <hip/hip_runtime.h>
#include <cstdio>
#include <cstdint>
__device__ __forceinline__ int hw_lane() { int l; asm volatile("v_mbcnt_lo_u32_b32 %0, -1, 0\n\tv_mbcnt_hi_u32_b32 %0, -1, %0" : "=v"(l)); return l; }
namespace pg8 {
#define PG8_LAS __attribute__((address_space(3)))
typedef unsigned short bf16_t;
typedef short bf16x8 __attribute__((ext_vector_type(8)));
typedef float f32x4 __attribute__((ext_vector_type(4)));
typedef unsigned u32x4 __attribute__((ext_vector_type(4)));
constexpr int BM = 256, BK = 64, HALF = 128, HTB = HALF * BK * 2  , STAGE_BYTES = 8 * HTB, NXCD = 8, WGM = 4;

__host__ __device__ __forceinline__ int lds_byte(int r, int c) { const int st = (r >> 4) * 2 + (c >> 5), rr = r & 15, cc = c & 31, ob = rr * 64 + cc * 2; return st * 1024 + (ob ^ (((ob >> 9) & 1) << 5)); }
__host__ __device__ __forceinline__ void stage_rc(int b, int& R, int& C) { const int st = b / 1024, sb = b % 1024, swz = sb ^ (((sb >> 9) & 1) << 5); R = (st >> 1) * 16 + swz / 64; C = (st & 1) * 32 + (swz % 64) / 2; }
__host__ __device__ __forceinline__ int perm32(int rho) { const int n = rho >> 4, i = rho & 15; return 8 * (i >> 2) + 4 * n + (i & 3); }

struct Unit { int pm, pn, kt0, nkt, aux; };
struct Gemm { const bf16_t* A; const bf16_t* Bt; int M, N, K; };

struct StaticOrder {
    static constexpr bool PARTS = false;
    int nM, nN, nwg, G, c, nkt;
    __host__ __device__ __forceinline__ void init(int M, int N, int K, int G_, int c_) { nM = M / BM; nN = N / BM; nwg = nM * nN; G = G_; c = c_; nkt = K / BK; }
    __host__ __device__ __forceinline__ bool next(int i, Unit& u) const {
        const long L = (long)i * G + c; if (L >= nwg) return false;
        int wgid = (int)L; { const int q = nwg / NXCD, r = nwg % NXCD, xcd = wgid % NXCD, off = wgid / NXCD; wgid = (xcd < r ? xcd * (q + 1) : r * (q + 1) + (xcd - r) * q) + off; }
        const int nig = WGM * nN, gid = wgid / nig, fm = gid * WGM, gsz = (nM - fm) < WGM ? (nM - fm) : WGM;
        u.pm = fm + ((wgid % nig) % gsz); u.pn = (wgid % nig) / gsz; u.kt0 = 0; u.nkt = nkt; u.aux = -1; return true;
    }
    __device__ __forceinline__ void a_ready(const Unit&) const {}
    __device__ __forceinline__ void done(const Unit&) const {}
};

__device__ __forceinline__ unsigned cvt_pk_bf16(float lo, float hi) { unsigned r; asm volatile("v_cvt_pk_bf16_f32 %0, %1, %2" : "=v"(r) : "v"(lo), "v"(hi)); return r; }
typedef float f32x2 __attribute__((ext_vector_type(2)));
typedef unsigned u32x2 __attribute__((ext_vector_type(2)));
typedef float f32x2 __attribute__((ext_vector_type(2)));
typedef __bf16 bf2_t __attribute__((ext_vector_type(2)));
__device__ __forceinline__ unsigned pkbf(float lo, float hi) { f32x2 v = {lo, hi}; return __builtin_bit_cast(unsigned, __builtin_convertvector(v, bf2_t)); }
__device__ __forceinline__ float bflo(unsigned w) { return __builtin_bit_cast(float, w << 16); }
__device__ __forceinline__ float bfhi(unsigned w) { return __builtin_bit_cast(float, w & 0xffff0000u); }
__device__ __forceinline__ float sigm(float x) { return __builtin_amdgcn_rcpf(1.f + __builtin_amdgcn_exp2f(-1.44269504089f * x)); }
__device__ __forceinline__ float gelu_t(float x) { const float u = x * (1.f + 0.044715f * x * x); return x * sigm(1.59576912161f * u); }

struct EpiF32 {
    static constexpr bool PERM = false, AFTER_DRAIN = false, HAS_MID = false;
    float* C; int ldc; const float* bias;
    __device__ __forceinline__ void operator()(const f32x4 (&acc)[2][2][4][2], const Unit& u, int wr, int wc, int fr, int fq) const {
        const int row0 = u.pm * BM + wr * 64 + fr, col0 = u.pn * BM + wc * 32 + 4 * fq;
        f32x4 bv[2][2];
#pragma unroll
        for (int bj = 0; bj < 2; ++bj)
#pragma unroll
            for (int n = 0; n < 2; ++n) bv[bj][n] = *(const f32x4*)(bias + col0 + bj * HALF + n * 16);
#pragma unroll
        for (int ai = 0; ai < 2; ++ai)
#pragma unroll
            for (int m = 0; m < 4; ++m) { float* rowp = C + (size_t)(row0 + ai * HALF + m * 16) * ldc + col0;
#pragma unroll
                for (int bj = 0; bj < 2; ++bj)
#pragma unroll
                    for (int n = 0; n < 2; ++n) *(f32x4*)(rowp + bj * HALF + n * 16) = acc[ai][bj][m][n] + bv[bj][n]; }
    }
};
template <int MODE> __device__ __forceinline__ float zact(float x) {
    if (MODE == 0) return gelu_t(x);
    if (MODE == 1) return x * sigm(x) * 0.08838834764831845f;
    if (MODE == 2) return x;
    if (MODE == 3) return x * sigm(x);
    return sigm(x);
}
struct EpiZ {
    static constexpr bool PERM = true, AFTER_DRAIN = false, HAS_MID = false;
    bf16_t* Z; int ldc; int pn_off;
    template <int MODE> __device__ __forceinline__ void run(const f32x4 (&acc)[2][2][4][2], const Unit& u, int wr, int wc, int fr, int fq) const {
        const int row0 = u.pm * BM + wr * 64 + fr, col0 = (u.pn + pn_off) * BM + wc * 32 + 8 * fq;
#pragma unroll
        for (int ai = 0; ai < 2; ++ai)
#pragma unroll
            for (int m = 0; m < 4; ++m) { bf16_t* rowp = Z + (size_t)(row0 + ai * HALF + m * 16) * ldc + col0;
#pragma unroll
                for (int bj = 0; bj < 2; ++bj) { const f32x4 v0 = acc[ai][bj][m][0], v1 = acc[ai][bj][m][1];
                    u32x4 w; w.x = pkbf(zact<MODE>(v0[0]), zact<MODE>(v0[1])); w.y = pkbf(zact<MODE>(v0[2]), zact<MODE>(v0[3]));
                    w.z = pkbf(zact<MODE>(v1[0]), zact<MODE>(v1[1])); w.w = pkbf(zact<MODE>(v1[2]), zact<MODE>(v1[3]));
                    *(u32x4*)(rowp + bj * HALF) = w; } }
    }
    __device__ __forceinline__ void operator()(const f32x4 (&acc)[2][2][4][2], const Unit& u, int wr, int wc, int fr, int fq) const {
        const int pn = u.pn + pn_off;
        if (pn < 8) run<0>(acc, u, wr, wc, fr, fq);
        else if (pn < 16) run<1>(acc, u, wr, wc, fr, fq);
        else if (pn < 32) run<2>(acc, u, wr, wc, fr, fq);
        else if (pn < 40) run<3>(acc, u, wr, wc, fr, fq);
        else run<4>(acc, u, wr, wc, fr, fq);
    }
};
template <bool SECOND> struct EpiBranch {
    static constexpr bool PERM = true, AFTER_DRAIN = false, HAS_MID = false;
    const bf16_t* Zg; bf16_t* Y;
    __device__ __forceinline__ void operator()(const f32x4 (&acc)[2][2][4][2], const Unit& u, int wr, int wc, int fr, int fq) const {
        const int row0 = u.pm * BM + wr * 64 + fr, col0 = u.pn * BM + wc * 32 + 8 * fq;
#pragma unroll
        for (int ai = 0; ai < 2; ++ai) {
            u32x4 gt[4][2], pv[4][2];
#pragma unroll
            for (int m = 0; m < 4; ++m) { const size_t row = (size_t)(row0 + ai * HALF + m * 16);
#pragma unroll
                for (int bj = 0; bj < 2; ++bj) { gt[m][bj] = *(const u32x4*)(Zg + row * 14336 + col0 + bj * HALF); if (SECOND) pv[m][bj] = *(const u32x4*)(Y + row * 2048 + col0 + bj * HALF); } }
#pragma unroll
            for (int m = 0; m < 4; ++m) { bf16_t* yr = Y + (size_t)(row0 + ai * HALF + m * 16) * 2048 + col0;
#pragma unroll
                for (int bj = 0; bj < 2; ++bj) { const u32x4 g = gt[m][bj]; const f32x4 v0 = acc[ai][bj][m][0], v1 = acc[ai][bj][m][1];
                    float r[8] = {v0[0] * bflo(g.x), v0[1] * bfhi(g.x), v0[2] * bflo(g.y), v0[3] * bfhi(g.y), v1[0] * bflo(g.z), v1[1] * bfhi(g.z), v1[2] * bflo(g.w), v1[3] * bfhi(g.w)};
                    if (SECOND) { const u32x4 p = pv[m][bj];
                        r[0] += bflo(p.x); r[1] += bfhi(p.x); r[2] += bflo(p.y); r[3] += bfhi(p.y); r[4] += bflo(p.z); r[5] += bfhi(p.z); r[6] += bflo(p.w); r[7] += bfhi(p.w); }
                    u32x4 w; w.x = pkbf(r[0], r[1]); w.y = pkbf(r[2], r[3]); w.z = pkbf(r[4], r[5]); w.w = pkbf(r[6], r[7]);
                    *(u32x4*)(yr + bj * HALF) = w; } }
            asm volatile("" ::: "memory"); }
    }
};
struct EpiResid {
    static constexpr bool PERM = true, AFTER_DRAIN = false, HAS_MID = false;
    const float* base_f; bf16_t* X; const float* gate; bool f32base;
    __device__ __forceinline__ void operator()(const f32x4 (&acc)[2][2][4][2], const Unit& u, int wr, int wc, int fr, int fq) const {
        const int row0 = u.pm * BM + wr * 64 + fr, col0 = u.pn * BM + wc * 32 + 8 * fq;
        f32x4 gv[2][2];
#pragma unroll
        for (int bj = 0; bj < 2; ++bj)
#pragma unroll
            for (int n = 0; n < 2; ++n) gv[bj][n] = *(const f32x4*)(gate + (size_t)(u.pm >> 3) * 24576 + col0 + bj * HALF + n * 4);
        if (f32base) {
#pragma unroll
            for (int am = 0; am < 4; ++am) { const int ai = am >> 1, m0 = (am & 1) * 2;
                f32x4 bs[2][2][2];
#pragma unroll
                for (int m = 0; m < 2; ++m) { const float* bp = base_f + (size_t)(row0 + ai * HALF + (m0 + m) * 16) * 2048 + col0;
#pragma unroll
                    for (int bj = 0; bj < 2; ++bj)
#pragma unroll
                        for (int n = 0; n < 2; ++n) bs[m][bj][n] = *(const f32x4*)(bp + bj * HALF + n * 4); }
#pragma unroll
                for (int m = 0; m < 2; ++m) { bf16_t* xo = X + (size_t)(row0 + ai * HALF + (m0 + m) * 16) * 2048 + col0;
#pragma unroll
                    for (int bj = 0; bj < 2; ++bj) { const f32x4 v0 = bs[m][bj][0] + gv[bj][0] * acc[ai][bj][m0 + m][0], v1 = bs[m][bj][1] + gv[bj][1] * acc[ai][bj][m0 + m][1];
                        u32x4 w; w.x = pkbf(v0[0], v0[1]); w.y = pkbf(v0[2], v0[3]); w.z = pkbf(v1[0], v1[1]); w.w = pkbf(v1[2], v1[3]);
                        *(u32x4*)(xo + bj * HALF) = w; } }
                asm volatile("" ::: "memory"); }
        } else {
#pragma unroll
            for (int ai = 0; ai < 2; ++ai) {
                u32x4 bs[4][2];
#pragma unroll
                for (int m = 0; m < 4; ++m) { const bf16_t* bp = X + (size_t)(row0 + ai * HALF + m * 16) * 2048 + col0;
#pragma unroll
                    for (int bj = 0; bj < 2; ++bj) bs[m][bj] = *(const u32x4*)(bp + bj * HALF); }
#pragma unroll
                for (int m = 0; m < 4; ++m) { bf16_t* xo = X + (size_t)(row0 + ai * HALF + m * 16) * 2048 + col0;
#pragma unroll
                    for (int bj = 0; bj < 2; ++bj) { const u32x4 p = bs[m][bj]; const f32x4 a0 = acc[ai][bj][m][0], a1 = acc[ai][bj][m][1], g0 = gv[bj][0], g1 = gv[bj][1];
                        u32x4 w; w.x = pkbf(bflo(p.x) + g0[0] * a0[0], bfhi(p.x) + g0[1] * a0[1]); w.y = pkbf(bflo(p.y) + g0[2] * a0[2], bfhi(p.y) + g0[3] * a0[3]);
                        w.z = pkbf(bflo(p.z) + g1[0] * a1[0], bfhi(p.z) + g1[1] * a1[1]); w.w = pkbf(bflo(p.w) + g1[2] * a1[2], bfhi(p.w) + g1[3] * a1[3]);
                        *(u32x4*)(xo + bj * HALF) = w; } }
                asm volatile("" ::: "memory"); }
        }
    }
};
struct EpiUp {
    static constexpr bool PERM = true, AFTER_DRAIN = false, HAS_MID = false;
    bf16_t* UP; float* outp; float* outs;
    __device__ __forceinline__ void operator()(const f32x4 (&acc)[2][2][4][2], const Unit& u, int wr, int wc, int fr, int fq) const {
        const int row0 = u.pm * BM + wr * 64 + fr, col0 = u.pn * BM + wc * 32 + 8 * fq;
#pragma unroll
        for (int ai = 0; ai < 2; ++ai)
#pragma unroll
            for (int m = 0; m < 4; ++m) { const int row = row0 + ai * HALF + m * 16; bf16_t* rowp = UP + (size_t)row * 11264 + col0;
                float* fo = nullptr;
                if (row < 8192) { const int t = row & 2047; if (t >= 2046) fo = outp + (size_t)((row >> 11) * 2 + (t - 2046)) * 11264 + col0; }
                else { const int rr = row - 8192, t = rr & 7; if (t >= 6) fo = outs + (size_t)((rr >> 3) * 2 + (t - 6)) * 11264 + col0; }
#pragma unroll
                for (int bj = 0; bj < 2; ++bj) { const f32x4 v0 = acc[ai][bj][m][0], v1 = acc[ai][bj][m][1];
                    u32x4 w; w.x = pkbf(v0[0], v0[1]); w.y = pkbf(v0[2], v0[3]); w.z = pkbf(v1[0], v1[1]); w.w = pkbf(v1[2], v1[3]);
                    *(u32x4*)(rowp + bj * HALF) = w;
                    if (fo) { *(f32x4*)(fo + bj * HALF) = v0; *(f32x4*)(fo + bj * HALF + 4) = v1; } } }
    }
};

struct SplitOrder {
    static constexpr bool PARTS = true;
    int G, c, S, nkt_full;
    __device__ __forceinline__ void init(int K, int S_, int G_, int c_) { G = G_; c = c_; S = S_; nkt_full = K / BK; }
    __device__ __forceinline__ bool next(int i, Unit& u) const {
        const int rot = (G == 256) ? (((c & 7) * nkt_full) >> 3) & ~1 : 0, two = rot > 0 ? 1 : 0;
        const int io = (i == 0) ? 0 : i - two;
        const int L = io * G + c;
        if (L >= 256 + 32 * S) return false;
        const bool pr = L < 256;
        const int wgid = (L & 7) * 32 + ((L >> 3) & 31);
        const int sl = L - 256, tile = sl & 31, s = sl >> 5;
        const int base = (nkt_full / (2 * S)) * 2, rem = (nkt_full - base * S) / 2;
        u.pm = pr ? ((wgid >> 6) * 8 + (wgid & 7)) : 32 + (tile >> 3);
        u.pn = pr ? ((wgid & 63) >> 3) : (tile & 7);
        const bool first = two && i == 0, second = two && i == 1;
        u.kt0 = pr ? (first ? rot : 0) : s * base + 2 * (s < rem ? s : rem);
        u.nkt = pr ? (first ? nkt_full - rot : (second ? rot : nkt_full)) : base + (s < rem ? 2 : 0);
        u.aux = pr ? (first ? -2 : -1) : s;
        return true;
    }
    __device__ __forceinline__ void a_ready(const Unit&) const {}
    __device__ __forceinline__ void done(const Unit&) const {}
};
constexpr size_t SLAB_ELEMS = (size_t)1024 * 2048 + 2560;
template <class Full> struct EpiSplit {
    static constexpr bool PERM = Full::PERM, AFTER_DRAIN = false, HAS_MID = false;
    Full full; bf16_t* slab;
    __device__ __forceinline__ void operator()(const f32x4 (&acc)[2][2][4][2], const Unit& u, int wr, int wc, int fr, int fq) const {
        if (u.aux < 0) { full(acc, u, wr, wc, fr, fq); return; }
        bf16_t* P = slab + (size_t)u.aux * SLAB_ELEMS;
        const int row0 = (u.pm - 32) * BM + wr * 64 + fr, col0 = u.pn * BM + wc * 32 + (PERM ? 8 * fq : 4 * fq);
#pragma unroll
        for (int ai = 0; ai < 2; ++ai)
#pragma unroll
            for (int m = 0; m < 4; ++m) { bf16_t* rowp = P + (size_t)(row0 + ai * HALF + m * 16) * 2048 + col0;
#pragma unroll
                for (int bj = 0; bj < 2; ++bj) {
                    if (PERM) { const f32x4 v0 = acc[ai][bj][m][0], v1 = acc[ai][bj][m][1]; u32x4 w; w.x = pkbf(v0[0], v0[1]); w.y = pkbf(v0[2], v0[3]); w.z = pkbf(v1[0], v1[1]); w.w = pkbf(v1[2], v1[3]); *(u32x4*)(rowp + bj * HALF) = w; }
                    else {
#pragma unroll
                        for (int n = 0; n < 2; ++n) { const f32x4 v = acc[ai][bj][m][n]; u32x2 w; w.x = pkbf(v[0], v[1]); w.y = pkbf(v[2], v[3]); *(u32x2*)(rowp + bj * HALF + 16 * n) = w; } } } }
    }
};
struct UpOrder {
    static constexpr bool PARTS = false;
    StaticOrder P; int G, c;
    __device__ __forceinline__ void init(int G_, int c_) { P.init(8192, 11264, 2048, G_, c_); G = G_; c = c_; }
    __device__ __forceinline__ bool next(int i, Unit& u) const {
        const int L = i * G + c;
        if (L >= 1536 + 192) return false;
        Unit up; const bool inP = P.next(i, up);
        const int x = L - 1408, sl = L - 1536, tile = sl % 48, s = sl / 48;
        const bool smp = !inP && L < 1536;
        u.pm = inP ? up.pm : (smp ? 32 + (x & 3) : 32 + (tile & 3));
        u.pn = inP ? up.pn : (smp ? (x >> 2) : 32 + (tile >> 2));
        u.kt0 = (inP || smp) ? 0 : 8 * s; u.nkt = (inP || smp) ? 32 : 8; u.aux = (inP || smp) ? -1 : s;
        return true;
    }
    __device__ __forceinline__ void a_ready(const Unit&) const {}
    __device__ __forceinline__ void done(const Unit&) const {}
};
constexpr size_t UPSLAB_ELEMS = (size_t)1024 * 3072 + 2560;
struct EpiUpSplit {
    static constexpr bool PERM = true, AFTER_DRAIN = false, HAS_MID = false;
    EpiUp full; bf16_t* slab;
    __device__ __forceinline__ void operator()(const f32x4 (&acc)[2][2][4][2], const Unit& u, int wr, int wc, int fr, int fq) const {
        if (u.aux < 0) { full(acc, u, wr, wc, fr, fq); return; }
        bf16_t* P = slab + (size_t)u.aux * UPSLAB_ELEMS;
        const int row0 = (u.pm - 32) * BM + wr * 64 + fr, col0 = (u.pn - 32) * BM + wc * 32 + 8 * fq;
#pragma unroll
        for (int ai = 0; ai < 2; ++ai)
#pragma unroll
            for (int m = 0; m < 4; ++m) { bf16_t* rowp = P + (size_t)(row0 + ai * HALF + m * 16) * 3072 + col0;
#pragma unroll
                for (int bj = 0; bj < 2; ++bj) { const f32x4 v0 = acc[ai][bj][m][0], v1 = acc[ai][bj][m][1]; u32x4 w; w.x = pkbf(v0[0], v0[1]); w.y = pkbf(v0[2], v0[3]); w.z = pkbf(v1[0], v1[1]); w.w = pkbf(v1[2], v1[3]); *(u32x4*)(rowp + bj * HALF) = w; } }
    }
};
template <class Epi, class Sched, bool ALIGN_EPI = false, bool SP2 = false>
__device__ __forceinline__ void gemm_phase(PG8_LAS unsigned char* lds, const Gemm g, const Sched& S, const Epi& E, const int wv0) {
    int tid_ = wv0 * 64 + hw_lane(); asm volatile("" : "+v"(tid_));
    const int tid = tid_, wid = __builtin_amdgcn_readfirstlane(tid >> 6), lane = tid & 63, wr = wid >> 2, wc = wid & 3, fr = lane & 15, fq = lane >> 4;
    const int K = g.K;
    unsigned voffA[2], voffB[2];
#pragma unroll
    for (int i = 0; i < 2; ++i) { int R, C; stage_rc(tid * 16 + i * 8192, R, C); const int Rb = Epi::PERM ? ((R & ~31) + perm32(R & 31)) : R;
        voffA[i] = (unsigned)(R * K + C) * 2u; voffB[i] = (unsigned)(Rb * K + C) * 2u; }
    const size_t kstep = (size_t)(BK * 2);
    const size_t hstep = (size_t)HALF * K * 2;
    const size_t tstep = 2 * hstep;
    const unsigned ldsw = (unsigned)wid * 1024u;
    const int aoff = lds_byte(wr * 64 + fr, fq * 8), boff = lds_byte(wc * 32 + fr, fq * 8);
#define PG8_SA(b, h) (((b) * 2 + (h)) * HTB)
#define PG8_SB(b, h) ((4 + (b) * 2 + (h)) * HTB)
#define PG8_STAGE(bufoff, gbase, voff) do { _Pragma("unroll") for (int _i = 0; _i < 2; ++_i) \
        __builtin_amdgcn_global_load_lds((const unsigned*)((const char*)(gbase) + (voff)[_i]), (PG8_LAS unsigned*)(lds + (bufoff) + ldsw + _i * 8192), 16, 0, 0); } while (0)
#define PG8_LDA(dst, b, h) do { _Pragma("unroll") for (int m = 0; m < 4; ++m) _Pragma("unroll") for (int k = 0; k < 2; ++k) dst[m][k] = *(const PG8_LAS bf16x8*)(lds + PG8_SA(b, h) + aoff + m * 2048 + k * 1024); } while (0)
#define PG8_LDB(dst, b, h) do { _Pragma("unroll") for (int n = 0; n < 2; ++n) _Pragma("unroll") for (int k = 0; k < 2; ++k) dst[n][k] = *(const PG8_LAS bf16x8*)(lds + PG8_SB(b, h) + boff + n * 2048 + k * 1024); } while (0)
#define PG8_MMA(ai, bj, At, Bt) do { __builtin_amdgcn_s_setprio(1); _Pragma("unroll") for (int m = 0; m < 4; ++m) _Pragma("unroll") for (int n = 0; n < 2; ++n) _Pragma("unroll") for (int k = 0; k < 2; ++k) \
        acc[ai][bj][m][n] = __builtin_amdgcn_mfma_f32_16x16x32_bf16(Bt[n][k], At[m][k], acc[ai][bj][m][n], 0, 0, 0); __builtin_amdgcn_s_setprio(0); } while (0)
#define PG8_WAIT_V(n) asm volatile("s_waitcnt vmcnt(" #n ")" ::: "memory")
#define PG8_WAIT_L(n) asm volatile("s_waitcnt lgkmcnt(" #n ")" ::: "memory")
#define PG8_BAR __builtin_amdgcn_s_barrier()
#define PG8_SCHED __builtin_amdgcn_sched_barrier(0)
    Unit cur, nxt; int ui = 0;
    if (!S.next(0, cur)) return;
    f32x4 acc[2][2][4][2];
#pragma unroll
    for (int a = 0; a < 2; ++a)
#pragma unroll
        for (int b = 0; b < 2; ++b)
#pragma unroll
            for (int m = 0; m < 4; ++m)
#pragma unroll
                for (int n = 0; n < 2; ++n) acc[a][b][m][n] = (f32x4){0.f, 0.f, 0.f, 0.f};
    bf16x8 At[4][2], B0[2][2], B1[2][2];
    const char* cA = (const char*)g.A + (size_t)cur.pm * tstep + (size_t)cur.kt0 * kstep; const char* cB = (const char*)g.Bt + (size_t)cur.pn * tstep + (size_t)cur.kt0 * kstep;
    S.a_ready(cur);
    if constexpr (SP2) {
        PG8_STAGE(PG8_SB(0, 0), cB, voffB); PG8_STAGE(PG8_SB(0, 1), cB + hstep, voffB); PG8_STAGE(PG8_SA(0, 0), cA, voffA); PG8_STAGE(PG8_SA(0, 1), cA + hstep, voffA);
        if (wr == 1) PG8_BAR;
        PG8_WAIT_V(2); PG8_BAR;
        PG8_STAGE(PG8_SB(1, 0), cB + kstep, voffB); PG8_STAGE(PG8_SA(1, 0), cA + kstep, voffA); PG8_STAGE(PG8_SB(1, 1), cB + hstep + kstep, voffB);
        PG8_WAIT_V(6); PG8_BAR;
    } else {
        PG8_STAGE(PG8_SB(0, 0), cB, voffB); PG8_STAGE(PG8_SA(0, 0), cA, voffA); PG8_STAGE(PG8_SB(0, 1), cB + hstep, voffB); PG8_STAGE(PG8_SA(0, 1), cA + hstep, voffA);
        if (wr == 1) PG8_BAR;
        PG8_WAIT_V(4); PG8_BAR;
        PG8_STAGE(PG8_SB(1, 0), cB + kstep, voffB); PG8_STAGE(PG8_SA(1, 0), cA + kstep, voffA); PG8_STAGE(PG8_SB(1, 1), cB + hstep + kstep, voffB);
        PG8_WAIT_V(6); PG8_BAR;
    }
    for (;;) {
        const bool has_next = S.next(ui + 1, nxt);
        const char* nA = has_next ? (const char*)g.A + (size_t)nxt.pm * tstep + (size_t)nxt.kt0 * kstep : cA; const char* nB = has_next ? (const char*)g.Bt + (size_t)nxt.pn * tstep + (size_t)nxt.kt0 * kstep : cB;
        const int nt = cur.nkt;
        for (int t = 0; t < nt; t += 2) {
            if constexpr (Epi::HAS_MID) { if (t == E.tmid) E.mid(acc, cur, wr, wc, fr, fq); }
            const bool last = (t == nt - 2);
            const char* a1 = cA + (size_t)(t + 1) * kstep;
            const char* a2 = last ? nA : cA + (size_t)(t + 2) * kstep; const char* b2 = last ? nB : cB + (size_t)(t + 2) * kstep;
            const char* a3 = a2 + kstep; const char* b3 = b2 + kstep;
            if (last && has_next) S.a_ready(nxt);
            if constexpr (SP2) {
            PG8_LDB(B0, 0, 0); PG8_LDB(B1, 0, 1); PG8_SCHED; PG8_LDA(At, 0, 0); PG8_STAGE(PG8_SA(1, 1), a1 + hstep, voffA);
            PG8_WAIT_V(8); PG8_WAIT_L(0); PG8_BAR; PG8_MMA(0, 0, At, B0); PG8_MMA(0, 1, At, B1); PG8_BAR; PG8_SCHED;
            PG8_LDA(At, 0, 1); PG8_STAGE(PG8_SB(0, 0), b2, voffB); PG8_STAGE(PG8_SB(0, 1), b2 + hstep, voffB); PG8_STAGE(PG8_SA(0, 0), a2, voffA);
            PG8_WAIT_V(8); PG8_WAIT_L(0); PG8_BAR; PG8_MMA(1, 0, At, B0); PG8_MMA(1, 1, At, B1); PG8_BAR; PG8_SCHED;
            PG8_LDB(B0, 1, 0); PG8_LDB(B1, 1, 1); PG8_SCHED; PG8_LDA(At, 1, 0); PG8_STAGE(PG8_SA(0, 1), a2 + hstep, voffA);
            PG8_WAIT_V(8); PG8_WAIT_L(0); PG8_BAR; PG8_MMA(0, 0, At, B0); PG8_MMA(0, 1, At, B1); PG8_BAR; PG8_SCHED;
            PG8_LDA(At, 1, 1); PG8_STAGE(PG8_SB(1, 0), b3, voffB); PG8_STAGE(PG8_SB(1, 1), b3 + hstep, voffB); PG8_STAGE(PG8_SA(1, 0), a3, voffA);
            PG8_WAIT_V(8); PG8_WAIT_L(0); PG8_BAR; PG8_MMA(1, 0, At, B0); PG8_MMA(1, 1, At, B1); PG8_BAR; PG8_SCHED;
            } else {
            PG8_LDB(B0, 0, 0); PG8_SCHED; PG8_LDA(At, 0, 0); PG8_STAGE(PG8_SA(1, 1), a1 + hstep, voffA);
            PG8_WAIT_L(8); PG8_BAR; PG8_WAIT_L(0); PG8_MMA(0, 0, At, B0); PG8_BAR; PG8_SCHED;
            PG8_LDB(B1, 0, 1); PG8_STAGE(PG8_SB(0, 0), b2, voffB);
            PG8_BAR; PG8_WAIT_L(0); PG8_MMA(0, 1, At, B1); PG8_BAR;
            PG8_LDA(At, 0, 1); PG8_STAGE(PG8_SA(0, 0), a2, voffA);
            PG8_BAR; PG8_WAIT_L(0); PG8_MMA(1, 0, At, B0); PG8_BAR; PG8_SCHED;
            PG8_STAGE(PG8_SB(0, 1), b2 + hstep, voffB);
            PG8_WAIT_V(6); PG8_BAR; PG8_MMA(1, 1, At, B1); PG8_BAR;
            PG8_LDB(B0, 1, 0); PG8_SCHED; PG8_LDA(At, 1, 0); PG8_STAGE(PG8_SA(0, 1), a2 + hstep, voffA);
            PG8_WAIT_L(8); PG8_BAR; PG8_WAIT_L(0); PG8_MMA(0, 0, At, B0); PG8_BAR; PG8_SCHED;
            PG8_LDB(B1, 1, 1); PG8_STAGE(PG8_SB(1, 0), b3, voffB);
            PG8_BAR; PG8_WAIT_L(0); PG8_MMA(0, 1, At, B1); PG8_BAR;
            PG8_LDA(At, 1, 1); PG8_STAGE(PG8_SA(1, 0), a3, voffA);
            PG8_BAR; PG8_WAIT_L(0); PG8_MMA(1, 0, At, B0); PG8_BAR; PG8_SCHED;
            PG8_STAGE(PG8_SB(1, 1), b3 + hstep, voffB);
            PG8_WAIT_V(6); PG8_BAR; PG8_MMA(1, 1, At, B1); PG8_BAR;
            }
        }
        const bool part = Sched::PARTS && cur.aux == -2;
        if (!part) {
        if constexpr (ALIGN_EPI) { if (wr == 0) PG8_BAR; }
        if constexpr (!Epi::AFTER_DRAIN) { E(acc, cur, wr, wc, fr, fq); S.done(cur); }
        }
        if (!has_next) break;
        if (!part) {
#pragma unroll
        for (int a = 0; a < 2; ++a)
#pragma unroll
            for (int b = 0; b < 2; ++b)
#pragma unroll
                for (int m = 0; m < 4; ++m)
#pragma unroll
                    for (int n = 0; n < 2; ++n) acc[a][b][m][n] = (f32x4){0.f, 0.f, 0.f, 0.f};
        }
        cur = nxt; cA = nA; cB = nB; ++ui;
        if (!part) {
        if constexpr (ALIGN_EPI) { if (wr == 1) PG8_BAR; }
        }
    }
    PG8_WAIT_V(0);
    if constexpr (!ALIGN_EPI) { if (wr == 0) PG8_BAR; }
    PG8_BAR;
    if constexpr (Epi::AFTER_DRAIN) { E.fused(acc, cur, wr, wc, fr, fq, lds, wid, lane); S.done(cur); }
#undef PG8_SA
#undef PG8_SB
#undef PG8_STAGE
#undef PG8_LDA
#undef PG8_LDB
#undef PG8_MMA
#undef PG8_WAIT_V
#undef PG8_WAIT_L
#undef PG8_BAR
#undef PG8_SCHED
}
}
#define GAS __attribute__((address_space(1)))
#define LAS __attribute__((address_space(3)))
typedef unsigned short bf16;
typedef unsigned v4u __attribute__((ext_vector_type(4)));
typedef float f32x4 __attribute__((ext_vector_type(4)));
typedef short bf16x8 __attribute__((ext_vector_type(8)));
typedef GAS unsigned gu32;
typedef GAS unsigned long long gu64;
#define RLX_AGENT __ATOMIC_RELAXED, __HIP_MEMORY_SCOPE_AGENT
#define LDS_WAIT() asm volatile("s_waitcnt lgkmcnt(0)" ::: "memory")
#define VM_WAIT() asm volatile("s_waitcnt vmcnt(0)" ::: "memory")
__device__ __forceinline__ unsigned long long rt() { return __builtin_amdgcn_s_memrealtime(); }
__device__ __forceinline__ unsigned f2bf(float f) { unsigned u = __builtin_bit_cast(unsigned, f); return (u + 0x7fffu + ((u >> 16) & 1u)) >> 16; }
__device__ __forceinline__ unsigned pk2(float lo, float hi) { return f2bf(lo) | (f2bf(hi) << 16); }

#define XB_TMO      128
#define XB_XCNT(j)  (256  + 64 * (j))
#define XB_XSUB(j)  (1280 + 64 * (j))
#define XB_XGEN(j)  (2304 + 64 * (j))
#define XB_TOP      3328
#define XB_TOPGEN   3392
#define XCD_BAR_WORDS 3456
#define XB_SPIN_CAP (1u << 18)

__device__ __forceinline__ unsigned xb_ld(unsigned* p)              { return __hip_atomic_load(p, __ATOMIC_RELAXED, __HIP_MEMORY_SCOPE_AGENT); }
__device__ __forceinline__ unsigned xb_add(unsigned* p, unsigned v) { return __hip_atomic_fetch_add(p, v, __ATOMIC_RELAXED, __HIP_MEMORY_SCOPE_AGENT); }
__device__ __forceinline__ unsigned xb_xcc_id() { return (unsigned)__builtin_amdgcn_s_getreg((3 << 11) | 20) & 0xFu; }
#define XB_SPIN(cond, bar) do { unsigned _sp = 0; while (cond) { __builtin_amdgcn_s_sleep(1); \
    if ((++_sp & 255u) == 0u) { if (xb_ld(&(bar)[XB_TMO])) break; if (_sp > XB_SPIN_CAP) { atomicAdd(&(bar)[XB_TMO], 1u); break; } } } } while (0)

struct XcdBarrier {
    unsigned* bar; unsigned x; unsigned w0;
    volatile LAS unsigned* st;
};

__device__ __forceinline__ XcdBarrier xcd_barrier_post(unsigned* bar, volatile LAS unsigned* st, int wv0) {
    XcdBarrier b; b.bar = bar; b.x = xb_xcc_id(); b.st = st; b.w0 = (unsigned)wv0;
    if (wv0 == 0 && hw_lane() == 0) (void)xb_add(&bar[XB_XCNT(b.x)], 1u);
    return b;
}
__device__ __forceinline__ void xcd_barrier_complete(unsigned* bar, unsigned x, unsigned& nloc, unsigned& nx) {
    const unsigned G = gridDim.x * gridDim.y * gridDim.z;
    unsigned sum, cnt, mine, sp = 0u;
    for (;;) {
        sum = 0u; cnt = 0u; mine = 0u;
#pragma unroll
        for (unsigned j = 0; j < 16; ++j) { const unsigned c = xb_ld(&bar[XB_XCNT(j)]); sum += c; cnt |= (c > 0u) ? (1u << j) : 0u; mine = (j == x) ? c : mine; }
        if (sum == G) break;
        __builtin_amdgcn_s_sleep(1);
        if ((++sp & 255u) == 0u) { if (xb_ld(&bar[XB_TMO])) break; if (sp > XB_SPIN_CAP) { atomicAdd(&bar[XB_TMO], 1u); break; } }
    }
    nloc = mine > 0u ? mine : 1u; nx = cnt | (1u << x);
}

__device__ __forceinline__ void xcd_barrier(const XcdBarrier& b) {
    asm volatile("s_waitcnt vmcnt(0)" ::: "memory");
    __syncthreads();
    if (b.w0 == 0u) {
        unsigned* bar = b.bar; const int ln = hw_lane();
        unsigned gen = 0u, mask = 0u;
        if (ln == 0) {
            __builtin_amdgcn_s_waitcnt(0);
            unsigned nloc = b.st[0], nx = b.st[1];
            if (nloc == 0u) { xcd_barrier_complete(bar, b.x, nloc, nx); b.st[0] = nloc; b.st[1] = nx; }
            const unsigned old = xb_add(&bar[XB_XSUB(b.x)], 1u);
            gen = old / nloc; mask = nx;
            if (old + 1u == (gen + 1u) * nloc) {
                __builtin_amdgcn_fence(__ATOMIC_RELEASE, "agent");
                asm volatile("s_waitcnt vmcnt(0)" ::: "memory");
                xb_add(&bar[XB_XGEN(b.x)], 1u);
            }
        }
        gen = (unsigned)__builtin_amdgcn_readfirstlane((int)gen); mask = (unsigned)__builtin_amdgcn_readfirstlane((int)mask);
        { const bool mine = ln < 16 && ((mask >> ln) & 1u); unsigned sp = 0u;
          for (;;) {
              bool ok = true; if (mine) ok = xb_ld(&bar[XB_XGEN(ln)]) > gen;
              if (__builtin_amdgcn_ballot_w64(!ok) == 0ull) break;
              __builtin_amdgcn_s_sleep(1);
              if ((++sp & 255u) == 0u) { if (xb_ld(&bar[XB_TMO])) break; if (sp > XB_SPIN_CAP) { if (ln == 0) atomicAdd(&bar[XB_TMO], 1u); break; } } } }
        __builtin_amdgcn_fence(__ATOMIC_ACQUIRE, "agent");
        asm volatile("s_waitcnt vmcnt(0)" ::: "memory");
    }
    __syncthreads();
}

constexpr int NWAVES = 8;
constexpr int DM = 2048, MP = 8192, MS = 1024, MT = MP + MS;
constexpr int NIN = 14336, DFF = 5632, NUP = 2 * DFF, NCOND = 132, MODP = 24576;
constexpr int ZU = 0, ZV = 1024, ZQ = 2048, ZF = 4096, ZI = 6144, ZOG = 8192, ZGA = 10240, ZGB = 12288;
constexpr float EPS = 1e-6f, L2E = 1.44269504089f;
constexpr size_t O_YP = 0, O_YS = 16777216, O_HP = 18874368, O_HS = 20971520, O_CP = 88080384, O_CS = 88260608, O_VP = 94027776, O_VS = 95076352, O_END = 97173504;
constexpr size_t MiB = 1u << 20;
constexpr size_t WS_CTL = 0, CTL_ZERO_BYTES = 1 * MiB;
constexpr size_t WS_AC = 1 * MiB;
constexpr size_t WS_MOD = 2 * MiB;
constexpr size_t WS_ADAT = 26 * MiB;
constexpr size_t WS_WIN = 122 * MiB, SZ_WIN = 56 * MiB;
constexpr size_t WS_WBA = 234 * MiB, SZ_WBA = 4 * MiB;
constexpr size_t WS_WBB = 242 * MiB, SZ_WBB = 8 * MiB;
constexpr size_t WS_WOUT = 258 * MiB, SZ_WOUT = 8 * MiB;
constexpr size_t WS_WUP = 274 * MiB, SZ_WUP = 44 * MiB;
constexpr size_t WS_WDN = 362 * MiB, SZ_WDN = 22 * MiB;
constexpr size_t WS_X = 406 * MiB;
constexpr size_t WS_H = 478 * MiB;
constexpr size_t WS_Z = 514 * MiB;
constexpr size_t WS_YA = 766 * MiB;
constexpr size_t WS_O = 784 * MiB;
constexpr size_t WS_Y = 820 * MiB;
constexpr size_t WS_ACT = 856 * MiB;
constexpr size_t WS_SLAB = 955 * MiB;
constexpr size_t WS_END = 1051 * MiB;
constexpr int CW_BAR = 4096;
constexpr int RING_OFF = 0, RING_BYTES = 131072;
constexpr int LDSCTL_OFF = RING_BYTES, MISC_OFF = LDSCTL_OFF + 320;
constexpr int LDS_BYTES = 147456;

#define DI __device__ __forceinline__
typedef unsigned v2u __attribute__((ext_vector_type(2)));
using pg8::pkbf; using pg8::bflo; using pg8::bfhi; using pg8::sigm; using pg8::gelu_t;
DI float fexp2(float x) { return __builtin_amdgcn_exp2f(x); }
DI float flog2(float x) { return __builtin_amdgcn_logf(x); }
DI float frcp(float x) { return __builtin_amdgcn_rcpf(x); }
DI float frsq(float x) { return __builtin_amdgcn_rsqf(x); }
DI float lane_get(float x, int src_lane) { return __builtin_bit_cast(float, __builtin_amdgcn_ds_bpermute(src_lane << 2, __builtin_bit_cast(int, x))); }
DI float wave_sum(float v, int lane) {
#pragma unroll
    for (int o = 1; o < 64; o <<= 1) v += lane_get(v, lane ^ o);
    return v;
}
#define LDS_BARRIER() do { asm volatile("s_waitcnt lgkmcnt(0)" ::: "memory"); __builtin_amdgcn_s_barrier(); asm volatile("" ::: "memory"); } while (0)
#define MFMA16(a, b, c) __builtin_amdgcn_mfma_f32_16x16x32_bf16((a), (b), (c), 0, 0, 0)

struct Args { const float* in[24]; float* out; unsigned char* ws; };
DI const float* inp(const Args& a, int k) { asm volatile("" : "+s"(k)); return (const float*)(const GAS float*)a.in[k]; }
enum { I_XP = 0, I_XS, I_CP, I_CS, I_SH, I_SC, I_ADAW, I_ADAB, I_N1, I_N2, I_WIN, I_VG, I_WS, I_BS, I_WBA, I_LB, I_HNG, I_WBB, I_WOUT, I_WUP, I_CW, I_CB, I_WDN, I_FNG };

struct P0It { const float* W; int N; bf16* WT; int pitch; int item; };
DI void p0_item_load(const P0It& d, int lane, float (&v)[32]) {
    const int nblk = d.N / 32, kb = d.item / nblk, nb = d.item % nblk, k0 = 64 * kb, n0 = 32 * nb;
#pragma unroll
    for (int i = 0; i < 32; ++i) { const int kk = 2 * i + (lane >> 5); v[i] = __builtin_nontemporal_load(d.W + (size_t)(k0 + kk) * d.N + n0 + (lane & 31)); }
}
DI void p0_item_store(const P0It& d, LAS float* scr, int lane, const float (&v)[32]) {
    const int nblk = d.N / 32, kb = d.item / nblk, nb = d.item % nblk, k0 = 64 * kb, n0 = 32 * nb;
#pragma unroll
    for (int i = 0; i < 32; ++i) { const int kk = 2 * i + (lane >> 5); scr[kk * 33 + (lane & 31)] = v[i]; }
    LDS_WAIT(); asm volatile("" ::: "memory");
    const int c = lane & 7;
#pragma unroll
    for (int j = 0; j < 4; ++j) { const int n = (lane >> 3) + 8 * j; const LAS float* sp = scr + (8 * c) * 33 + n;
        v4u o; o.x = pkbf(sp[0 * 33], sp[1 * 33]); o.y = pkbf(sp[2 * 33], sp[3 * 33]); o.z = pkbf(sp[4 * 33], sp[5 * 33]); o.w = pkbf(sp[6 * 33], sp[7 * 33]);
        *(GAS v4u*)(d.WT + (size_t)(n0 + n) * d.pitch + k0 + 8 * c) = o; }
    LDS_WAIT(); asm volatile("" ::: "memory");
}

template <bool FINAL>
DI void norm_rows(const void* xp, const void* xs, bool pbf, bool sbf  , const float* g, const float* modsh  , bf16* H, float* out, int gw, int NGW, int lane,
                  const bf16* slab  , const float* gate  , bf16* xs_out  , LAS unsigned char* lds) {
    asm volatile("" : "+v"(lane), "+s"(gw));
    const bool bal = (slab != nullptr) && (NGW == 2048);
    int srow = -1, r0, r1;
    if (bal) { if (gw < 1024) { srow = MP + gw; r0 = 2 * gw; r1 = r0 + 2; } else { r0 = 2048 + 6 * (gw - 1024); r1 = r0 + 6; } }
    else { unsigned n_ = (unsigned)NGW; asm volatile("" : "+s"(n_));
           r0 = (int)((unsigned)(gw * MT) / n_); r1 = (int)((unsigned)((gw + 1) * MT) / n_); }
    int cbc = -1; f32x4 wv[8], shv[8];
    auto params = [&](int row) {
        const int cb = row < MP ? (row >> 11) : 4 + ((row - MP) >> 3);
        if (cb == cbc) return;
        cbc = cb;
        if (FINAL) {
#pragma unroll
            for (int j = 0; j < 8; ++j) wv[j] = ((const GAS f32x4*)g)[lane + 64 * j];
        } else {
            const GAS f32x4* sh = (const GAS f32x4*)(modsh + (size_t)cb * MODP) + lane; const GAS f32x4* sc = sh + DM / 4;
#pragma unroll
            for (int j = 0; j < 8; ++j) { wv[j] = ((const GAS f32x4*)g)[lane + 64 * j] * (sc[64 * j] + 1.f); shv[j] = sh[64 * j]; }
        } };
    auto ldrow = [&](int row, f32x4 (&v)[8]) {
        const bool isb = row < MP ? pbf : sbf; const size_t roff = row < MP ? (size_t)row * DM : (size_t)(row - MP) * DM; const void* rbase = row < MP ? xp : xs;
        if (isb) { const GAS v2u* xr = (const GAS v2u*)((const bf16*)rbase + roff) + lane; v2u w[8];
#pragma unroll
            for (int j = 0; j < 8; ++j) w[j] = xr[64 * j];
#pragma unroll
            for (int j = 0; j < 8; ++j) v[j] = (f32x4){bflo(w[j].x), bfhi(w[j].x), bflo(w[j].y), bfhi(w[j].y)}; }
        else { const GAS f32x4* xr = (const GAS f32x4*)((const float*)rbase + roff) + lane;
#pragma unroll
            for (int j = 0; j < 8; ++j) v[j] = xr[64 * j]; } };
    auto fold = [&](int row, f32x4 (&v)[8], bool lgate = false) {
        const int cbs = 4 + ((row - MP) >> 3);
        const GAS f32x4* gp = (const GAS f32x4*)(gate + (size_t)cbs * MODP) + lane; const GAS v2u* sp = (const GAS v2u*)(slab + (size_t)(row - MP) * DM) + lane;
        f32x4 a[8], gq[8];
#pragma unroll
        for (int j = 0; j < 8; ++j) { a[j] = (f32x4){0.f, 0.f, 0.f, 0.f}; if (!lgate) gq[j] = gp[64 * j]; }
#pragma unroll 1
        for (int sh = 0; sh < 2; ++sh) {
#pragma unroll
            for (int j = 0; j < 8; ++j)
#pragma unroll
                for (int s = 0; s < 4; ++s) { const v2u w = sp[(size_t)(4 * sh + s) * (pg8::SLAB_ELEMS / 4) + 64 * j]; a[j] += (f32x4){bflo(w.x), bfhi(w.x), bflo(w.y), bfhi(w.y)}; } }
        if (lgate) {
#pragma unroll
            for (int j = 0; j < 8; ++j) gq[j] = *(const LAS f32x4*)(lds + (lane + 64 * j) * 16); }
#pragma unroll
        for (int j = 0; j < 8; ++j) v[j] += gq[j] * a[j];
        if (xs_out) { GAS v2u* xo = (GAS v2u*)(xs_out + (size_t)(row - MP) * DM) + lane;
#pragma unroll
            for (int j = 0; j < 8; ++j) { v2u w; w.x = pkbf(v[j].x, v[j].y); w.y = pkbf(v[j].z, v[j].w); xo[64 * j] = w; } } };
    auto finish = [&](int row, const f32x4 (&v)[8]) {
        float ss = 0.f;
#pragma unroll
        for (int j = 0; j < 8; ++j) ss += (v[j].x * v[j].x + v[j].y * v[j].y) + (v[j].z * v[j].z + v[j].w * v[j].w);
        const float rstd = frsq(wave_sum(ss, lane) * (1.f / DM) + EPS);
        if (FINAL) { GAS f32x4* o = (GAS f32x4*)(out + (size_t)row * DM) + lane;
#pragma unroll
            for (int j = 0; j < 8; ++j) o[64 * j] = v[j] * rstd * wv[j]; }
        else { GAS v2u* o = (GAS v2u*)(H + (size_t)row * DM) + lane;
#pragma unroll
            for (int j = 0; j < 8; ++j) { const f32x4 h = v[j] * rstd * wv[j] + shv[j]; v2u w; w.x = pkbf(h.x, h.y); w.y = pkbf(h.z, h.w); o[64 * j] = w; } } };
    if (srow >= 0) {
        const int cbs = 4 + ((srow - MP) >> 3); const int idx = (srow & 7) * 64 + lane;
        const f32x4 g4 = ((const GAS f32x4*)(gate + (size_t)cbs * MODP))[idx];
        f32x4 w4 = ((const GAS f32x4*)g)[idx], s4 = {0.f, 0.f, 0.f, 0.f};
        if (!FINAL) { const GAS f32x4* sh = (const GAS f32x4*)(modsh + (size_t)cbs * MODP); w4 = w4 * (sh[DM / 4 + idx] + 1.f); s4 = sh[idx]; }
        *(LAS f32x4*)(lds + idx * 16) = g4; *(LAS f32x4*)(lds + 8192 + idx * 16) = w4; *(LAS f32x4*)(lds + 16384 + idx * 16) = s4;
    }
    if (bal) { if (gw < 1024) LDS_BARRIER(); }
    if (srow >= 0) {
        v2u w2[2][8];
        const bool pre = pbf && (r1 - r0 == 2);
        if (pre) {
#pragma unroll
            for (int t = 0; t < 2; ++t) { const GAS v2u* xr = (const GAS v2u*)((const bf16*)xp + (size_t)(r0 + t) * DM) + lane;
#pragma unroll
                for (int j = 0; j < 8; ++j) w2[t][j] = xr[64 * j]; } }
        { f32x4 v[8]; ldrow(srow, v); fold(srow, v, true);
#pragma unroll
          for (int j = 0; j < 8; ++j) { wv[j] = *(const LAS f32x4*)(lds + 8192 + (lane + 64 * j) * 16); shv[j] = *(const LAS f32x4*)(lds + 16384 + (lane + 64 * j) * 16); }
          cbc = 4 + ((srow - MP) >> 3);
          finish(srow, v); }
        if (pre) { params(r0);
#pragma unroll
            for (int t = 0; t < 2; ++t) { f32x4 v[8];
#pragma unroll
                for (int j = 0; j < 8; ++j) v[j] = (f32x4){bflo(w2[t][j].x), bfhi(w2[t][j].x), bflo(w2[t][j].y), bfhi(w2[t][j].y)};
                finish(r0 + t, v); }
            r0 = r1; } }
    for (int row = r0; row < r1;) {
        asm volatile("" : "+v"(lane));
        const bool pair = (row + 1 < r1) && (row + 1 < MP) && ((row >> 11) == ((row + 1) >> 11));
        if (pair) { f32x4 v0[8], v1[8]; ldrow(row, v0); ldrow(row + 1, v1); params(row); finish(row, v0); finish(row + 1, v1); row += 2; }
        else { f32x4 v[8]; ldrow(row, v); if (slab && row >= MP) fold(row, v); params(row); finish(row, v); row += 1; }
    }
}

constexpr int HP = 272, HPK = 144;
constexpr int HG_QT = 0, HG_KT = 64 * HP, HG_IVT = 2 * 64 * HP, HG_EAR = HG_IVT + 128 * HPK, HG_PART = HG_EAR + 512, HG_BUF0 = HG_PART + 2048;
constexpr int HG_KDT = HG_BUF0, HG_P = HG_KDT + 128 * HPK, HG_DEC = HG_P + 64 * HPK, HG_BUFSZ = 128 * HPK + 64 * HPK + 512, HG_END = HG_BUF0 + 2 * HG_BUFSZ;
static_assert(HG_END <= RING_BYTES, "hgrn lds");
struct HgRegs { v2u qt[4], kt[4], kd[4], iv[4]; f32x4 dec, ear; };
DI void hg_load(const bf16* Z, int rowb, int h, int k0, int tg, bool valid, v2u (&qw)[4], v2u (&fw)[4], v2u (&iw)[4]) {
#pragma unroll
    for (int j = 0; j < 4; ++j) {
        if (valid) { const bf16* zr = Z + (size_t)(rowb + 4 * tg + j) * NIN + h * 128 + k0;
            qw[j] = *(const v2u*)(zr + ZQ); fw[j] = *(const v2u*)(zr + ZF); iw[j] = *(const v2u*)(zr + ZI); }
        else { qw[j] = (v2u){0u, 0u}; fw[j] = (v2u){0u, 0u}; iw[j] = (v2u){0u, 0u}; }
    }
}
template <int NG>
DI void hg_elem(const v2u (&qw)[4], const v2u (&fw)[4], const v2u (&iw)[4], const float (&lb)[4], const float (&oml)[4], bool valid, int lane, int tg, int kql, HgRegs& R) {
#pragma unroll
    for (int cp = 0; cp < 2; ++cp) {
        float lf[4][2], kk[4][2];
#pragma unroll
        for (int j = 0; j < 4; ++j) { const unsigned w = cp ? fw[j].y : fw[j].x;
#pragma unroll
            for (int c = 0; c < 2; ++c) { const float fr = c ? bfhi(w) : bflo(w);
                const float e = fexp2(fminf(-L2E * fr, 60.f)), r = frcp(1.f + e);
                const float f = (1.f + lb[2 * cp + c] * e) * r;
                kk[j][c] = valid ? oml[2 * cp + c] * e * r : 0.f;
                lf[j][c] = valid ? flog2(f) : 0.f; } }
#pragma unroll
        for (int j = 1; j < 4; ++j) { lf[j][0] += lf[j - 1][0]; lf[j][1] += lf[j - 1][1]; }
        float before[2], aref[2], e2[2];
#pragma unroll
        for (int c = 0; c < 2; ++c) { float x = lf[3][c];
#pragma unroll
            for (int d = 1; d < 16; d <<= 1) { const float y = lane_get(x, (lane - 4 * d) & 63); if (tg >= d) x += y; }
            before[c] = x - lf[3][c]; aref[c] = lane_get(x, 4 * (NG / 2 - 1) + kql); const float al = lane_get(x, 4 * (NG - 1) + kql);
            e2[c] = fexp2(al - aref[c]); R.dec[2 * cp + c] = fexp2(al); R.ear[2 * cp + c] = fexp2(aref[c]); }
        float kd[4][2];
#pragma unroll
        for (int j = 0; j < 4; ++j) { const unsigned w = cp ? qw[j].y : qw[j].x; float qt[2], kt[2];
#pragma unroll
            for (int c = 0; c < 2; ++c) { const float qv = c ? bfhi(w) : bflo(w);
                const float d = before[c] + lf[j][c] - aref[c];
                qt[c] = qv * fexp2(fminf(d, 100.f)); kt[c] = kk[j][c] * fexp2(fminf(-d, 100.f)); kd[j][c] = kt[c] * e2[c]; }
            if (cp) { R.qt[j].y = pkbf(qt[0], qt[1]); R.kt[j].y = pkbf(kt[0], kt[1]); } else { R.qt[j].x = pkbf(qt[0], qt[1]); R.kt[j].x = pkbf(kt[0], kt[1]); } }
#pragma unroll
        for (int c = 0; c < 2; ++c) { R.kd[2 * cp + c] = (v2u){pkbf(kd[0][c], kd[1][c]), pkbf(kd[2][c], kd[3][c])};
            unsigned e0, e1, e2b, e3;
            if (cp == 0) { if (c == 0) { e0 = iw[0].x & 0xffffu; e1 = iw[1].x & 0xffffu; e2b = iw[2].x & 0xffffu; e3 = iw[3].x & 0xffffu; } else { e0 = iw[0].x >> 16; e1 = iw[1].x >> 16; e2b = iw[2].x >> 16; e3 = iw[3].x >> 16; } }
            else { if (c == 0) { e0 = iw[0].y & 0xffffu; e1 = iw[1].y & 0xffffu; e2b = iw[2].y & 0xffffu; e3 = iw[3].y & 0xffffu; } else { e0 = iw[0].y >> 16; e1 = iw[1].y >> 16; e2b = iw[2].y >> 16; e3 = iw[3].y >> 16; } }
            R.iv[2 * cp + c] = (v2u){e0 | (e1 << 16), e2b | (e3 << 16)}; }
        __builtin_amdgcn_sched_barrier(0);
    }
}
template <int TT> DI void hg_final(LAS unsigned char* lds, int wave, int lane, const f32x4 (&o)[TT], const v2u (&ogw)[TT], const f32x4 og4, bf16* OB, int rowb, int h);
template <int TT, bool DEFER = false>
DI void hg_stage1(LAS unsigned char* lds, int wave, int lane, const HgRegs& R, f32x4 (&S)[8], f32x4 (&o)[TT], v2u (&ogw)[TT], const bf16* Z, int rowb, int h,
                  int pb = 0  , bool have_prev = false, const f32x4 og4 = (f32x4){0.f, 0.f, 0.f, 0.f}, bf16* OB = nullptr) {
    constexpr int CS = (TT == 4) ? 64 : 32, NG = CS / 4;
    const int bo = pb * HG_BUFSZ;
    const int kql = lane & 3, tg = lane >> 2, k0 = 16 * wave + 4 * kql, i = lane & 15, q = lane >> 4;
    if (tg < NG) {
#pragma unroll
        for (int j = 0; j < 4; ++j) { const int ro = (4 * tg + j) * HP + k0 * 2; *(LAS v2u*)(lds + HG_QT + ro) = R.qt[j]; *(LAS v2u*)(lds + HG_KT + ro) = R.kt[j]; }
#pragma unroll
        for (int c = 0; c < 4; ++c) { *(LAS v2u*)(lds + HG_KDT + bo + (k0 + c) * HPK + 8 * tg) = R.kd[c]; *(LAS v2u*)(lds + HG_IVT + (k0 + c) * HPK + 8 * tg) = R.iv[c]; }
        if (tg == 0) { *(LAS f32x4*)(lds + HG_DEC + bo + k0 * 4) = R.dec; *(LAS f32x4*)(lds + HG_EAR + k0 * 4) = R.ear; }
    }
    LDS_BARRIER();
    if (DEFER && have_prev) hg_final<TT>(lds, wave, lane, o, ogw, og4, OB, rowb - 16 * TT, h);
#pragma unroll
    for (int it = 0; it < TT; ++it) ogw[it] = (TT == 4 || i < 8) ? *(const v2u*)(Z + (size_t)(rowb + 16 * it + i) * NIN + ZOG + h * 128 + 16 * wave + 4 * q) : (v2u){0u, 0u};
    if (TT == 4 || wave == 0) {
        const int it = (TT == 4) ? (wave >> 1) : 0;
#pragma unroll
        for (int is2 = 0; is2 < 2; ++is2) { const int is = ((TT == 4) ? 2 * (wave & 1) : 0) + is2;
            f32x4 sc = {0.f, 0.f, 0.f, 0.f};
#pragma unroll
            for (int ks = 0; ks < 4; ++ks) { const bf16x8 X = *(const LAS bf16x8*)(lds + HG_KT + (16 * is + i) * HP + (32 * ks + 8 * q) * 2), Y = *(const LAS bf16x8*)(lds + HG_QT + (16 * it + i) * HP + (32 * ks + 8 * q) * 2);
                sc = MFMA16(X, Y, sc); }
            const int t = 16 * it + i, s0 = 16 * is + 4 * q;
            *(LAS v2u*)(lds + HG_P + bo + t * HPK + s0 * 2) = (v2u){pkbf(s0 <= t ? sc[0] : 0.f, s0 + 1 <= t ? sc[1] : 0.f), pkbf(s0 + 2 <= t ? sc[2] : 0.f, s0 + 3 <= t ? sc[3] : 0.f)};
        }
    }
    {
        bf16x8 Sf[4];
#pragma unroll
        for (int ks = 0; ks < 4; ++ks) { const f32x4 e0 = *(const LAS f32x4*)(lds + HG_EAR + (32 * ks + 4 * q) * 4), e1 = *(const LAS f32x4*)(lds + HG_EAR + (32 * ks + 16 + 4 * q) * 4);
            const f32x4 a0 = S[2 * ks] * e0, a1 = S[2 * ks + 1] * e1;
            v4u p; p.x = pkbf(a0[0], a0[1]); p.y = pkbf(a0[2], a0[3]); p.z = pkbf(a1[0], a1[1]); p.w = pkbf(a1[2], a1[3]); Sf[ks] = __builtin_bit_cast(bf16x8, p); }
#pragma unroll
        for (int it = 0; it < TT; ++it) { o[it] = (f32x4){0.f, 0.f, 0.f, 0.f};
#pragma unroll
            for (int ks = 0; ks < 4; ++ks) { const v2u lo = *(const LAS v2u*)(lds + HG_QT + (16 * it + i) * HP + (32 * ks + 4 * q) * 2), hi = *(const LAS v2u*)(lds + HG_QT + (16 * it + i) * HP + (32 * ks + 16 + 4 * q) * 2);
                const v4u y = {lo.x, lo.y, hi.x, hi.y}; o[it] = MFMA16(Sf[ks], __builtin_bit_cast(bf16x8, y), o[it]); } }
    }
    bf16x8 IVf[CS / 32];
#pragma unroll
    for (int ss = 0; ss < CS / 32; ++ss) IVf[ss] = *(const LAS bf16x8*)(lds + HG_IVT + (16 * wave + i) * HPK + (32 * ss + 8 * q) * 2);
    LDS_BARRIER();
#pragma unroll
    for (int it = 0; it < TT; ++it)
#pragma unroll
        for (int ss = 0; ss < CS / 32; ++ss) if (TT != 4 || ss <= (it >> 1)) { const bf16x8 Y = *(const LAS bf16x8*)(lds + HG_P + bo + (16 * it + i) * HPK + (32 * ss + 8 * q) * 2); o[it] = MFMA16(IVf[ss], Y, o[it]); }
#pragma unroll
    for (int a = 0; a < 8; ++a) { const f32x4 d = *(const LAS f32x4*)(lds + HG_DEC + bo + (16 * a + 4 * q) * 4); S[a] *= d;
#pragma unroll
        for (int ss = 0; ss < CS / 32; ++ss) { const bf16x8 X = *(const LAS bf16x8*)(lds + HG_KDT + bo + (16 * a + i) * HPK + (32 * ss + 8 * q) * 2); S[a] = MFMA16(X, IVf[ss], S[a]); } }
#pragma unroll
    for (int it = 0; it < TT; ++it) { float p = (o[it][0] * o[it][0] + o[it][1] * o[it][1]) + (o[it][2] * o[it][2] + o[it][3] * o[it][3]); p += lane_get(p, lane ^ 16); p += lane_get(p, lane ^ 32);
        if (q == 0) *(LAS float*)(lds + HG_PART + (wave * 64 + 16 * it + i) * 4) = p; }
}
template <int TT>
DI void hg_final(LAS unsigned char* lds, int wave, int lane, const f32x4 (&o)[TT], const v2u (&ogw)[TT], const f32x4 og4, bf16* OB, int rowb, int h) {
    const int i = lane & 15, q = lane >> 4;
#pragma unroll
    for (int it = 0; it < TT; ++it) { float tot = 0.f;
#pragma unroll
        for (int w = 0; w < 8; ++w) tot += *(const LAS float*)(lds + HG_PART + (w * 64 + 16 * it + i) * 4);
        const float rstd = frsq(tot * (1.f / 128.f) + EPS);
        if (TT == 4 || i < 8) { const v2u g = ogw[it];
            const float r0 = o[it][0] * rstd * og4[0] * bflo(g.x), r1 = o[it][1] * rstd * og4[1] * bfhi(g.x), r2 = o[it][2] * rstd * og4[2] * bflo(g.y), r3 = o[it][3] * rstd * og4[3] * bfhi(g.y);
            *(v2u*)(OB + (size_t)(rowb + 16 * it + i) * 2048 + h * 128 + 16 * wave + 4 * q) = (v2u){pkbf(r0, r1), pkbf(r2, r3)}; } }
}
template <int TT>
DI void hg_stage2(LAS unsigned char* lds, int wave, int lane, const f32x4 (&o)[TT], const v2u (&ogw)[TT], const f32x4 og4, bf16* OB, int rowb, int h) {
    LDS_BARRIER();
    hg_final<TT>(lds, wave, lane, o, ogw, og4, OB, rowb, h);
}
DI void hgrn_prompt_unit(LAS unsigned char* lds, int tid, int wave, int lane, const bf16* Z, bf16* OB, float* s_out,
                         const float* ogain  , const float* lbp  , int l, int h, int row0, int nblk) {
    asm volatile("" : "+v"(tid), "+v"(lane), "+s"(wave));
    const int kql = lane & 3, tg = lane >> 2, k0 = 16 * wave + 4 * kql, i = lane & 15, q = lane >> 4;
    float lb[4], oml[4];
#pragma unroll
    for (int c = 0; c < 4; ++c) { lb[c] = (l == 0) ? 0.f : sigm(lbp[2048 + h * 128 + k0 + c] - lbp[h * 128 + k0 + c]); oml[c] = 1.f - lb[c]; }
    f32x4 S[8];
#pragma unroll
    for (int a = 0; a < 8; ++a) S[a] = (f32x4){0.f, 0.f, 0.f, 0.f};
    const f32x4 og4 = *(const f32x4*)(ogain + 16 * wave + 4 * q);
    v2u qw[4], fw[4], iw[4]; HgRegs R;
    hg_load(Z, row0, h, k0, tg, true, qw, fw, iw);
    hg_elem<16>(qw, fw, iw, lb, oml, true, lane, tg, kql, R);
    if (nblk > 1) hg_load(Z, row0 + 64, h, k0, tg, true, qw, fw, iw);
    f32x4 o[4]; v2u ogw[4];
#pragma unroll
    for (int it = 0; it < 4; ++it) { o[it] = (f32x4){0.f, 0.f, 0.f, 0.f}; ogw[it] = (v2u){0u, 0u}; }
    for (int blk = 0; blk < nblk; ++blk) {
        const int rowb = row0 + blk * 64;
        hg_stage1<4, true>(lds, wave, lane, R, S, o, ogw, Z, rowb, h, blk & 1, blk > 0, og4, OB);
        if (blk + 1 < nblk) { hg_elem<16>(qw, fw, iw, lb, oml, true, lane, tg, kql, R);
            if (blk + 2 < nblk) hg_load(Z, rowb + 128, h, k0, tg, true, qw, fw, iw); }
    }
    hg_stage2<4>(lds, wave, lane, o, ogw, og4, OB, row0 + (nblk - 1) * 64, h);
    { float* sp = s_out + (size_t)(4 * q) * 128 + 16 * wave + i;
#pragma unroll
      for (int a = 0; a < 8; ++a) {
#pragma unroll
          for (int r = 0; r < 4; ++r) __builtin_nontemporal_store(S[a][r], sp + r * 128);
          sp += 16 * 128; } }
    LDS_BARRIER();
}
DI void hgrn_sample_loop(LAS unsigned char* lds, int tid, int wave, int lane, const bf16* Z, bf16* OB, const float* st_in  , float* st_out,
                         const float* hng  , const float* lbp, int l, int su0, int step) {
    asm volatile("" : "+v"(tid), "+v"(lane), "+s"(wave));
    if (su0 >= 2048) return;
    const int kql = lane & 3, tg = lane >> 2, k0 = 16 * wave + 4 * kql, i = lane & 15, q = lane >> 4;
    const bool valid = tg < 2;
    const size_t lo = (size_t)(16 * 0 + 4 * q) * 128 + 16 * wave + i;
    f32x4 A[8], B[8];
    v2u qw[4], fw[4], iw[4]; HgRegs R;
    auto ldstate = [&](f32x4 (&T)[8], int su) { const float* sp = st_in + (size_t)su * 16384 + lo;
#pragma unroll
        for (int a = 0; a < 8; ++a)
#pragma unroll
            for (int r = 0; r < 4; ++r) T[a][r] = __builtin_nontemporal_load(sp + (16 * a + r) * 128); };
    auto unit = [&](int su, f32x4 (&T)[8]) {
        const int h = su & 15, rowb = MP + (su >> 4) * 8, nsu = su + step, n2 = su + 2 * step;
        float lb[4], oml[4];
#pragma unroll
        for (int c = 0; c < 4; ++c) { lb[c] = (l == 0) ? 0.f : sigm(lbp[2048 + h * 128 + k0 + c] - lbp[h * 128 + k0 + c]); oml[c] = 1.f - lb[c]; }
        const f32x4 og4 = *(const f32x4*)(hng + h * 128 + 16 * wave + 4 * q);
        hg_elem<8>(qw, fw, iw, lb, oml, valid, lane, tg, kql, R);
        if (nsu < 2048) hg_load(Z, MP + (nsu >> 4) * 8, nsu & 15, k0, tg, valid, qw, fw, iw);
        f32x4 o[1]; v2u ogw[1];
        hg_stage1<1>(lds, wave, lane, R, T, o, ogw, Z, rowb, h);
        { float* sp = st_out + (size_t)su * 16384 + lo;
#pragma unroll
          for (int a = 0; a < 8; ++a)
#pragma unroll
              for (int r = 0; r < 4; ++r) __builtin_nontemporal_store(T[a][r], sp + (16 * a + r) * 128); }
        if (n2 < 2048) ldstate(T, n2);
        hg_stage2<1>(lds, wave, lane, o, ogw, og4, OB, rowb, h); };
    ldstate(A, su0);
    hg_load(Z, MP + (su0 >> 4) * 8, su0 & 15, k0, tg, valid, qw, fw, iw);
    if (su0 + step < 2048) ldstate(B, su0 + step);
    for (int su = su0; su < 2048; su += 2 * step) {
        unit(su, A);
        if (su + step < 2048) unit(su + step, B);
    }
    LDS_BARRIER();
}

constexpr int MX_VNT = 0, MX_W = 128 * HP, MX_END = 2 * 128 * HP;
static_assert(MX_END <= RING_BYTES, "mixer lds");
DI void mixer_unit(LAS unsigned char* lds, int tid, int wave, int lane, int tt, int g, const bf16* Z, bf16* YA, const float* wsp  , const float* bsp  , const float* vgp  , float* vout  ) {
    asm volatile("" : "+v"(tid), "+v"(lane), "+s"(wave));
    const int r0 = tt * 128; const bool sample = tt >= 64;
    {
        const int cq = tid & 31, sg = tid >> 5, c0 = 4 * cq;
        const f32x4 vg4 = *(const f32x4*)(vgp + c0);
        float vn[8][4];
#pragma unroll
        for (int j = 0; j < 8; ++j) { const int s = 8 * sg + j; const v2u w = *(const v2u*)(Z + (size_t)(r0 + s) * NIN + ZV + g * 128 + c0);
            const float x0 = bflo(w.x), x1 = bfhi(w.x), x2 = bflo(w.y), x3 = bfhi(w.y);
            float ss = (x0 * x0 + x1 * x1) + (x2 * x2 + x3 * x3);
            ss += lane_get(ss, lane ^ 1); ss += lane_get(ss, lane ^ 2); ss += lane_get(ss, lane ^ 4); ss += lane_get(ss, lane ^ 8); ss += lane_get(ss, lane ^ 16);
            const float rstd = frsq(ss * (1.f / 128.f) + EPS);
            vn[j][0] = x0 * rstd * vg4[0]; vn[j][1] = x1 * rstd * vg4[1]; vn[j][2] = x2 * rstd * vg4[2]; vn[j][3] = x3 * rstd * vg4[3];
            if (vout) *(f32x4*)(vout + (size_t)s * 1024 + c0) = (f32x4){vn[j][0], vn[j][1], vn[j][2], vn[j][3]}; }
#pragma unroll
        for (int c = 0; c < 4; ++c) { v4u p; p.x = pkbf(vn[0][c], vn[1][c]); p.y = pkbf(vn[2][c], vn[3][c]); p.z = pkbf(vn[4][c], vn[5][c]); p.w = pkbf(vn[6][c], vn[7][c]);
            *(LAS v4u*)(lds + MX_VNT + (c0 + c) * HP + 16 * sg) = p; }
    }
    {
        const int t = tid >> 2, sq = tid & 3;
#pragma unroll
        for (int jj = 0; jj < 4; ++jj) { const int s0 = sq * 32 + 8 * jj; float x[8];
            if (!sample) { const f32x4 a = *(const f32x4*)(wsp + t * 128 + s0), b = *(const f32x4*)(wsp + t * 128 + s0 + 4);
                x[0] = a[0]; x[1] = a[1]; x[2] = a[2]; x[3] = a[3]; x[4] = b[0]; x[5] = b[1]; x[6] = b[2]; x[7] = b[3];
#pragma unroll
                for (int e = 0; e < 8; ++e) x[e] = (s0 + e <= t) ? x[e] : 0.f; }
            else {
#pragma unroll
                for (int e = 0; e < 8; ++e) { const int s = s0 + e; x[e] = ((s >> 3) == (t >> 3) && (s & 7) <= (t & 7)) ? wsp[(t & 7) * 128 + (s & 7)] : 0.f; } }
            v4u p; p.x = pkbf(x[0], x[1]); p.y = pkbf(x[2], x[3]); p.z = pkbf(x[4], x[5]); p.w = pkbf(x[6], x[7]);
            *(LAS v4u*)(lds + MX_W + t * HP + s0 * 2) = p; }
    }
    LDS_BARRIER();
    const int i = lane & 15, q = lane >> 4;
    f32x4 acc[8];
#pragma unroll
    for (int ct = 0; ct < 8; ++ct) acc[ct] = (f32x4){0.f, 0.f, 0.f, 0.f};
    const int nks = (wave >> 1) + 1;
    for (int ks = 0; ks < nks; ++ks) { const bf16x8 Y = *(const LAS bf16x8*)(lds + MX_W + (16 * wave + i) * HP + (32 * ks + 8 * q) * 2);
#pragma unroll
        for (int ct = 0; ct < 8; ++ct) { const bf16x8 X = *(const LAS bf16x8*)(lds + MX_VNT + (16 * ct + i) * HP + (32 * ks + 8 * q) * 2); acc[ct] = MFMA16(X, Y, acc[ct]); } }
    const int t = 16 * wave + i; const float bias = bsp[sample ? (t & 7) : t];
#pragma unroll
    for (int ct = 0; ct < 8; ++ct) { const int c = g * 128 + 16 * ct + 4 * q; const v2u uw = *(const v2u*)(Z + (size_t)(r0 + t) * NIN + ZU + c);
        const float y0 = bflo(uw.x) * (acc[ct][0] + bias), y1 = bfhi(uw.x) * (acc[ct][1] + bias), y2 = bflo(uw.y) * (acc[ct][2] + bias), y3 = bfhi(uw.y) * (acc[ct][3] + bias);
        *(v2u*)(YA + (size_t)(r0 + t) * 1024 + c) = (v2u){pkbf(y0, y1), pkbf(y2, y3)}; }
    LDS_BARRIER();
}

constexpr int MD_PITCH = 144, MD_WT = 0, MD_AS = 128 * MD_PITCH, MD_BUF = MD_AS + 144 * MD_PITCH;
static_assert(2 * MD_BUF <= RING_BYTES, "mod lds");
DI void mod_direct(LAS unsigned char* lds, int tid, int wave, int lane, int slab, const float* cp, const float* cs, const float* adaw, const float* adab, float* MOD) {
    asm volatile("" : "+v"(tid), "+v"(lane), "+s"(wave));
    const int n0g = slab * 128, l = n0g / 12288, n0 = n0g - l * 12288, i = lane & 15, q = lane >> 4;
    const int wn = tid & 127, wk = tid >> 7;
    const float* W = adaw + (size_t)l * 2048 * 12288 + n0 + wn + (size_t)(16 * wk) * 12288;
    float wv[2][16]; f32x4 av[2][5];
    f32x4 acc[9];
#pragma unroll
    for (int mt = 0; mt < 9; ++mt) acc[mt] = (f32x4){0.f, 0.f, 0.f, 0.f};
#define MD_LOAD(kc, B) do { \
        _Pragma("unroll") for (int kk = 0; kk < 16; ++kk) wv[B][kk] = __builtin_nontemporal_load(W + (size_t)(64 * (kc) + kk) * 12288); \
        _Pragma("unroll") for (int ii = 0; ii < 5; ++ii) { const int idx = tid + 512 * ii, row = idx >> 4, c4 = idx & 15; \
            av[B][ii] = (f32x4){0.f, 0.f, 0.f, 0.f}; \
            if (idx < 2304 && row < NCOND) av[B][ii] = *(const f32x4*)((row < 4 ? cp + (size_t)row * DM : cs + (size_t)(row - 4) * DM) + 64 * (kc) + 4 * c4); } } while (0)
#define MD_STEP(kc, B) do { \
        LAS unsigned char* buf = lds + ((kc) & 1) * MD_BUF; \
        { v4u p0, p1; p0.x = pkbf(wv[B][0], wv[B][1]); p0.y = pkbf(wv[B][2], wv[B][3]); p0.z = pkbf(wv[B][4], wv[B][5]); p0.w = pkbf(wv[B][6], wv[B][7]); \
          p1.x = pkbf(wv[B][8], wv[B][9]); p1.y = pkbf(wv[B][10], wv[B][11]); p1.z = pkbf(wv[B][12], wv[B][13]); p1.w = pkbf(wv[B][14], wv[B][15]); \
          *(LAS v4u*)(buf + MD_WT + wn * MD_PITCH + 32 * wk) = p0; *(LAS v4u*)(buf + MD_WT + wn * MD_PITCH + 32 * wk + 16) = p1; } \
        _Pragma("unroll") for (int ii = 0; ii < 5; ++ii) { const int idx = tid + 512 * ii, row = idx >> 4, c4 = idx & 15; \
            if (idx < 2304) { const f32x4 v = av[B][ii]; \
                *(LAS v2u*)(buf + MD_AS + row * MD_PITCH + 8 * c4) = (v2u){pkbf(v[0] * sigm(v[0]), v[1] * sigm(v[1])), pkbf(v[2] * sigm(v[2]), v[3] * sigm(v[3]))}; } } \
        if ((kc) + 2 < 32) MD_LOAD((kc) + 2, B); \
        LDS_BARRIER(); \
        { bf16x8 X[2]; \
          _Pragma("unroll") for (int ks = 0; ks < 2; ++ks) X[ks] = *(const LAS bf16x8*)(buf + MD_WT + (16 * wave + i) * MD_PITCH + (32 * ks + 8 * q) * 2); \
          _Pragma("unroll") for (int mt = 0; mt < 9; ++mt) \
              _Pragma("unroll") for (int ks = 0; ks < 2; ++ks) { const bf16x8 Y = *(const LAS bf16x8*)(buf + MD_AS + (16 * mt + i) * MD_PITCH + (32 * ks + 8 * q) * 2); acc[mt] = MFMA16(X[ks], Y, acc[mt]); } } } while (0)
    MD_LOAD(0, 0); MD_LOAD(1, 1);
    for (int kc = 0; kc < 32; kc += 2) { MD_STEP(kc, 0); MD_STEP(kc + 1, 1); }
#undef MD_STEP
#undef MD_LOAD
    { const int n = n0g + 16 * wave + 4 * q; const f32x4 bias = *(const f32x4*)(adab + n);
#pragma unroll
      for (int mt = 0; mt < 9; ++mt) { const int cb = 16 * mt + i; if (cb < NCOND) *(f32x4*)(MOD + (size_t)cb * MODP + n) = acc[mt] + bias; } }
    LDS_BARRIER();
}

__global__ void __launch_bounds__(NWAVES * 64, 2) mk_fwd(Args args) {
    extern __shared__ __attribute__((aligned(16))) unsigned char lds_raw[];
    LAS unsigned char* lds = (LAS unsigned char*)lds_raw;
    volatile LAS unsigned* MISC = (volatile LAS unsigned*)(lds + MISC_OFF);
    const int wv0 = __builtin_amdgcn_readfirstlane((int)(threadIdx.x >> 6));
#define IDS() int tid = wv0 * 64 + hw_lane(); asm volatile("" : "+v"(tid)); const int lane = tid & 63, wave = __builtin_amdgcn_readfirstlane(tid >> 6), gw = vcu * NWAVES + wave; (void)lane; (void)gw
    const int G = gridDim.x, bx = blockIdx.x;
    const int vcu = (G % 8 == 0) ? (bx % 8) * (G / 8) + bx / 8 : bx;
    const int NGW = G * NWAVES;
    unsigned char* ws = args.ws;
    gu32* ctl = (gu32*)(ws + WS_CTL);
    for (int u = wv0 * 64 + hw_lane(); u < (LDS_BYTES - LDSCTL_OFF) / 4; u += NWAVES * 64) ((LAS unsigned*)(lds + LDSCTL_OFF))[u] = 0u;
    __syncthreads();
    XcdBarrier bar = xcd_barrier_post((unsigned*)(ctl + CW_BAR), MISC + 8, wv0);
#define GRID_BAR() do { XcdBarrier b_ = bar; int z_ = 0; asm volatile("" : "+s"(z_), "+s"(b_.x)); b_.bar += z_; xcd_barrier(b_); } while (0)

    float* MOD = (float*)(ws + WS_MOD);
    bf16* X = (bf16*)(ws + WS_X); bf16* H = (bf16*)(ws + WS_H); bf16* Z = (bf16*)(ws + WS_Z); bf16* UP = Z;
    bf16* YA = (bf16*)(ws + WS_YA); bf16* OB = (bf16*)(ws + WS_O); bf16* Y = (bf16*)(ws + WS_Y); bf16* ACT = (bf16*)(ws + WS_ACT);
    float* out = args.out; bf16* SLAB = (bf16*)(ws + WS_SLAB); bf16* Xs = X + (size_t)MP * DM;

    {
        IDS();
        for (int slab = bx; slab < 192; slab += G) mod_direct(lds, tid, wave, lane, slab, inp(args, I_CP), inp(args, I_CS), inp(args, I_ADAW), inp(args, I_ADAB), MOD);
        LAS float* scr = (LAS float*)(lds + RING_OFF + wave * 16384);
        constexpr int IT_IN = 32 * 448, IT_BA = 16 * 64, IT_BB = 32 * 64, IT_OUT = 32 * 64, IT_UP = 32 * 352, IT_DN = 88 * 64;
        const int IT_L = (G == 256) ? IT_IN + IT_BA + IT_BB + IT_OUT + IT_UP : IT_IN + IT_BA + IT_BB + IT_OUT + IT_UP + IT_DN;
        auto decode = [&](int it, P0It& d) {
            const int l = it / IT_L; int r = it - l * IT_L;
            if (r < IT_IN) { d = P0It{inp(args, I_WIN) + (size_t)l * 2048 * NIN, NIN, (bf16*)(ws + WS_WIN + l * SZ_WIN), 2048, r}; return; } r -= IT_IN;
            if (r < IT_BA) { d = P0It{inp(args, I_WBA) + (size_t)l * 1024 * 2048, 2048, (bf16*)(ws + WS_WBA + l * SZ_WBA), 1024, r}; return; } r -= IT_BA;
            if (r < IT_BB) { d = P0It{inp(args, I_WBB) + (size_t)l * 2048 * 2048, 2048, (bf16*)(ws + WS_WBB + l * SZ_WBB), 2048, r}; return; } r -= IT_BB;
            if (r < IT_OUT) { d = P0It{inp(args, I_WOUT) + (size_t)l * 2048 * 2048, 2048, (bf16*)(ws + WS_WOUT + l * SZ_WOUT), 2048, r}; return; } r -= IT_OUT;
            if (r < IT_UP) { d = P0It{inp(args, I_WUP) + (size_t)l * 2048 * NUP, NUP, (bf16*)(ws + WS_WUP + l * SZ_WUP), 2048, r}; return; } r -= IT_UP;
            d = P0It{inp(args, I_WDN) + (size_t)l * DFF * 2048, 2048, (bf16*)(ws + WS_WDN + l * SZ_WDN), DFF, r}; };
        { P0It da, db; float va[32], vb[32]; int it = gw;
          if (it < 2 * IT_L) { decode(it, da); p0_item_load(da, lane, va); }
          while (it < 2 * IT_L) {
              int itn = it + NGW; if (itn < 2 * IT_L) { decode(itn, db); p0_item_load(db, lane, vb); }
              p0_item_store(da, scr, lane, va);
              it = itn; if (it >= 2 * IT_L) break;
              itn = it + NGW; if (itn < 2 * IT_L) { decode(itn, da); p0_item_load(da, lane, va); }
              p0_item_store(db, scr, lane, vb);
              it = itn; } }
    }
    GRID_BAR();

    for (int l = 0; l < 2; ++l) {
        int bxl = blockIdx.x; asm volatile("" : "+s"(bxl));
        const float* modl = MOD + (size_t)l * 12288;
        const void* xin_p = (l == 0) ? (const void*)inp(args, I_XP) : (const void*)X; const void* xin_s = (l == 0) ? (const void*)inp(args, I_XS) : (const void*)Xs;
        { IDS(); norm_rows<false>(xin_p, xin_s, l != 0, l != 0, inp(args, I_N1) + l * DM, modl, H, nullptr, gw, NGW, lane, (l == 0) ? nullptr : SLAB, MOD + 5 * DM  , Xs, lds); }
        GRID_BAR();
        {
            pg8::Gemm g{H, (const bf16*)(ws + WS_WIN + l * SZ_WIN), MT, 40 * 256, DM}; pg8::StaticOrder S; S.init(MT, 40 * 256, DM, G, bxl);
            pg8::EpiZ E{Z, NIN, 0};
            pg8::gemm_phase<pg8::EpiZ, pg8::StaticOrder, true, true>(lds + RING_OFF, g, S, E, wv0);
        }
        if (G == 256 && bxl >= 160) {
            IDS();
            LAS float* scr = (LAS float*)(lds + RING_OFF + wave * 16384);
            constexpr int IT_DN = 88 * 64; const int w0 = (bxl - 160) * NWAVES + wave, nw = 96 * NWAVES;
            const float* wsrc = inp(args, I_WDN) + (size_t)l * DFF * 2048; bf16* wdst = (bf16*)(ws + WS_WDN + l * SZ_WDN);
            for (int it = w0; it < IT_DN; it += nw) { int it_ = it; asm volatile("" : "+s"(it_));
                const P0It d{wsrc, 2048, wdst, DFF, it_}; float v[32]; p0_item_load(d, lane, v); p0_item_store(d, scr, lane, v); }
        }
        GRID_BAR();
        {
            IDS();
            const float* hng = inp(args, I_HNG) + l * 2048; const float* lbp = inp(args, I_LB);
            for (int pu = bxl; pu < 64; pu += G) { const int b = pu >> 4, h = pu & 15;
                hgrn_prompt_unit(lds, tid, wave, lane, Z, OB, out + O_HP + ((size_t)(l * 4 + b) * 16 + h) * 16384, hng + h * 128, lbp, l, h, b * 2048, 32); }
            const int nb = (G > 64) ? G - 64 : G, jb = (G > 64) ? bxl - 64 : bxl;
            if (jb >= 0) for (int step = 0; step < 2; ++step) {
                if (((step ^ jb) & 1) == 0) {
                    pg8::Gemm g{H, (const bf16*)(ws + WS_WIN + l * SZ_WIN) + (size_t)40 * 256 * DM, MT, 16 * 256, DM}; pg8::StaticOrder S; S.init(MT, 16 * 256, DM, nb, jb);
                    pg8::EpiZ E{Z, NIN, 40};
                    pg8::gemm_phase<pg8::EpiZ, pg8::StaticOrder, true, true>(lds + RING_OFF, g, S, E, wv0);
                    continue;
                }
                hgrn_sample_loop(lds, tid, wave, lane, Z, OB, inp(args, I_SH) + (size_t)l * 2048 * 16384, out + O_HS + (size_t)l * 2048 * 16384, hng, lbp, l, jb, nb);
                for (int mu = jb; mu < 576; mu += nb) { const int tt = mu % 72, g = mu / 72;
                    float* vout = nullptr;
                    if (tt >= 64) vout = out + O_VS + ((size_t)l * 1024 + (size_t)(tt - 64) * 128) * 1024 + g * 128;
                    else if ((tt & 15) == 15) vout = out + O_VP + ((size_t)(l * 4 + (tt >> 4)) * 128) * 1024 + g * 128;
                    mixer_unit(lds, tid, wave, lane, tt, g, Z, YA, inp(args, I_WS) + (size_t)(l * 8 + g) * 16384, inp(args, I_BS) + (l * 8 + g) * 128, inp(args, I_VG) + l * 1024 + g * 128, vout); }
            }
        }
        GRID_BAR();
        {
            { pg8::SplitOrder S; S.init(1024, 4, G, bxl); pg8::Gemm g{YA, (const bf16*)(ws + WS_WBA + l * SZ_WBA), MT, DM, 1024};
              pg8::EpiSplit<pg8::EpiBranch<false>> E{{Z + ZGA, Y}, SLAB};
              pg8::gemm_phase<pg8::EpiSplit<pg8::EpiBranch<false>>, pg8::SplitOrder, true, true>(lds + RING_OFF, g, S, E, wv0); }
            { pg8::SplitOrder S; S.init(2048, 8, G, bxl); pg8::Gemm g{OB, (const bf16*)(ws + WS_WBB + l * SZ_WBB), MT, DM, 2048};
              pg8::EpiSplit<pg8::EpiBranch<true>> E{{Z + ZGB, Y}, SLAB + 4 * pg8::SLAB_ELEMS};
              pg8::gemm_phase<pg8::EpiSplit<pg8::EpiBranch<true>>, pg8::SplitOrder, true, true>(lds + RING_OFF, g, S, E, wv0); }
        }
        GRID_BAR();
        { IDS();
        for (int it = gw; it < 2 * MS; it += NGW) { const int r = it >> 1, c0 = (it & 1) * 1024 + 8 * lane;
            f32x4 a[2][2], b[2][2];
#pragma unroll
            for (int h = 0; h < 2; ++h) { a[h][0] = (f32x4){0.f, 0.f, 0.f, 0.f}; a[h][1] = a[h][0]; b[h][0] = a[h][0]; b[h][1] = a[h][0]; }
            v4u w[12][2];
#pragma unroll
            for (int s2 = 0; s2 < 12; ++s2)
#pragma unroll
                for (int h = 0; h < 2; ++h) w[s2][h] = *(const v4u*)(SLAB + (size_t)s2 * pg8::SLAB_ELEMS + (size_t)r * DM + c0 + 512 * h);
            const bf16* zr = Z + (size_t)(MP + r) * NIN + c0;
            v4u ga[2], gb[2];
#pragma unroll
            for (int h = 0; h < 2; ++h) { ga[h] = *(const v4u*)(zr + ZGA + 512 * h); gb[h] = *(const v4u*)(zr + ZGB + 512 * h); }
#pragma unroll
            for (int s2 = 0; s2 < 12; ++s2)
#pragma unroll
                for (int h = 0; h < 2; ++h) { const v4u x = w[s2][h]; const f32x4 lo = {bflo(x.x), bfhi(x.x), bflo(x.y), bfhi(x.y)}, hi = {bflo(x.z), bfhi(x.z), bflo(x.w), bfhi(x.w)};
                    if (s2 < 4) { a[h][0] += lo; a[h][1] += hi; } else { b[h][0] += lo; b[h][1] += hi; } }
#pragma unroll
            for (int h = 0; h < 2; ++h) { const v4u p = ga[h], q = gb[h];
                const f32x4 gal = {bflo(p.x), bfhi(p.x), bflo(p.y), bfhi(p.y)}, gah = {bflo(p.z), bfhi(p.z), bflo(p.w), bfhi(p.w)}, gbl = {bflo(q.x), bfhi(q.x), bflo(q.y), bfhi(q.y)}, gbh = {bflo(q.z), bfhi(q.z), bflo(q.w), bfhi(q.w)};
                const f32x4 yl = gal * a[h][0] + gbl * b[h][0], yh = gah * a[h][1] + gbh * b[h][1];
                v4u o; o.x = pkbf(yl.x, yl.y); o.y = pkbf(yl.z, yl.w); o.z = pkbf(yh.x, yh.y); o.w = pkbf(yh.z, yh.w);
                *(v4u*)(Y + (size_t)(MP + r) * DM + c0 + 512 * h) = o; } } }
        GRID_BAR();
        {
            pg8::SplitOrder S; S.init(DM, 8, G, bxl); pg8::Gemm g{Y, (const bf16*)(ws + WS_WOUT + l * SZ_WOUT), MT, DM, DM};
            pg8::EpiSplit<pg8::EpiResid> E{{(const float*)xin_p, X, modl + 2 * DM, l == 0}, SLAB};
            pg8::gemm_phase<pg8::EpiSplit<pg8::EpiResid>, pg8::SplitOrder, true, true>(lds + RING_OFF, g, S, E, wv0);
        }
        GRID_BAR();
        { IDS(); norm_rows<false>(X, xin_s, true, l != 0, inp(args, I_N2) + l * DM, modl + 3 * DM, H, nullptr, gw, NGW, lane, SLAB, modl + 2 * DM, Xs, lds); }
        GRID_BAR();
        {
            pg8::Gemm g{H, (const bf16*)(ws + WS_WUP + l * SZ_WUP), MT, NUP, DM}; pg8::UpOrder S; S.init(G, bxl);
            pg8::EpiUpSplit E{{UP, out + O_CP + (size_t)l * 4 * 2 * NUP, out + O_CS + (size_t)l * 128 * 2 * NUP}, SLAB};
            pg8::gemm_phase<pg8::EpiUpSplit, pg8::UpOrder, true, true>(lds + RING_OFF, g, S, E, wv0);
        }
        GRID_BAR();
        {
            const float* cw = inp(args, I_CW) + (size_t)l * 3 * NUP; const float* cbias = inp(args, I_CB) + (size_t)l * NUP; const float* cst = inp(args, I_SC) + (size_t)l * 128 * 2 * NUP;
            IDS();
            constexpr int NWC = DFF / 512, NRG = MT / 8, NSB = 4;
            const int nseg = NGW / NWC;
            if (gw < nseg * NWC) {
                const int wcb = gw % NWC, sg = gw / NWC, col = (wcb * 64 + lane) * 8;
                constexpr int NPR = MP / 8, NSR = MS / 8;
                const bool wdeal = nseg > NSR && 5 * NSR < NPR;
                const int pr0 = wdeal ? (sg < NSR ? 5 * sg : 5 * NSR + ((sg - NSR) * (NPR - 5 * NSR)) / (nseg - NSR)) : (sg * NPR) / nseg;
                const int pr1 = wdeal ? (sg < NSR ? 5 * sg + 5 : 5 * NSR + ((sg + 1 - NSR) * (NPR - 5 * NSR)) / (nseg - NSR)) : ((sg + 1) * NPR) / nseg;
                float wa[3][8], wb[3][8], ba[8], bb[8];
#pragma unroll
                for (int k = 0; k < 3; ++k) { const f32x4 a0 = *(const f32x4*)(cw + k * NUP + col), a1 = *(const f32x4*)(cw + k * NUP + col + 4), b0 = *(const f32x4*)(cw + k * NUP + DFF + col), b1 = *(const f32x4*)(cw + k * NUP + DFF + col + 4);
#pragma unroll
                    for (int e = 0; e < 4; ++e) { wa[k][e] = a0[e]; wa[k][4 + e] = a1[e]; wb[k][e] = b0[e]; wb[k][4 + e] = b1[e]; } }
                { const f32x4 a0 = *(const f32x4*)(cbias + col), a1 = *(const f32x4*)(cbias + col + 4), b0 = *(const f32x4*)(cbias + DFF + col), b1 = *(const f32x4*)(cbias + DFF + col + 4);
#pragma unroll
                  for (int e = 0; e < 4; ++e) { ba[e] = a0[e]; ba[4 + e] = a1[e]; bb[e] = b0[e]; bb[4 + e] = b1[e]; } }
                const bool slabcols = col >= 2560;
                for (int part = 0;; ++part) {
                int rg0 = pr0, rg1 = pr1;
                if (part > 0) { const int srg = sg + (part - 1) * nseg; if (srg >= NSR) break; rg0 = NPR + srg; rg1 = rg0 + 1; }
                for (int rs = rg0; rs < rg1;) {
                    float pa2[8], pa1[8], pb2[8], pb1[8];
                    const int rb = rs * 8;
                    int re = rs + 1;
                    if (rb >= MP) { const float* s0 = cst + (size_t)((rb - MP) >> 3) * 2 * NUP + col;
#pragma unroll
                        for (int e = 0; e < 8; ++e) { pa2[e] = s0[e]; pa1[e] = s0[NUP + e]; pb2[e] = s0[DFF + e]; pb1[e] = s0[NUP + DFF + e]; } }
                    else {
                        re = ((rs >> 8) + 1) << 8; re = re < rg1 ? re : rg1;
                        if ((rb & 2047) == 0) {
#pragma unroll
                            for (int e = 0; e < 8; ++e) { pa2[e] = 0.f; pa1[e] = 0.f; pb2[e] = 0.f; pb1[e] = 0.f; } }
                        else { const v4u a2 = *(const v4u*)(UP + (size_t)(rb - 2) * NUP + col), a1 = *(const v4u*)(UP + (size_t)(rb - 1) * NUP + col), b2 = *(const v4u*)(UP + (size_t)(rb - 2) * NUP + DFF + col), b1 = *(const v4u*)(UP + (size_t)(rb - 1) * NUP + DFF + col);
#pragma unroll
                            for (int e = 0; e < 4; ++e) { pa2[2 * e] = bflo(a2[e]); pa2[2 * e + 1] = bfhi(a2[e]); pa1[2 * e] = bflo(a1[e]); pa1[2 * e + 1] = bfhi(a1[e]);
                                pb2[2 * e] = bflo(b2[e]); pb2[2 * e + 1] = bfhi(b2[e]); pb1[2 * e] = bflo(b1[e]); pb1[2 * e + 1] = bfhi(b1[e]); } } }
                    for (int rg = rs; rg < re; ++rg) {
                    const int r0 = rg * 8;
                    const bool fromslab = (r0 >= MP) && slabcols;
                    if (!fromslab) {
#pragma unroll
                        for (int jb = 0; jb < 8; jb += 8) {
                        v4u avr[8], bvr[8];
#pragma unroll
                        for (int j = 0; j < 8; ++j) { avr[j] = *(const v4u*)(UP + (size_t)(r0 + jb + j) * NUP + col); bvr[j] = *(const v4u*)(UP + (size_t)(r0 + jb + j) * NUP + DFF + col); }
#pragma unroll
                        for (int jj = 0; jj < 8; ++jj) { const int j = jb + jj; float ca[8], cb2[8], res[8];
#pragma unroll
                            for (int e = 0; e < 4; ++e) { ca[2 * e] = bflo(avr[jj][e]); ca[2 * e + 1] = bfhi(avr[jj][e]); cb2[2 * e] = bflo(bvr[jj][e]); cb2[2 * e + 1] = bfhi(bvr[jj][e]); }
#pragma unroll
                            for (int e = 0; e < 8; ++e) { const float a = ba[e] + wa[0][e] * pa2[e] + wa[1][e] * pa1[e] + wa[2][e] * ca[e]; const float b = bb[e] + wb[0][e] * pb2[e] + wb[1][e] * pb1[e] + wb[2][e] * cb2[e];
                                res[e] = gelu_t(a) * b; pa2[e] = pa1[e]; pa1[e] = ca[e]; pb2[e] = pb1[e]; pb1[e] = cb2[e]; }
                            v4u w; w.x = pkbf(res[0], res[1]); w.y = pkbf(res[2], res[3]); w.z = pkbf(res[4], res[5]); w.w = pkbf(res[6], res[7]);
                            *(v4u*)(ACT + (size_t)(r0 + j) * DFF + col) = w; }
                        asm volatile("" ::: "memory"); }
                    } else
#pragma unroll
                    for (int jb = 0; jb < 8; jb += NSB) {
                        v4u avs[NSB], sls[NSB][4];
#pragma unroll
                        for (int jj = 0; jj < NSB; ++jj) { avs[jj] = *(const v4u*)(UP + (size_t)(r0 + jb + jj) * NUP + col);
                            const bf16* sp = SLAB + (size_t)(r0 - MP + jb + jj) * 3072 + (col - 2560);
#pragma unroll
                            for (int q = 0; q < 4; ++q) sls[jj][q] = *(const v4u*)(sp + q * pg8::UPSLAB_ELEMS); }
#pragma unroll
                        for (int jj = 0; jj < NSB; ++jj) { const int j = jb + jj; const v4u av = avs[jj];
                        float ca[8], cb2[8], res[8];
#pragma unroll
                        for (int e = 0; e < 4; ++e) { ca[2 * e] = bflo(av[e]); ca[2 * e + 1] = bfhi(av[e]); }
                        { f32x4 s0 = {0.f, 0.f, 0.f, 0.f}, s1 = s0;
#pragma unroll
                          for (int q = 0; q < 4; ++q) { const v4u w = sls[jj][q]; s0 += (f32x4){bflo(w.x), bfhi(w.x), bflo(w.y), bfhi(w.y)}; s1 += (f32x4){bflo(w.z), bfhi(w.z), bflo(w.w), bfhi(w.w)}; }
#pragma unroll
                          for (int e = 0; e < 4; ++e) { cb2[e] = s0[e]; cb2[4 + e] = s1[e]; }
                          if (j >= 6) { float* fo = out + O_CS + (size_t)l * 128 * 2 * NUP + (size_t)(((r0 - MP) >> 3) * 2 + (j - 6)) * NUP + DFF + col; *(f32x4*)fo = s0; *(f32x4*)(fo + 4) = s1; } }
#pragma unroll
                        for (int e = 0; e < 8; ++e) { const float a = ba[e] + wa[0][e] * pa2[e] + wa[1][e] * pa1[e] + wa[2][e] * ca[e]; const float b = bb[e] + wb[0][e] * pb2[e] + wb[1][e] * pb1[e] + wb[2][e] * cb2[e];
                            res[e] = gelu_t(a) * b; pa2[e] = pa1[e]; pa1[e] = ca[e]; pb2[e] = pb1[e]; pb1[e] = cb2[e]; }
                        v4u w; w.x = pkbf(res[0], res[1]); w.y = pkbf(res[2], res[3]); w.z = pkbf(res[4], res[5]); w.w = pkbf(res[6], res[7]);
                        *(v4u*)(ACT + (size_t)(r0 + j) * DFF + col) = w; }
                        asm volatile("" ::: "memory"); }
                    }
                    rs = re;
                }
                }
            }
        }
        GRID_BAR();
        {
            pg8::Gemm g{ACT, (const bf16*)(ws + WS_WDN + l * SZ_WDN), MT, DM, DFF}; pg8::SplitOrder S; S.init(DFF, 8, G, bxl);
            pg8::EpiSplit<pg8::EpiResid> E{{nullptr, X, modl + 5 * DM, false}, SLAB};
            pg8::gemm_phase<pg8::EpiSplit<pg8::EpiResid>, pg8::SplitOrder, true, true>(lds + RING_OFF, g, S, E, wv0);
        }
        GRID_BAR();
    }
    { IDS(); norm_rows<true>(X, Xs, true, true, inp(args, I_FNG), nullptr, nullptr, out, gw, NGW, lane, SLAB, MOD + 12288 + 5 * DM  , nullptr, lds); }
}

extern "C" void kernel_launch(void* const* d_in, const int* in_sizes, int n_in, void* d_out, int out_size, void* d_ws, size_t ws_size, hipStream_t stream) {
    static int grid = 0;
    if (grid == 0) {
        if (n_in != 24 || (size_t)out_size != O_END || ws_size < WS_END) { fprintf(stderr, "kernel_launch: unexpected shapes (n_in %d, out %d, ws %zu); nothing launched\n", n_in, out_size, ws_size); grid = -1; return; }
        int dev = 0, cus = 0, per_cu = 0;
        if (hipGetDevice(&dev) != hipSuccess || hipDeviceGetAttribute(&cus, hipDeviceAttributeMultiprocessorCount, dev) != hipSuccess) { grid = -1; return; }
        if (hipFuncSetAttribute((const void*)mk_fwd, hipFuncAttributeMaxDynamicSharedMemorySize, LDS_BYTES) != hipSuccess) { fprintf(stderr, "kernel_launch: hipFuncSetAttribute failed\n"); grid = -1; return; }
        if (hipOccupancyMaxActiveBlocksPerMultiprocessor(&per_cu, (const void*)mk_fwd, NWAVES * 64, LDS_BYTES) != hipSuccess || per_cu < 1) { fprintf(stderr, "kernel_launch: occupancy query reports %d blocks per CU\n", per_cu); }
        (void)hipGetLastError();
        grid = cus;
    }
    if (grid < 0) return;
    if (hipMemsetAsync((char*)d_ws + WS_CTL, 0, CTL_ZERO_BYTES, stream) != hipSuccess) return;
    Args a{};
    for (int i = 0; i < 24; ++i) a.in[i] = (const float*)d_in[i];
    a.out = (float*)d_out; a.ws = (unsigned char*)d_ws;
    hipLaunchKernelGGL(mk_fwd, dim3(grid), dim3(NWAVES * 64), LDS_BYTES, stream, a);
}
```

```cpp
#include <hip/hip_runtime.h>
#include <cstdio>
#include <cstdint>
__device__ __forceinline__ int hw_lane() { int l; asm volatile("v_mbcnt_lo_u32_b32 %0, -1, 0\n\tv_mbcnt_hi_u32_b32 %0, -1, %0" : "=v"(l)); return l; }
namespace pg8 {
#define PG8_LAS __attribute__((address_space(3)))
typedef unsigned short bf16_t;
typedef short bf16x8 __attribute__((ext_vector_type(8)));
typedef float f32x4 __attribute__((ext_vector_type(4)));
typedef unsigned u32x4 __attribute__((ext_vector_type(4)));
constexpr int BM = 256, BK = 64, HALF = 128, HTB = HALF * BK * 2  , STAGE_BYTES = 8 * HTB, NXCD = 8, WGM = 4;

__host__ __device__ __forceinline__ int lds_byte(int r, int c) { const int st = (r >> 4) * 2 + (c >> 5), rr = r & 15, cc = c & 31, ob = rr * 64 + cc * 2; return st * 1024 + (ob ^ (((ob >> 9) & 1) << 5)); }
__host__ __device__ __forceinline__ void stage_rc(int b, int& R, int& C) { const int st = b / 1024, sb = b % 1024, swz = sb ^ (((sb >> 9) & 1) << 5); R = (st >> 1) * 16 + swz / 64; C = (st & 1) * 32 + (swz % 64) / 2; }
__host__ __device__ __forceinline__ int perm32(int rho) { const int n = rho >> 4, i = rho & 15; return 8 * (i >> 2) + 4 * n + (i & 3); }

struct Unit { int pm, pn, kt0, nkt, aux; };
struct Gemm { const bf16_t* A; const bf16_t* Bt; int M, N, K; };

struct StaticOrder {
    static constexpr bool PARTS = false;
    int nM, nN, nwg, G, c, nkt;
    __host__ __device__ __forceinline__ void init(int M, int N, int K, int G_, int c_) { nM = M / BM; nN = N / BM; nwg = nM * nN; G = G_; c = c_; nkt = K / BK; }
    __host__ __device__ __forceinline__ bool next(int i, Unit& u) const {
        const long L = (long)i * G + c; if (L >= nwg) return false;
        int wgid = (int)L; { const int q = nwg / NXCD, r = nwg % NXCD, xcd = wgid % NXCD, off = wgid / NXCD; wgid = (xcd < r ? xcd * (q + 1) : r * (q + 1) + (xcd - r) * q) + off; }
        const int nig = WGM * nN, gid = wgid / nig, fm = gid * WGM, gsz = (nM - fm) < WGM ? (nM - fm) : WGM;
        u.pm = fm + ((wgid % nig) % gsz); u.pn = (wgid % nig) / gsz; u.kt0 = 0; u.nkt = nkt; u.aux = -1; return true;
    }
    __device__ __forceinline__ void a_ready(const Unit&) const {}
    __device__ __forceinline__ void done(const Unit&) const {}
};

__device__ __forceinline__ unsigned cvt_pk_bf16(float lo, float hi) { unsigned r; asm volatile("v_cvt_pk_bf16_f32 %0, %1, %2" : "=v"(r) : "v"(lo), "v"(hi)); return r; }
typedef float f32x2 __attribute__((ext_vector_type(2)));
typedef unsigned u32x2 __attribute__((ext_vector_type(2)));
typedef float f32x2 __attribute__((ext_vector_type(2)));
typedef __bf16 bf2_t __attribute__((ext_vector_type(2)));
__device__ __forceinline__ unsigned pkbf(float lo, float hi) { f32x2 v = {lo, hi}; return __builtin_bit_cast(unsigned, __builtin_convertvector(v, bf2_t)); }
__device__ __forceinline__ float bflo(unsigned w) { return __builtin_bit_cast(float, w << 16); }
__device__ __forceinline__ float bfhi(unsigned w) { return __builtin_bit_cast(float, w & 0xffff0000u); }
__device__ __forceinline__ float sigm(float x) { return __builtin_amdgcn_rcpf(1.f + __builtin_amdgcn_exp2f(-1.44269504089f * x)); }
__device__ __forceinline__ float gelu_t(float x) { const float u = x * (1.f + 0.044715f * x * x); return x * sigm(1.59576912161f * u); }

struct EpiF32 {
    static constexpr bool PERM = false, AFTER_DRAIN = false, HAS_MID = false;
    float* C; int ldc; const float* bias;
    __device__ __forceinline__ void operator()(const f32x4 (&acc)[2][2][4][2], const Unit& u, int wr, int wc, int fr, int fq) const {
        const int row0 = u.pm * BM + wr * 64 + fr, col0 = u.pn * BM + wc * 32 + 4 * fq;
        f32x4 bv[2][2];
#pragma unroll
        for (int bj = 0; bj < 2; ++bj)
#pragma unroll
            for (int n = 0; n < 2; ++n) bv[bj][n] = *(const f32x4*)(bias + col0 + bj * HALF + n * 16);
#pragma unroll
        for (int ai = 0; ai < 2; ++ai)
#pragma unroll
            for (int m = 0; m < 4; ++m) { float* rowp = C + (size_t)(row0 + ai * HALF + m * 16) * ldc + col0;
#pragma unroll
                for (int bj = 0; bj < 2; ++bj)
#pragma unroll
                    for (int n = 0; n < 2; ++n) *(f32x4*)(rowp + bj * HALF + n * 16) = acc[ai][bj][m][n] + bv[bj][n]; }
    }
};
template <int MODE> __device__ __forceinline__ float zact(float x) {
    if (MODE == 0) return gelu_t(x);
    if (MODE == 1) return x * sigm(x) * 0.08838834764831845f;
    if (MODE == 2) return x;
    if (MODE == 3) return x * sigm(x);
    return sigm(x);
}
struct EpiZ {
    static constexpr bool PERM = true, AFTER_DRAIN = false, HAS_MID = false;
    bf16_t* Z; int ldc; int pn_off;
    template <int MODE> __device__ __forceinline__ void run(const f32x4 (&acc)[2][2][4][2], const Unit& u, int wr, int wc, int fr, int fq) const {
        const int row0 = u.pm * BM + wr * 64 + fr, col0 = (u.pn + pn_off) * BM + wc * 32 + 8 * fq;
#pragma unroll
        for (int ai = 0; ai < 2; ++ai)
#pragma unroll
            for (int m = 0; m < 4; ++m) { bf16_t* rowp = Z + (size_t)(row0 + ai * HALF + m * 16) * ldc + col0;
#pragma unroll
                for (int bj = 0; bj < 2; ++bj) { const f32x4 v0 = acc[ai][bj][m][0], v1 = acc[ai][bj][m][1];
                    u32x4 w; w.x = pkbf(zact<MODE>(v0[0]), zact<MODE>(v0[1])); w.y = pkbf(zact<MODE>(v0[2]), zact<MODE>(v0[3]));
                    w.z = pkbf(zact<MODE>(v1[0]), zact<MODE>(v1[1])); w.w = pkbf(zact<MODE>(v1[2]), zact<MODE>(v1[3]));
                    *(u32x4*)(rowp + bj * HALF) = w; } }
    }
    __device__ __forceinline__ void operator()(const f32x4 (&acc)[2][2][4][2], const Unit& u, int wr, int wc, int fr, int fq) const {
        const int pn = u.pn + pn_off;
        if (pn < 8) run<0>(acc, u, wr, wc, fr, fq);
        else if (pn < 16) run<1>(acc, u, wr, wc, fr, fq);
        else if (pn < 32) run<2>(acc, u, wr, wc, fr, fq);
        else if (pn < 40) run<3>(acc, u, wr, wc, fr, fq);
        else run<4>(acc, u, wr, wc, fr, fq);
    }
};
template <bool SECOND> struct EpiBranch {
    static constexpr bool PERM = true, AFTER_DRAIN = false, HAS_MID = false;
    const bf16_t* Zg; bf16_t* Y;
    __device__ __forceinline__ void operator()(const f32x4 (&acc)[2][2][4][2], const Unit& u, int wr, int wc, int fr, int fq) const {
        const int row0 = u.pm * BM + wr * 64 + fr, col0 = u.pn * BM + wc * 32 + 8 * fq;
#pragma unroll
        for (int ai = 0; ai < 2; ++ai) {
            u32x4 gt[4][2], pv[4][2];
#pragma unroll
            for (int m = 0; m < 4; ++m) { const size_t row = (size_t)(row0 + ai * HALF + m * 16);
#pragma unroll
                for (int bj = 0; bj < 2; ++bj) { gt[m][bj] = *(const u32x4*)(Zg + row * 14336 + col0 + bj * HALF); if (SECOND) pv[m][bj] = *(const u32x4*)(Y + row * 2048 + col0 + bj * HALF); } }
#pragma unroll
            for (int m = 0; m < 4; ++m) { bf16_t* yr = Y + (size_t)(row0 + ai * HALF + m * 16) * 2048 + col0;
#pragma unroll
                for (int bj = 0; bj < 2; ++bj) { const u32x4 g = gt[m][bj]; const f32x4 v0 = acc[ai][bj][m][0], v1 = acc[ai][bj][m][1];
                    float r[8] = {v0[0] * bflo(g.x), v0[1] * bfhi(g.x), v0[2] * bflo(g.y), v0[3] * bfhi(g.y), v1[0] * bflo(g.z), v1[1] * bfhi(g.z), v1[2] * bflo(g.w), v1[3] * bfhi(g.w)};
                    if (SECOND) { const u32x4 p = pv[m][bj];
                        r[0] += bflo(p.x); r[1] += bfhi(p.x); r[2] += bflo(p.y); r[3] += bfhi(p.y); r[4] += bflo(p.z); r[5] += bfhi(p.z); r[6] += bflo(p.w); r[7] += bfhi(p.w); }
                    u32x4 w; w.x = pkbf(r[0], r[1]); w.y = pkbf(r[2], r[3]); w.z = pkbf(r[4], r[5]); w.w = pkbf(r[6], r[7]);
                    *(u32x4*)(yr + bj * HALF) = w; } }
            asm volatile("" ::: "memory"); }
    }
};
struct EpiResid {
    static constexpr bool PERM = true, AFTER_DRAIN = false, HAS_MID = false;
    const float* base_f; bf16_t* X; const float* gate; bool f32base;
    __device__ __forceinline__ void operator()(const f32x4 (&acc)[2][2][4][2], const Unit& u, int wr, int wc, int fr, int fq) const {
        const int row0 = u.pm * BM + wr * 64 + fr, col0 = u.pn * BM + wc * 32 + 8 * fq;
        f32x4 gv[2][2];
#pragma unroll
        for (int bj = 0; bj < 2; ++bj)
#pragma unroll
            for (int n = 0; n < 2; ++n) gv[bj][n] = *(const f32x4*)(gate + (size_t)(u.pm >> 3) * 24576 + col0 + bj * HALF + n * 4);
        if (f32base) {
#pragma unroll
            for (int am = 0; am < 4; ++am) { const int ai = am >> 1, m0 = (am & 1) * 2;
                f32x4 bs[2][2][2];
#pragma unroll
                for (int m = 0; m < 2; ++m) { const float* bp = base_f + (size_t)(row0 + ai * HALF + (m0 + m) * 16) * 2048 + col0;
#pragma unroll
                    for (int bj = 0; bj < 2; ++bj)
#pragma unroll
                        for (int n = 0; n < 2; ++n) bs[m][bj][n] = *(const f32x4*)(bp + bj * HALF + n * 4); }
#pragma unroll
                for (int m = 0; m < 2; ++m) { bf16_t* xo = X + (size_t)(row0 + ai * HALF + (m0 + m) * 16) * 2048 + col0;
#pragma unroll
                    for (int bj = 0; bj < 2; ++bj) { const f32x4 v0 = bs[m][bj][0] + gv[bj][0] * acc[ai][bj][m0 + m][0], v1 = bs[m][bj][1] + gv[bj][1] * acc[ai][bj][m0 + m][1];
                        u32x4 w; w.x = pkbf(v0[0], v0[1]); w.y = pkbf(v0[2], v0[3]); w.z = pkbf(v1[0], v1[1]); w.w = pkbf(v1[2], v1[3]);
                        *(u32x4*)(xo + bj * HALF) = w; } }
                asm volatile("" ::: "memory"); }
        } else {
#pragma unroll
            for (int ai = 0; ai < 2; ++ai) {
                u32x4 bs[4][2];
#pragma unroll
                for (int m = 0; m < 4; ++m) { const bf16_t* bp = X + (size_t)(row0 + ai * HALF + m * 16) * 2048 + col0;
#pragma unroll
                    for (int bj = 0; bj < 2; ++bj) bs[m][bj] = *(const u32x4*)(bp + bj * HALF); }
#pragma unroll
                for (int m = 0; m < 4; ++m) { bf16_t* xo = X + (size_t)(row0 + ai * HALF + m * 16) * 2048 + col0;
#pragma unroll
                    for (int bj = 0; bj < 2; ++bj) { const u32x4 p = bs[m][bj]; const f32x4 a0 = acc[ai][bj][m][0], a1 = acc[ai][bj][m][1], g0 = gv[bj][0], g1 = gv[bj][1];
                        u32x4 w; w.x = pkbf(bflo(p.x) + g0[0] * a0[0], bfhi(p.x) + g0[1] * a0[1]); w.y = pkbf(bflo(p.y) + g0[2] * a0[2], bfhi(p.y) + g0[3] * a0[3]);
                        w.z = pkbf(bflo(p.z) + g1[0] * a1[0], bfhi(p.z) + g1[1] * a1[1]); w.w = pkbf(bflo(p.w) + g1[2] * a1[2], bfhi(p.w) + g1[3] * a1[3]);
                        *(u32x4*)(xo + bj * HALF) = w; } }
                asm volatile("" ::: "memory"); }
        }
    }
};
struct EpiUp {
    static constexpr bool PERM = true, AFTER_DRAIN = false, HAS_MID = false;
    bf16_t* UP; float* outp; float* outs;
    __device__ __forceinline__ void operator()(const f32x4 (&acc)[2][2][4][2], const Unit& u, int wr, int wc, int fr, int fq) const {
        const int row0 = u.pm * BM + wr * 64 + fr, col0 = u.pn * BM + wc * 32 + 8 * fq;
#pragma unroll
        for (int ai = 0; ai < 2; ++ai)
#pragma unroll
            for (int m = 0; m < 4; ++m) { const int row = row0 + ai * HALF + m * 16; bf16_t* rowp = UP + (size_t)row * 11264 + col0;
                float* fo = nullptr;
                if (row < 8192) { const int t = row & 2047; if (t >= 2046) fo = outp + (size_t)((row >> 11) * 2 + (t - 2046)) * 11264 + col0; }
                else { const int rr = row - 8192, t = rr & 7; if (t >= 6) fo = outs + (size_t)((rr >> 3) * 2 + (t - 6)) * 11264 + col0; }
#pragma unroll
                for (int bj = 0; bj < 2; ++bj) { const f32x4 v0 = acc[ai][bj][m][0], v1 = acc[ai][bj][m][1];
                    u32x4 w; w.x = pkbf(v0[0], v0[1]); w.y = pkbf(v0[2], v0[3]); w.z = pkbf(v1[0], v1[1]); w.w = pkbf(v1[2], v1[3]);
                    *(u32x4*)(rowp + bj * HALF) = w;
                    if (fo) { *(f32x4*)(fo + bj * HALF) = v0; *(f32x4*)(fo + bj * HALF + 4) = v1; } } }
    }
};

struct SplitOrder {
    static constexpr bool PARTS = true;
    int G, c, S, nkt_full;
    __device__ __forceinline__ void init(int K, int S_, int G_, int c_) { G = G_; c = c_; S = S_; nkt_full = K / BK; }
    __device__ __forceinline__ bool next(int i, Unit& u) const {
        const int rot = (G == 256) ? (((c & 7) * nkt_full) >> 3) & ~1 : 0, two = rot > 0 ? 1 : 0;
        const int io = (i == 0) ? 0 : i - two;
        const int L = io * G + c;
        if (L >= 256 + 32 * S) return false;
        const bool pr = L < 256;
        const int wgid = (L & 7) * 32 + ((L >> 3) & 31);
        const int sl = L - 256, tile = sl & 31, s = sl >> 5;
        const int base = (nkt_full / (2 * S)) * 2, rem = (nkt_full - base * S) / 2;
        u.pm = pr ? ((wgid >> 6) * 8 + (wgid & 7)) : 32 + (tile >> 3);
        u.pn = pr ? ((wgid & 63) >> 3) : (tile & 7);
        const bool first = two && i == 0, second = two && i == 1;
        u.kt0 = pr ? (first ? rot : 0) : s * base + 2 * (s < rem ? s : rem);
        u.nkt = pr ? (first ? nkt_full - rot : (second ? rot : nkt_full)) : base + (s < rem ? 2 : 0);
        u.aux = pr ? (first ? -2 : -1) : s;
        return true;
    }
    __device__ __forceinline__ void a_ready(const Unit&) const {}
    __device__ __forceinline__ void done(const Unit&) const {}
};
constexpr size_t SLAB_ELEMS = (size_t)1024 * 2048 + 2560;
template <class Full> struct EpiSplit {
    static constexpr bool PERM = Full::PERM, AFTER_DRAIN = false, HAS_MID = false;
    Full full; bf16_t* slab;
    __device__ __forceinline__ void operator()(const f32x4 (&acc)[2][2][4][2], const Unit& u, int wr, int wc, int fr, int fq) const {
        if (u.aux < 0) { full(acc, u, wr, wc, fr, fq); return; }
        bf16_t* P = slab + (size_t)u.aux * SLAB_ELEMS;
        const int row0 = (u.pm - 32) * BM + wr * 64 + fr, col0 = u.pn * BM + wc * 32 + (PERM ? 8 * fq : 4 * fq);
#pragma unroll
        for (int ai = 0; ai < 2; ++ai)
#pragma unroll
            for (int m = 0; m < 4; ++m) { bf16_t* rowp = P + (size_t)(row0 + ai * HALF + m * 16) * 2048 + col0;
#pragma unroll
                for (int bj = 0; bj < 2; ++bj) {
                    if (PERM) { const f32x4 v0 = acc[ai][bj][m][0], v1 = acc[ai][bj][m][1]; u32x4 w; w.x = pkbf(v0[0], v0[1]); w.y = pkbf(v0[2], v0[3]); w.z = pkbf(v1[0], v1[1]); w.w = pkbf(v1[2], v1[3]); *(u32x4*)(rowp + bj * HALF) = w; }
                    else {
#pragma unroll
                        for (int n = 0; n < 2; ++n) { const f32x4 v = acc[ai][bj][m][n]; u32x2 w; w.x = pkbf(v[0], v[1]); w.y = pkbf(v[2], v[3]); *(u32x2*)(rowp + bj * HALF + 16 * n) = w; } } } }
    }
};
struct UpOrder {
    static constexpr bool PARTS = false;
    StaticOrder P; int G, c;
    __device__ __forceinline__ void init(int G_, int c_) { P.init(8192, 11264, 2048, G_, c_); G = G_; c = c_; }
    __device__ __forceinline__ bool next(int i, Unit& u) const {
        const int L = i * G + c;
        if (L >= 1536 + 192) return false;
        Unit up; const bool inP = P.next(i, up);
        const int x = L - 1408, sl = L - 1536, tile = sl % 48, s = sl / 48;
        const bool smp = !inP && L < 1536;
        u.pm = inP ? up.pm : (smp ? 32 + (x & 3) : 32 + (tile & 3));
        u.pn = inP ? up.pn : (smp ? (x >> 2) : 32 + (tile >> 2));
        u.kt0 = (inP || smp) ? 0 : 8 * s; u.nkt = (inP || smp) ? 32 : 8; u.aux = (inP || smp) ? -1 : s;
        return true;
    }
    __device__ __forceinline__ void a_ready(const Unit&) const {}
    __device__ __forceinline__ void done(const Unit&) const {}
};
constexpr size_t UPSLAB_ELEMS = (size_t)1024 * 3072 + 2560;
struct EpiUpSplit {
    static constexpr bool PERM = true, AFTER_DRAIN = false, HAS_MID = false;
    EpiUp full; bf16_t* slab;
    __device__ __forceinline__ void operator()(const f32x4 (&acc)[2][2][4][2], const Unit& u, int wr, int wc, int fr, int fq) const {
        if (u.aux < 0) { full(acc, u, wr, wc, fr, fq); return; }
        bf16_t* P = slab + (size_t)u.aux * UPSLAB_ELEMS;
        const int row0 = (u.pm - 32) * BM + wr * 64 + fr, col0 = (u.pn - 32) * BM + wc * 32 + 8 * fq;
#pragma unroll
        for (int ai = 0; ai < 2; ++ai)
#pragma unroll
            for (int m = 0; m < 4; ++m) { bf16_t* rowp = P + (size_t)(row0 + ai * HALF + m * 16) * 3072 + col0;
#pragma unroll
                for (int bj = 0; bj < 2; ++bj) { const f32x4 v0 = acc[ai][bj][m][0], v1 = acc[ai][bj][m][1]; u32x4 w; w.x = pkbf(v0[0], v0[1]); w.y = pkbf(v0[2], v0[3]); w.z = pkbf(v1[0], v1[1]); w.w = pkbf(v1[2], v1[3]); *(u32x4*)(rowp + bj * HALF) = w; } }
    }
};
template <class Epi, class Sched, bool ALIGN_EPI = false, bool SP2 = false>
__device__ __forceinline__ void gemm_phase(PG8_LAS unsigned char* lds, const Gemm g, const Sched& S, const Epi& E, const int wv0) {
    int tid_ = wv0 * 64 + hw_lane(); asm volatile("" : "+v"(tid_));
    const int tid = tid_, wid = __builtin_amdgcn_readfirstlane(tid >> 6), lane = tid & 63, wr = wid >> 2, wc = wid & 3, fr = lane & 15, fq = lane >> 4;
    const int K = g.K;
    unsigned voffA[2], voffB[2];
#pragma unroll
    for (int i = 0; i < 2; ++i) { int R, C; stage_rc(tid * 16 + i * 8192, R, C); const int Rb = Epi::PERM ? ((R & ~31) + perm32(R & 31)) : R;
        voffA[i] = (unsigned)(R * K + C) * 2u; voffB[i] = (unsigned)(Rb * K + C) * 2u; }
    const size_t kstep = (size_t)(BK * 2);
    const size_t hstep = (size_t)HALF * K * 2;
    const size_t tstep = 2 * hstep;
    const unsigned ldsw = (unsigned)wid * 1024u;
    const int aoff = lds_byte(wr * 64 + fr, fq * 8), boff = lds_byte(wc * 32 + fr, fq * 8);
#define PG8_SA(b, h) (((b) * 2 + (h)) * HTB)
#define PG8_SB(b, h) ((4 + (b) * 2 + (h)) * HTB)
#define PG8_STAGE(bufoff, gbase, voff) do { _Pragma("unroll") for (int _i = 0; _i < 2; ++_i) \
        __builtin_amdgcn_global_load_lds((const unsigned*)((const char*)(gbase) + (voff)[_i]), (PG8_LAS unsigned*)(lds + (bufoff) + ldsw + _i * 8192), 16, 0, 0); } while (0)
#define PG8_LDA(dst, b, h) do { _Pragma("unroll") for (int m = 0; m < 4; ++m) _Pragma("unroll") for (int k = 0; k < 2; ++k) dst[m][k] = *(const PG8_LAS bf16x8*)(lds + PG8_SA(b, h) + aoff + m * 2048 + k * 1024); } while (0)
#define PG8_LDB(dst, b, h) do { _Pragma("unroll") for (int n = 0; n < 2; ++n) _Pragma("unroll") for (int k = 0; k < 2; ++k) dst[n][k] = *(const PG8_LAS bf16x8*)(lds + PG8_SB(b, h) + boff + n * 2048 + k * 1024); } while (0)
#define PG8_MMA(ai, bj, At, Bt) do { __builtin_amdgcn_s_setprio(1); _Pragma("unroll") for (int m = 0; m < 4; ++m) _Pragma("unroll") for (int n = 0; n < 2; ++n) _Pragma("unroll") for (int k = 0; k < 2; ++k) \
        acc[ai][bj][m][n] = __builtin_amdgcn_mfma_f32_16x16x32_bf16(Bt[n][k], At[m][k], acc[ai][bj][m][n], 0, 0, 0); __builtin_amdgcn_s_setprio(0); } while (0)
#define PG8_WAIT_V(n) asm volatile("s_waitcnt vmcnt(" #n ")" ::: "memory")
#define PG8_WAIT_L(n) asm volatile("s_waitcnt lgkmcnt(" #n ")" ::: "memory")
#define PG8_BAR __builtin_amdgcn_s_barrier()
#define PG8_SCHED __builtin_amdgcn_sched_barrier(0)
    Unit cur, nxt; int ui = 0;
    if (!S.next(0, cur)) return;
    f32x4 acc[2][2][4][2];
#pragma unroll
    for (int a = 0; a < 2; ++a)
#pragma unroll
        for (int b = 0; b < 2; ++b)
#pragma unroll
            for (int m = 0; m < 4; ++m)
#pragma unroll
                for (int n = 0; n < 2; ++n) acc[a][b][m][n] = (f32x4){0.f, 0.f, 0.f, 0.f};
    bf16x8 At[4][2], B0[2][2], B1[2][2];
    const char* cA = (const char*)g.A + (size_t)cur.pm * tstep + (size_t)cur.kt0 * kstep; const char* cB = (const char*)g.Bt + (size_t)cur.pn * tstep + (size_t)cur.kt0 * kstep;
    S.a_ready(cur);
    if constexpr (SP2) {
        PG8_STAGE(PG8_SB(0, 0), cB, voffB); PG8_STAGE(PG8_SB(0, 1), cB + hstep, voffB); PG8_STAGE(PG8_SA(0, 0), cA, voffA); PG8_STAGE(PG8_SA(0, 1), cA + hstep, voffA);
        if (wr == 1) PG8_BAR;
        PG8_WAIT_V(2); PG8_BAR;
        PG8_STAGE(PG8_SB(1, 0), cB + kstep, voffB); PG8_STAGE(PG8_SA(1, 0), cA + kstep, voffA); PG8_STAGE(PG8_SB(1, 1), cB + hstep + kstep, voffB);
        PG8_WAIT_V(6); PG8_BAR;
    } else {
        PG8_STAGE(PG8_SB(0, 0), cB, voffB); PG8_STAGE(PG8_SA(0, 0), cA, voffA); PG8_STAGE(PG8_SB(0, 1), cB + hstep, voffB); PG8_STAGE(PG8_SA(0, 1), cA + hstep, voffA);
        if (wr == 1) PG8_BAR;
        PG8_WAIT_V(4); PG8_BAR;
        PG8_STAGE(PG8_SB(1, 0), cB + kstep, voffB); PG8_STAGE(PG8_SA(1, 0), cA + kstep, voffA); PG8_STAGE(PG8_SB(1, 1), cB + hstep + kstep, voffB);
        PG8_WAIT_V(6); PG8_BAR;
    }
    for (;;) {
        const bool has_next = S.next(ui + 1, nxt);
        const char* nA = has_next ? (const char*)g.A + (size_t)nxt.pm * tstep + (size_t)nxt.kt0 * kstep : cA; const char* nB = has_next ? (const char*)g.Bt + (size_t)nxt.pn * tstep + (size_t)nxt.kt0 * kstep : cB;
        const int nt = cur.nkt;
        for (int t = 0; t < nt; t += 2) {
            if constexpr (Epi::HAS_MID) { if (t == E.tmid) E.mid(acc, cur, wr, wc, fr, fq); }
            const bool last = (t == nt - 2);
            const char* a1 = cA + (size_t)(t + 1) * kstep;
            const char* a2 = last ? nA : cA + (size_t)(t + 2) * kstep; const char* b2 = last ? nB : cB + (size_t)(t + 2) * kstep;
            const char* a3 = a2 + kstep; const char* b3 = b2 + kstep;
            if (last && has_next) S.a_ready(nxt);
            if constexpr (SP2) {
            PG8_LDB(B0, 0, 0); PG8_LDB(B1, 0, 1); PG8_SCHED; PG8_LDA(At, 0, 0); PG8_STAGE(PG8_SA(1, 1), a1 + hstep, voffA);
            PG8_WAIT_V(8); PG8_WAIT_L(0); PG8_BAR; PG8_MMA(0, 0, At, B0); PG8_MMA(0, 1, At, B1); PG8_BAR; PG8_SCHED;
            PG8_LDA(At, 0, 1); PG8_STAGE(PG8_SB(0, 0), b2, voffB); PG8_STAGE(PG8_SB(0, 1), b2 + hstep, voffB); PG8_STAGE(PG8_SA(0, 0), a2, voffA);
            PG8_WAIT_V(8); PG8_WAIT_L(0); PG8_BAR; PG8_MMA(1, 0, At, B0); PG8_MMA(1, 1, At, B1); PG8_BAR; PG8_SCHED;
            PG8_LDB(B0, 1, 0); PG8_LDB(B1, 1, 1); PG8_SCHED; PG8_LDA(At, 1, 0); PG8_STAGE(PG8_SA(0, 1), a2 + hstep, voffA);
            PG8_WAIT_V(8); PG8_WAIT_L(0); PG8_BAR; PG8_MMA(0, 0, At, B0); PG8_MMA(0, 1, At, B1); PG8_BAR; PG8_SCHED;
            PG8_LDA(At, 1, 1); PG8_STAGE(PG8_SB(1, 0), b3, voffB); PG8_STAGE(PG8_SB(1, 1), b3 + hstep, voffB); PG8_STAGE(PG8_SA(1, 0), a3, voffA);
            PG8_WAIT_V(8); PG8_WAIT_L(0); PG8_BAR; PG8_MMA(1, 0, At, B0); PG8_MMA(1, 1, At, B1); PG8_BAR; PG8_SCHED;
            } else {
            PG8_LDB(B0, 0, 0); PG8_SCHED; PG8_LDA(At, 0, 0); PG8_STAGE(PG8_SA(1, 1), a1 + hstep, voffA);
            PG8_WAIT_L(8); PG8_BAR; PG8_WAIT_L(0); PG8_MMA(0, 0, At, B0); PG8_BAR; PG8_SCHED;
            PG8_LDB(B1, 0, 1); PG8_STAGE(PG8_SB(0, 0), b2, voffB);
            PG8_BAR; PG8_WAIT_L(0); PG8_MMA(0, 1, At, B1); PG8_BAR;
            PG8_LDA(At, 0, 1); PG8_STAGE(PG8_SA(0, 0), a2, voffA);
            PG8_BAR; PG8_WAIT_L(0); PG8_MMA(1, 0, At, B0); PG8_BAR; PG8_SCHED;
            PG8_STAGE(PG8_SB(0, 1), b2 + hstep, voffB);
            PG8_WAIT_V(6); PG8_BAR; PG8_MMA(1, 1, At, B1); PG8_BAR;
            PG8_LDB(B0, 1, 0); PG8_SCHED; PG8_LDA(At, 1, 0); PG8_STAGE(PG8_SA(0, 1), a2 + hstep, voffA);
            PG8_WAIT_L(8); PG8_BAR; PG8_WAIT_L(0); PG8_MMA(0, 0, At, B0); PG8_BAR; PG8_SCHED;
            PG8_LDB(B1, 1, 1); PG8_STAGE(PG8_SB(1, 0), b3, voffB);
            PG8_BAR; PG8_WAIT_L(0); PG8_MMA(0, 1, At, B1); PG8_BAR;
            PG8_LDA(At, 1, 1); PG8_STAGE(PG8_SA(1, 0), a3, voffA);
            PG8_BAR; PG8_WAIT_L(0); PG8_MMA(1, 0, At, B0); PG8_BAR; PG8_SCHED;
            PG8_STAGE(PG8_SB(1, 1), b3 + hstep, voffB);
            PG8_WAIT_V(6); PG8_BAR; PG8_MMA(1, 1, At, B1); PG8_BAR;
            }
        }
        const bool part = Sched::PARTS && cur.aux == -2;
        if (!part) {
        if constexpr (ALIGN_EPI) { if (wr == 0) PG8_BAR; }
        if constexpr (!Epi::AFTER_DRAIN) { E(acc, cur, wr, wc, fr, fq); S.done(cur); }
        }
        if (!has_next) break;
        if (!part) {
#pragma unroll
        for (int a = 0; a < 2; ++a)
#pragma unroll
            for (int b = 0; b < 2; ++b)
#pragma unroll
                for (int m = 0; m < 4; ++m)
#pragma unroll
                    for (int n = 0; n < 2; ++n) acc[a][b][m][n] = (f32x4){0.f, 0.f, 0.f, 0.f};
        }
        cur = nxt; cA = nA; cB = nB; ++ui;
        if (!part) {
        if constexpr (ALIGN_EPI) { if (wr == 1) PG8_BAR; }
        }
    }
    PG8_WAIT_V(0);
    if constexpr (!ALIGN_EPI) { if (wr == 0) PG8_BAR; }
    PG8_BAR;
    if constexpr (Epi::AFTER_DRAIN) { E.fused(acc, cur, wr, wc, fr, fq, lds, wid, lane); S.done(cur); }
#undef PG8_SA
#undef PG8_SB
#undef PG8_STAGE
#undef PG8_LDA
#undef PG8_LDB
#undef PG8_MMA
#undef PG8_WAIT_V
#undef PG8_WAIT_L
#undef PG8_BAR
#undef PG8_SCHED
}
}
#define GAS __attribute__((address_space(1)))
#define LAS __attribute__((address_space(3)))
typedef unsigned short bf16;
typedef unsigned v4u __attribute__((ext_vector_type(4)));
typedef float f32x4 __attribute__((ext_vector_type(4)));
typedef short bf16x8 __attribute__((ext_vector_type(8)));
typedef GAS unsigned gu32;
typedef GAS unsigned long long gu64;
#define RLX_AGENT __ATOMIC_RELAXED, __HIP_MEMORY_SCOPE_AGENT
#define LDS_WAIT() asm volatile("s_waitcnt lgkmcnt(0)" ::: "memory")
#define VM_WAIT() asm volatile("s_waitcnt vmcnt(0)" ::: "memory")
__device__ __forceinline__ unsigned long long rt() { return __builtin_amdgcn_s_memrealtime(); }
__device__ __forceinline__ unsigned f2bf(float f) { unsigned u = __builtin_bit_cast(unsigned, f); return (u + 0x7fffu + ((u >> 16) & 1u)) >> 16; }
__device__ __forceinline__ unsigned pk2(float lo, float hi) { return f2bf(lo) | (f2bf(hi) << 16); }

#define XB_TMO      128
#define XB_XCNT(j)  (256  + 64 * (j))
#define XB_XSUB(j)  (1280 + 64 * (j))
#define XB_XGEN(j)  (2304 + 64 * (j))
#define XB_TOP      3328
#define XB_TOPGEN   3392
#define XCD_BAR_WORDS 3456
#define XB_SPIN_CAP (1u << 18)

__device__ __forceinline__ unsigned xb_ld(unsigned* p)              { return __hip_atomic_load(p, __ATOMIC_RELAXED, __HIP_MEMORY_SCOPE_AGENT); }
__device__ __forceinline__ unsigned xb_add(unsigned* p, unsigned v) { return __hip_atomic_fetch_add(p, v, __ATOMIC_RELAXED, __HIP_MEMORY_SCOPE_AGENT); }
__device__ __forceinline__ unsigned xb_xcc_id() { return (unsigned)__builtin_amdgcn_s_getreg((3 << 11) | 20) & 0xFu; }
#define XB_SPIN(cond, bar) do { unsigned _sp = 0; while (cond) { __builtin_amdgcn_s_sleep(1); \
    if ((++_sp & 255u) == 0u) { if (xb_ld(&(bar)[XB_TMO])) break; if (_sp > XB_SPIN_CAP) { atomicAdd(&(bar)[XB_TMO], 1u); break; } } } } while (0)

struct XcdBarrier {
    unsigned* bar; unsigned x; unsigned w0;
    volatile LAS unsigned* st;
};

__device__ __forceinline__ XcdBarrier xcd_barrier_post(unsigned* bar, volatile LAS unsigned* st, int wv0) {
    XcdBarrier b; b.bar = bar; b.x = xb_xcc_id(); b.st = st; b.w0 = (unsigned)wv0;
    if (wv0 == 0 && hw_lane() == 0) (void)xb_add(&bar[XB_XCNT(b.x)], 1u);
    return b;
}
__device__ __forceinline__ void xcd_barrier_complete(unsigned* bar, unsigned x, unsigned& nloc, unsigned& nx) {
    const unsigned G = gridDim.x * gridDim.y * gridDim.z;
    unsigned sum, cnt, mine, sp = 0u;
    for (;;) {
        sum = 0u; cnt = 0u; mine = 0u;
#pragma unroll
        for (unsigned j = 0; j < 16; ++j) { const unsigned c = xb_ld(&bar[XB_XCNT(j)]); sum += c; cnt |= (c > 0u) ? (1u << j) : 0u; mine = (j == x) ? c : mine; }
        if (sum == G) break;
        __builtin_amdgcn_s_sleep(1);
        if ((++sp & 255u) == 0u) { if (xb_ld(&bar[XB_TMO])) break; if (sp > XB_SPIN_CAP) { atomicAdd(&bar[XB_TMO], 1u); break; } }
    }
    nloc = mine > 0u ? mine : 1u; nx = cnt | (1u << x);
}

__device__ __forceinline__ void xcd_barrier(const XcdBarrier& b) {
    asm volatile("s_waitcnt vmcnt(0)" ::: "memory");
    __syncthreads();
    if (b.w0 == 0u) {
        unsigned* bar = b.bar; const int ln = hw_lane();
        unsigned gen = 0u, mask = 0u;
        if (ln == 0) {
            __builtin_amdgcn_s_waitcnt(0);
            unsigned nloc = b.st[0], nx = b.st[1];
            if (nloc == 0u) { xcd_barrier_complete(bar, b.x, nloc, nx); b.st[0] = nloc; b.st[1] = nx; }
            const unsigned old = xb_add(&bar[XB_XSUB(b.x)], 1u);
            gen = old / nloc; mask = nx;
            if (old + 1u == (gen + 1u) * nloc) {
                __builtin_amdgcn_fence(__ATOMIC_RELEASE, "agent");
                asm volatile("s_waitcnt vmcnt(0)" ::: "memory");
                xb_add(&bar[XB_XGEN(b.x)], 1u);
            }
        }
        gen = (unsigned)__builtin_amdgcn_readfirstlane((int)gen); mask = (unsigned)__builtin_amdgcn_readfirstlane((int)mask);
        { const bool mine = ln < 16 && ((mask >> ln) & 1u); unsigned sp = 0u;
          for (;;) {
              bool ok = true; if (mine) ok = xb_ld(&bar[XB_XGEN(ln)]) > gen;
              if (__builtin_amdgcn_ballot_w64(!ok) == 0ull) break;
              __builtin_amdgcn_s_sleep(1);
              if ((++sp & 255u) == 0u) { if (xb_ld(&bar[XB_TMO])) break; if (sp > XB_SPIN_CAP) { if (ln == 0) atomicAdd(&bar[XB_TMO], 1u); break; } } } }
        __builtin_amdgcn_fence(__ATOMIC_ACQUIRE, "agent");
        asm volatile("s_waitcnt vmcnt(0)" ::: "memory");
    }
    __syncthreads();
}

constexpr int NWAVES = 8;
constexpr int DM = 2048, MP = 8192, MS = 1024, MT = MP + MS;
constexpr int NIN = 14336, DFF = 5632, NUP = 2 * DFF, NCOND = 132, MODP = 24576;
constexpr int ZU = 0, ZV = 1024, ZQ = 2048, ZF = 4096, ZI = 6144, ZOG = 8192, ZGA = 10240, ZGB = 12288;
constexpr float EPS = 1e-6f, L2E = 1.44269504089f;
constexpr size_t O_YP = 0, O_YS = 16777216, O_HP = 18874368, O_HS = 20971520, O_CP = 88080384, O_CS = 88260608, O_VP = 94027776, O_VS = 95076352, O_END = 97173504;
constexpr size_t MiB = 1u << 20;
constexpr size_t WS_CTL = 0, CTL_ZERO_BYTES = 1 * MiB;
constexpr size_t WS_AC = 1 * MiB;
constexpr size_t WS_MOD = 2 * MiB;
constexpr size_t WS_ADAT = 26 * MiB;
constexpr size_t WS_WIN = 122 * MiB, SZ_WIN = 56 * MiB;
constexpr size_t WS_WBA = 234 * MiB, SZ_WBA = 4 * MiB;
constexpr size_t WS_WBB = 242 * MiB, SZ_WBB = 8 * MiB;
constexpr size_t WS_WOUT = 258 * MiB, SZ_WOUT = 8 * MiB;
constexpr size_t WS_WUP = 274 * MiB, SZ_WUP = 44 * MiB;
constexpr size_t WS_WDN = 362 * MiB, SZ_WDN = 22 * MiB;
constexpr size_t WS_X = 406 * MiB;
constexpr size_t WS_H = 478 * MiB;
constexpr size_t WS_Z = 514 * MiB;
constexpr size_t WS_YA = 766 * MiB;
constexpr size_t WS_O = 784 * MiB;
constexpr size_t WS_Y = 820 * MiB;
constexpr size_t WS_ACT = 856 * MiB;
constexpr size_t WS_SLAB = 955 * MiB;
constexpr size_t WS_END = 1051 * MiB;
constexpr int CW_BAR = 4096;
constexpr int RING_OFF = 0, RING_BYTES = 131072;
constexpr int LDSCTL_OFF = RING_BYTES, MISC_OFF = LDSCTL_OFF + 320;
constexpr int LDS_BYTES = 147456;

#define DI __device__ __forceinline__
typedef unsigned v2u __attribute__((ext_vector_type(2)));
using pg8::pkbf; using pg8::bflo; using pg8::bfhi; using pg8::sigm; using pg8::gelu_t;
DI float fexp2(float x) { return __builtin_amdgcn_exp2f(x); }
DI float flog2(float x) { return __builtin_amdgcn_logf(x); }
DI float frcp(float x) { return __builtin_amdgcn_rcpf(x); }
DI float frsq(float x) { return __builtin_amdgcn_rsqf(x); }
DI float lane_get(float x, int src_lane) { return __builtin_bit_cast(float, __builtin_amdgcn_ds_bpermute(src_lane << 2, __builtin_bit_cast(int, x))); }
DI float wave_sum(float v, int lane) {
#pragma unroll
    for (int o = 1; o < 64; o <<= 1) v += lane_get(v, lane ^ o);
    return v;
}
#define LDS_BARRIER() do { asm volatile("s_waitcnt lgkmcnt(0)" ::: "memory"); __builtin_amdgcn_s_barrier(); asm volatile("" ::: "memory"); } while (0)
#define MFMA16(a, b, c) __builtin_amdgcn_mfma_f32_16x16x32_bf16((a), (b), (c), 0, 0, 0)

struct Args { const float* in[24]; float* out; unsigned char* ws; };
DI const float* inp(const Args& a, int k) { asm volatile("" : "+s"(k)); return (const float*)(const GAS float*)a.in[k]; }
enum { I_XP = 0, I_XS, I_CP, I_CS, I_SH, I_SC, I_ADAW, I_ADAB, I_N1, I_N2, I_WIN, I_VG, I_WS, I_BS, I_WBA, I_LB, I_HNG, I_WBB, I_WOUT, I_WUP, I_CW, I_CB, I_WDN, I_FNG };

struct P0It { const float* W; int N; bf16* WT; int pitch; int item; };
DI void p0_item_load(const P0It& d, int lane, float (&v)[32]) {
    const int nblk = d.N / 32, kb = d.item / nblk, nb = d.item % nblk, k0 = 64 * kb, n0 = 32 * nb;
#pragma unroll
    for (int i = 0; i < 32; ++i) { const int kk = 2 * i + (lane >> 5); v[i] = __builtin_nontemporal_load(d.W + (size_t)(k0 + kk) * d.N + n0 + (lane & 31)); }
}
DI void p0_item_store(const P0It& d, LAS float* scr, int lane, const float (&v)[32]) {
    const int nblk = d.N / 32, kb = d.item / nblk, nb = d.item % nblk, k0 = 64 * kb, n0 = 32 * nb;
#pragma unroll
    for (int i = 0; i < 32; ++i) { const int kk = 2 * i + (lane >> 5); scr[kk * 33 + (lane & 31)] = v[i]; }
    LDS_WAIT(); asm volatile("" ::: "memory");
    const int c = lane & 7;
#pragma unroll
    for (int j = 0; j < 4; ++j) { const int n = (lane >> 3) + 8 * j; const LAS float* sp = scr + (8 * c) * 33 + n;
        v4u o; o.x = pkbf(sp[0 * 33], sp[1 * 33]); o.y = pkbf(sp[2 * 33], sp[3 * 33]); o.z = pkbf(sp[4 * 33], sp[5 * 33]); o.w = pkbf(sp[6 * 33], sp[7 * 33]);
        *(GAS v4u*)(d.WT + (size_t)(n0 + n) * d.pitch + k0 + 8 * c) = o; }
    LDS_WAIT(); asm volatile("" ::: "memory");
}

template <bool FINAL>
DI void norm_rows(const void* xp, const void* xs, bool pbf, bool sbf  , const float* g, const float* modsh  , bf16* H, float* out, int gw, int NGW, int lane,
                  const bf16* slab  , const float* gate  , bf16* xs_out  , LAS unsigned char* lds) {
    asm volatile("" : "+v"(lane), "+s"(gw));
    const bool bal = (slab != nullptr) && (NGW == 2048);
    int srow = -1, r0, r1;
    if (bal) { if (gw < 1024) { srow = MP + gw; r0 = 2 * gw; r1 = r0 + 2; } else { r0 = 2048 + 6 * (gw - 1024); r1 = r0 + 6; } }
    else { unsigned n_ = (unsigned)NGW; asm volatile("" : "+s"(n_));
           r0 = (int)((unsigned)(gw * MT) / n_); r1 = (int)((unsigned)((gw + 1) * MT) / n_); }
    int cbc = -1; f32x4 wv[8], shv[8];
    auto params = [&](int row) {
        const int cb = row < MP ? (row >> 11) : 4 + ((row - MP) >> 3);
        if (cb == cbc) return;
        cbc = cb;
        if (FINAL) {
#pragma unroll
            for (int j = 0; j < 8; ++j) wv[j] = ((const GAS f32x4*)g)[lane + 64 * j];
        } else {
            const GAS f32x4* sh = (const GAS f32x4*)(modsh + (size_t)cb * MODP) + lane; const GAS f32x4* sc = sh + DM / 4;
#pragma unroll
            for (int j = 0; j < 8; ++j) { wv[j] = ((const GAS f32x4*)g)[lane + 64 * j] * (sc[64 * j] + 1.f); shv[j] = sh[64 * j]; }
        } };
    auto ldrow = [&](int row, f32x4 (&v)[8]) {
        const bool isb = row < MP ? pbf : sbf; const size_t roff = row < MP ? (size_t)row * DM : (size_t)(row - MP) * DM; const void* rbase = row < MP ? xp : xs;
        if (isb) { const GAS v2u* xr = (const GAS v2u*)((const bf16*)rbase + roff) + lane; v2u w[8];
#pragma unroll
            for (int j = 0; j < 8; ++j) w[j] = xr[64 * j];
#pragma unroll
            for (int j = 0; j < 8; ++j) v[j] = (f32x4){bflo(w[j].x), bfhi(w[j].x), bflo(w[j].y), bfhi(w[j].y)}; }
        else { const GAS f32x4* xr = (const GAS f32x4*)((const float*)rbase + roff) + lane;
#pragma unroll
            for (int j = 0; j < 8; ++j) v[j] = xr[64 * j]; } };
    auto fold = [&](int row, f32x4 (&v)[8], bool lgate = false) {
        const int cbs = 4 + ((row - MP) >> 3);
        const GAS f32x4* gp = (const GAS f32x4*)(gate + (size_t)cbs * MODP) + lane; const GAS v2u* sp = (const GAS v2u*)(slab + (size_t)(row - MP) * DM) + lane;
        f32x4 a[8], gq[8];
#pragma unroll
        for (int j = 0; j < 8; ++j) { a[j] = (f32x4){0.f, 0.f, 0.f, 0.f}; if (!lgate) gq[j] = gp[64 * j]; }
#pragma unroll 1
        for (int sh = 0; sh < 2; ++sh) {
#pragma unroll
            for (int j = 0; j < 8; ++j)
#pragma unroll
                for (int s = 0; s < 4; ++s) { const v2u w = sp[(size_t)(4 * sh + s) * (pg8::SLAB_ELEMS / 4) + 64 * j]; a[j] += (f32x4){bflo(w.x), bfhi(w.x), bflo(w.y), bfhi(w.y)}; } }
        if (lgate) {
#pragma unroll
            for (int j = 0; j < 8; ++j) gq[j] = *(const LAS f32x4*)(lds + (lane + 64 * j) * 16); }
#pragma unroll
        for (int j = 0; j < 8; ++j) v[j] += gq[j] * a[j];
        if (xs_out) { GAS v2u* xo = (GAS v2u*)(xs_out + (size_t)(row - MP) * DM) + lane;
#pragma unroll
            for (int j = 0; j < 8; ++j) { v2u w; w.x = pkbf(v[j].x, v[j].y); w.y = pkbf(v[j].z, v[j].w); xo[64 * j] = w; } } };
    auto finish = [&](int row, const f32x4 (&v)[8]) {
        float ss = 0.f;
#pragma unroll
        for (int j = 0; j < 8; ++j) ss += (v[j].x * v[j].x + v[j].y * v[j].y) + (v[j].z * v[j].z + v[j].w * v[j].w);
        const float rstd = frsq(wave_sum(ss, lane) * (1.f / DM) + EPS);
        if (FINAL) { GAS f32x4* o = (GAS f32x4*)(out + (size_t)row * DM) + lane;
#pragma unroll
            for (int j = 0; j < 8; ++j) o[64 * j] = v[j] * rstd * wv[j]; }
        else { GAS v2u* o = (GAS v2u*)(H + (size_t)row * DM) + lane;
#pragma unroll
            for (int j = 0; j < 8; ++j) { const f32x4 h = v[j] * rstd * wv[j] + shv[j]; v2u w; w.x = pkbf(h.x, h.y); w.y = pkbf(h.z, h.w); o[64 * j] = w; } } };
    if (srow >= 0) {
        const int cbs = 4 + ((srow - MP) >> 3); const int idx = (srow & 7) * 64 + lane;
        const f32x4 g4 = ((const GAS f32x4*)(gate + (size_t)cbs * MODP))[idx];
        f32x4 w4 = ((const GAS f32x4*)g)[idx], s4 = {0.f, 0.f, 0.f, 0.f};
        if (!FINAL) { const GAS f32x4* sh = (const GAS f32x4*)(modsh + (size_t)cbs * MODP); w4 = w4 * (sh[DM / 4 + idx] + 1.f); s4 = sh[idx]; }
        *(LAS f32x4*)(lds + idx * 16) = g4; *(LAS f32x4*)(lds + 8192 + idx * 16) = w4; *(LAS f32x4*)(lds + 16384 + idx * 16) = s4;
    }
    if (bal) { if (gw < 1024) LDS_BARRIER(); }
    if (srow >= 0) {
        v2u w2[2][8];
        const bool pre = pbf && (r1 - r0 == 2);
        if (pre) {
#pragma unroll
            for (int t = 0; t < 2; ++t) { const GAS v2u* xr = (const GAS v2u*)((const bf16*)xp + (size_t)(r0 + t) * DM) + lane;
#pragma unroll
                for (int j = 0; j < 8; ++j) w2[t][j] = xr[64 * j]; } }
        { f32x4 v[8]; ldrow(srow, v); fold(srow, v, true);
#pragma unroll
          for (int j = 0; j < 8; ++j) { wv[j] = *(const LAS f32x4*)(lds + 8192 + (lane + 64 * j) * 16); shv[j] = *(const LAS f32x4*)(lds + 16384 + (lane + 64 * j) * 16); }
          cbc = 4 + ((srow - MP) >> 3);
          finish(srow, v); }
        if (pre) { params(r0);
#pragma unroll
            for (int t = 0; t < 2; ++t) { f32x4 v[8];
#pragma unroll
                for (int j = 0; j < 8; ++j) v[j] = (f32x4){bflo(w2[t][j].x), bfhi(w2[t][j].x), bflo(w2[t][j].y), bfhi(w2[t][j].y)};
                finish(r0 + t, v); }
            r0 = r1; } }
    for (int row = r0; row < r1;) {
        asm volatile("" : "+v"(lane));
        const bool pair = (row + 1 < r1) && (row + 1 < MP) && ((row >> 11) == ((row + 1) >> 11));
        if (pair) { f32x4 v0[8], v1[8]; ldrow(row, v0); ldrow(row + 1, v1); params(row); finish(row, v0); finish(row + 1, v1); row += 2; }
        else { f32x4 v[8]; ldrow(row, v); if (slab && row >= MP) fold(row, v); params(row); finish(row, v); row += 1; }
    }
}

constexpr int HP = 272, HPK = 144;
constexpr int HG_QT = 0, HG_KT = 64 * HP, HG_IVT = 2 * 64 * HP, HG_EAR = HG_IVT + 128 * HPK, HG_PART = HG_EAR + 512, HG_BUF0 = HG_PART + 2048;
constexpr int HG_KDT = HG_BUF0, HG_P = HG_KDT + 128 * HPK, HG_DEC = HG_P + 64 * HPK, HG_BUFSZ = 128 * HPK + 64 * HPK + 512, HG_END = HG_BUF0 + 2 * HG_BUFSZ;
static_assert(HG_END <= RING_BYTES, "hgrn lds");
struct HgRegs { v2u qt[4], kt[4], kd[4], iv[4]; f32x4 dec, ear; };
DI void hg_load(const bf16* Z, int rowb, int h, int k0, int tg, bool valid, v2u (&qw)[4], v2u (&fw)[4], v2u (&iw)[4]) {
#pragma unroll
    for (int j = 0; j < 4; ++j) {
        if (valid) { const bf16* zr = Z + (size_t)(rowb + 4 * tg + j) * NIN + h * 128 + k0;
            qw[j] = *(const v2u*)(zr + ZQ); fw[j] = *(const v2u*)(zr + ZF); iw[j] = *(const v2u*)(zr + ZI); }
        else { qw[j] = (v2u){0u, 0u}; fw[j] = (v2u){0u, 0u}; iw[j] = (v2u){0u, 0u}; }
    }
}
template <int NG>
DI void hg_elem(const v2u (&qw)[4], const v2u (&fw)[4], const v2u (&iw)[4], const float (&lb)[4], const float (&oml)[4], bool valid, int lane, int tg, int kql, HgRegs& R) {
#pragma unroll
    for (int cp = 0; cp < 2; ++cp) {
        float lf[4][2], kk[4][2];
#pragma unroll
        for (int j = 0; j < 4; ++j) { const unsigned w = cp ? fw[j].y : fw[j].x;
#pragma unroll
            for (int c = 0; c < 2; ++c) { const float fr = c ? bfhi(w) : bflo(w);
                const float e = fexp2(fminf(-L2E * fr, 60.f)), r = frcp(1.f + e);
                const float f = (1.f + lb[2 * cp + c] * e) * r;
                kk[j][c] = valid ? oml[2 * cp + c] * e * r : 0.f;
                lf[j][c] = valid ? flog2(f) : 0.f; } }
#pragma unroll
        for (int j = 1; j < 4; ++j) { lf[j][0] += lf[j - 1][0]; lf[j][1] += lf[j - 1][1]; }
        float before[2], aref[2], e2[2];
#pragma unroll
        for (int c = 0; c < 2; ++c) { float x = lf[3][c];
#pragma unroll
            for (int d = 1; d < 16; d <<= 1) { const float y = lane_get(x, (lane - 4 * d) & 63); if (tg >= d) x += y; }
            before[c] = x - lf[3][c]; aref[c] = lane_get(x, 4 * (NG / 2 - 1) + kql); const float al = lane_get(x, 4 * (NG - 1) + kql);
            e2[c] = fexp2(al - aref[c]); R.dec[2 * cp + c] = fexp2(al); R.ear[2 * cp + c] = fexp2(aref[c]); }
        float kd[4][2];
#pragma unroll
        for (int j = 0; j < 4; ++j) { const unsigned w = cp ? qw[j].y : qw[j].x; float qt[2], kt[2];
#pragma unroll
            for (int c = 0; c < 2; ++c) { const float qv = c ? bfhi(w) : bflo(w);
                const float d = before[c] + lf[j][c] - aref[c];
                qt[c] = qv * fexp2(fminf(d, 100.f)); kt[c] = kk[j][c] * fexp2(fminf(-d, 100.f)); kd[j][c] = kt[c] * e2[c]; }
            if (cp) { R.qt[j].y = pkbf(qt[0], qt[1]); R.kt[j].y = pkbf(kt[0], kt[1]); } else { R.qt[j].x = pkbf(qt[0], qt[1]); R.kt[j].x = pkbf(kt[0], kt[1]); } }
#pragma unroll
        for (int c = 0; c < 2; ++c) { R.kd[2 * cp + c] = (v2u){pkbf(kd[0][c], kd[1][c]), pkbf(kd[2][c], kd[3][c])};
            unsigned e0, e1, e2b, e3;
            if (cp == 0) { if (c == 0) { e0 = iw[0].x & 0xffffu; e1 = iw[1].x & 0xffffu; e2b = iw[2].x & 0xffffu; e3 = iw[3].x & 0xffffu; } else { e0 = iw[0].x >> 16; e1 = iw[1].x >> 16; e2b = iw[2].x >> 16; e3 = iw[3].x >> 16; } }
            else { if (c == 0) { e0 = iw[0].y & 0xffffu; e1 = iw[1].y & 0xffffu; e2b = iw[2].y & 0xffffu; e3 = iw[3].y & 0xffffu; } else { e0 = iw[0].y >> 16; e1 = iw[1].y >> 16; e2b = iw[2].y >> 16; e3 = iw[3].y >> 16; } }
            R.iv[2 * cp + c] = (v2u){e0 | (e1 << 16), e2b | (e3 << 16)}; }
        __builtin_amdgcn_sched_barrier(0);
    }
}
template <int TT> DI void hg_final(LAS unsigned char* lds, int wave, int lane, const f32x4 (&o)[TT], const v2u (&ogw)[TT], const f32x4 og4, bf16* OB, int rowb, int h);
template <int TT, bool DEFER = false>
DI void hg_stage1(LAS unsigned char* lds, int wave, int lane, const HgRegs& R, f32x4 (&S)[8], f32x4 (&o)[TT], v2u (&ogw)[TT], const bf16* Z, int rowb, int h,
                  int pb = 0  , bool have_prev = false, const f32x4 og4 = (f32x4){0.f, 0.f, 0.f, 0.f}, bf16* OB = nullptr) {
    constexpr int CS = (TT == 4) ? 64 : 32, NG = CS / 4;
    const int bo = pb * HG_BUFSZ;
    const int kql = lane & 3, tg = lane >> 2, k0 = 16 * wave + 4 * kql, i = lane & 15, q = lane >> 4;
    if (tg < NG) {
#pragma unroll
        for (int j = 0; j < 4; ++j) { const int ro = (4 * tg + j) * HP + k0 * 2; *(LAS v2u*)(lds + HG_QT + ro) = R.qt[j]; *(LAS v2u*)(lds + HG_KT + ro) = R.kt[j]; }
#pragma unroll
        for (int c = 0; c < 4; ++c) { *(LAS v2u*)(lds + HG_KDT + bo + (k0 + c) * HPK + 8 * tg) = R.kd[c]; *(LAS v2u*)(lds + HG_IVT + (k0 + c) * HPK + 8 * tg) = R.iv[c]; }
        if (tg == 0) { *(LAS f32x4*)(lds + HG_DEC + bo + k0 * 4) = R.dec; *(LAS f32x4*)(lds + HG_EAR + k0 * 4) = R.ear; }
    }
    LDS_BARRIER();
    if (DEFER && have_prev) hg_final<TT>(lds, wave, lane, o, ogw, og4, OB, rowb - 16 * TT, h);
#pragma unroll
    for (int it = 0; it < TT; ++it) ogw[it] = (TT == 4 || i < 8) ? *(const v2u*)(Z + (size_t)(rowb + 16 * it + i) * NIN + ZOG + h * 128 + 16 * wave + 4 * q) : (v2u){0u, 0u};
    if (TT == 4 || wave == 0) {
        const int it = (TT == 4) ? (wave >> 1) : 0;
#pragma unroll
        for (int is2 = 0; is2 < 2; ++is2) { const int is = ((TT == 4) ? 2 * (wave & 1) : 0) + is2;
            f32x4 sc = {0.f, 0.f, 0.f, 0.f};
#pragma unroll
            for (int ks = 0; ks < 4; ++ks) { const bf16x8 X = *(const LAS bf16x8*)(lds + HG_KT + (16 * is + i) * HP + (32 * ks + 8 * q) * 2), Y = *(const LAS bf16x8*)(lds + HG_QT + (16 * it + i) * HP + (32 * ks + 8 * q) * 2);
                sc = MFMA16(X, Y, sc); }
            const int t = 16 * it + i, s0 = 16 * is + 4 * q;
            *(LAS v2u*)(lds + HG_P + bo + t * HPK + s0 * 2) = (v2u){pkbf(s0 <= t ? sc[0] : 0.f, s0 + 1 <= t ? sc[1] : 0.f), pkbf(s0 + 2 <= t ? sc[2] : 0.f, s0 + 3 <= t ? sc[3] : 0.f)};
        }
    }
    {
        bf16x8 Sf[4];
#pragma unroll
        for (int ks = 0; ks < 4; ++ks) { const f32x4 e0 = *(const LAS f32x4*)(lds + HG_EAR + (32 * ks + 4 * q) * 4), e1 = *(const LAS f32x4*)(lds + HG_EAR + (32 * ks + 16 + 4 * q) * 4);
            const f32x4 a0 = S[2 * ks] * e0, a1 = S[2 * ks + 1] * e1;
            v4u p; p.x = pkbf(a0[0], a0[1]); p.y = pkbf(a0[2], a0[3]); p.z = pkbf(a1[0], a1[1]); p.w = pkbf(a1[2], a1[3]); Sf[ks] = __builtin_bit_cast(bf16x8, p); }
#pragma unroll
        for (int it = 0; it < TT; ++it) { o[it] = (f32x4){0.f, 0.f, 0.f, 0.f};
#pragma unroll
            for (int ks = 0; ks < 4; ++ks) { const v2u lo = *(const LAS v2u*)(lds + HG_QT + (16 * it + i) * HP + (32 * ks + 4 * q) * 2), hi = *(const LAS v2u*)(lds + HG_QT + (16 * it + i) * HP + (32 * ks + 16 + 4 * q) * 2);
                const v4u y = {lo.x, lo.y, hi.x, hi.y}; o[it] = MFMA16(Sf[ks], __builtin_bit_cast(bf16x8, y), o[it]); } }
    }
    bf16x8 IVf[CS / 32];
#pragma unroll
    for (int ss = 0; ss < CS / 32; ++ss) IVf[ss] = *(const LAS bf16x8*)(lds + HG_IVT + (16 * wave + i) * HPK + (32 * ss + 8 * q) * 2);
    LDS_BARRIER();
#pragma unroll
    for (int it = 0; it < TT; ++it)
#pragma unroll
        for (int ss = 0; ss < CS / 32; ++ss) if (TT != 4 || ss <= (it >> 1)) { const bf16x8 Y = *(const LAS bf16x8*)(lds + HG_P + bo + (16 * it + i) * HPK + (32 * ss + 8 * q) * 2); o[it] = MFMA16(IVf[ss], Y, o[it]); }
#pragma unroll
    for (int a = 0; a < 8; ++a) { const f32x4 d = *(const LAS f32x4*)(lds + HG_DEC + bo + (16 * a + 4 * q) * 4); S[a] *= d;
#pragma unroll
        for (int ss = 0; ss < CS / 32; ++ss) { const bf16x8 X = *(const LAS bf16x8*)(lds + HG_KDT + bo + (16 * a + i) * HPK + (32 * ss + 8 * q) * 2); S[a] = MFMA16(X, IVf[ss], S[a]); } }
#pragma unroll
    for (int it = 0; it < TT; ++it) { float p = (o[it][0] * o[it][0] + o[it][1] * o[it][1]) + (o[it][2] * o[it][2] + o[it][3] * o[it][3]); p += lane_get(p, lane ^ 16); p += lane_get(p, lane ^ 32);
        if (q == 0) *(LAS float*)(lds + HG_PART + (wave * 64 + 16 * it + i) * 4) = p; }
}
template <int TT>
DI void hg_final(LAS unsigned char* lds, int wave, int lane, const f32x4 (&o)[TT], const v2u (&ogw)[TT], const f32x4 og4, bf16* OB, int rowb, int h) {
    const int i = lane & 15, q = lane >> 4;
#pragma unroll
    for (int it = 0; it < TT; ++it) { float tot = 0.f;
#pragma unroll
        for (int w = 0; w < 8; ++w) tot += *(const LAS float*)(lds + HG_PART + (w * 64 + 16 * it + i) * 4);
        const float rstd = frsq(tot * (1.f / 128.f) + EPS);
        if (TT == 4 || i < 8) { const v2u g = ogw[it];
            const float r0 = o[it][0] * rstd * og4[0] * bflo(g.x), r1 = o[it][1] * rstd * og4[1] * bfhi(g.x), r2 = o[it][2] * rstd * og4[2] * bflo(g.y), r3 = o[it][3] * rstd * og4[3] * bfhi(g.y);
            *(v2u*)(OB + (size_t)(rowb + 16 * it + i) * 2048 + h * 128 + 16 * wave + 4 * q) = (v2u){pkbf(r0, r1), pkbf(r2, r3)}; } }
}
template <int TT>
DI void hg_stage2(LAS unsigned char* lds, int wave, int lane, const f32x4 (&o)[TT], const v2u (&ogw)[TT], const f32x4 og4, bf16* OB, int rowb, int h) {
    LDS_BARRIER();
    hg_final<TT>(lds, wave, lane, o, ogw, og4, OB, rowb, h);
}
DI void hgrn_prompt_unit(LAS unsigned char* lds, int tid, int wave, int lane, const bf16* Z, bf16* OB, float* s_out,
                         const float* ogain  , const float* lbp  , int l, int h, int row0, int nblk) {
    asm volatile("" : "+v"(tid), "+v"(lane), "+s"(wave));
    const int kql = lane & 3, tg = lane >> 2, k0 = 16 * wave + 4 * kql, i = lane & 15, q = lane >> 4;
    float lb[4], oml[4];
#pragma unroll
    for (int c = 0; c < 4; ++c) { lb[c] = (l == 0) ? 0.f : sigm(lbp[2048 + h * 128 + k0 + c] - lbp[h * 128 + k0 + c]); oml[c] = 1.f - lb[c]; }
    f32x4 S[8];
#pragma unroll
    for (int a = 0; a < 8; ++a) S[a] = (f32x4){0.f, 0.f, 0.f, 0.f};
    const f32x4 og4 = *(const f32x4*)(ogain + 16 * wave + 4 * q);
    v2u qw[4], fw[4], iw[4]; HgRegs R;
    hg_load(Z, row0, h, k0, tg, true, qw, fw, iw);
    hg_elem<16>(qw, fw, iw, lb, oml, true, lane, tg, kql, R);
    if (nblk > 1) hg_load(Z, row0 + 64, h, k0, tg, true, qw, fw, iw);
    f32x4 o[4]; v2u ogw[4];
#pragma unroll
    for (int it = 0; it < 4; ++it) { o[it] = (f32x4){0.f, 0.f, 0.f, 0.f}; ogw[it] = (v2u){0u, 0u}; }
    for (int blk = 0; blk < nblk; ++blk) {
        const int rowb = row0 + blk * 64;
        hg_stage1<4, true>(lds, wave, lane, R, S, o, ogw, Z, rowb, h, blk & 1, blk > 0, og4, OB);
        if (blk + 1 < nblk) { hg_elem<16>(qw, fw, iw, lb, oml, true, lane, tg, kql, R);
            if (blk + 2 < nblk) hg_load(Z, rowb + 128, h, k0, tg, true, qw, fw, iw); }
    }
    hg_stage2<4>(lds, wave, lane, o, ogw, og4, OB, row0 + (nblk - 1) * 64, h);
    { float* sp = s_out + (size_t)(4 * q) * 128 + 16 * wave + i;
#pragma unroll
      for (int a = 0; a < 8; ++a) {
#pragma unroll
          for (int r = 0; r < 4; ++r) __builtin_nontemporal_store(S[a][r], sp + r * 128);
          sp += 16 * 128; } }
    LDS_BARRIER();
}
DI void hgrn_sample_loop(LAS unsigned char* lds, int tid, int wave, int lane, const bf16* Z, bf16* OB, const float* st_in  , float* st_out,
                         const float* hng  , const float* lbp, int l, int su0, int step) {
    asm volatile("" : "+v"(tid), "+v"(lane), "+s"(wave));
    if (su0 >= 2048) return;
    const int kql = lane & 3, tg = lane >> 2, k0 = 16 * wave + 4 * kql, i = lane & 15, q = lane >> 4;
    const bool valid = tg < 2;
    const size_t lo = (size_t)(16 * 0 + 4 * q) * 128 + 16 * wave + i;
    f32x4 A[8], B[8];
    v2u qw[4], fw[4], iw[4]; HgRegs R;
    auto ldstate = [&](f32x4 (&T)[8], int su) { const float* sp = st_in + (size_t)su * 16384 + lo;
#pragma unroll
        for (int a = 0; a < 8; ++a)
#pragma unroll
            for (int r = 0; r < 4; ++r) T[a][r] = __builtin_nontemporal_load(sp + (16 * a + r) * 128); };
    auto unit = [&](int su, f32x4 (&T)[8]) {
        const int h = su & 15, rowb = MP + (su >> 4) * 8, nsu = su + step, n2 = su + 2 * step;
        float lb[4], oml[4];
#pragma unroll
        for (int c = 0; c < 4; ++c) { lb[c] = (l == 0) ? 0.f : sigm(lbp[2048 + h * 128 + k0 + c] - lbp[h * 128 + k0 + c]); oml[c] = 1.f - lb[c]; }
        const f32x4 og4 = *(const f32x4*)(hng + h * 128 + 16 * wave + 4 * q);
        hg_elem<8>(qw, fw, iw, lb, oml, valid, lane, tg, kql, R);
        if (nsu < 2048) hg_load(Z, MP + (nsu >> 4) * 8, nsu & 15, k0, tg, valid, qw, fw, iw);
        f32x4 o[1]; v2u ogw[1];
        hg_stage1<1>(lds, wave, lane, R, T, o, ogw, Z, rowb, h);
        { float* sp = st_out + (size_t)su * 16384 + lo;
#pragma unroll
          for (int a = 0; a < 8; ++a)
#pragma unroll
              for (int r = 0; r < 4; ++r) __builtin_nontemporal_store(T[a][r], sp + (16 * a + r) * 128); }
        if (n2 < 2048) ldstate(T, n2);
        hg_stage2<1>(lds, wave, lane, o, ogw, og4, OB, rowb, h); };
    ldstate(A, su0);
    hg_load(Z, MP + (su0 >> 4) * 8, su0 & 15, k0, tg, valid, qw, fw, iw);
    if (su0 + step < 2048) ldstate(B, su0 + step);
    for (int su = su0; su < 2048; su += 2 * step) {
        unit(su, A);
        if (su + step < 2048) unit(su + step, B);
    }
    LDS_BARRIER();
}

constexpr int MX_VNT = 0, MX_W = 128 * HP, MX_END = 2 * 128 * HP;
static_assert(MX_END <= RING_BYTES, "mixer lds");
DI void mixer_unit(LAS unsigned char* lds, int tid, int wave, int lane, int tt, int g, const bf16* Z, bf16* YA, const float* wsp  , const float* bsp  , const float* vgp  , float* vout  ) {
    asm volatile("" : "+v"(tid), "+v"(lane), "+s"(wave));
    const int r0 = tt * 128; const bool sample = tt >= 64;
    {
        const int cq = tid & 31, sg = tid >> 5, c0 = 4 * cq;
        const f32x4 vg4 = *(const f32x4*)(vgp + c0);
        float vn[8][4];
#pragma unroll
        for (int j = 0; j < 8; ++j) { const int s = 8 * sg + j; const v2u w = *(const v2u*)(Z + (size_t)(r0 + s) * NIN + ZV + g * 128 + c0);
            const float x0 = bflo(w.x), x1 = bfhi(w.x), x2 = bflo(w.y), x3 = bfhi(w.y);
            float ss = (x0 * x0 + x1 * x1) + (x2 * x2 + x3 * x3);
            ss += lane_get(ss, lane ^ 1); ss += lane_get(ss, lane ^ 2); ss += lane_get(ss, lane ^ 4); ss += lane_get(ss, lane ^ 8); ss += lane_get(ss, lane ^ 16);
            const float rstd = frsq(ss * (1.f / 128.f) + EPS);
            vn[j][0] = x0 * rstd * vg4[0]; vn[j][1] = x1 * rstd * vg4[1]; vn[j][2] = x2 * rstd * vg4[2]; vn[j][3] = x3 * rstd * vg4[3];
            if (vout) *(f32x4*)(vout + (size_t)s * 1024 + c0) = (f32x4){vn[j][0], vn[j][1], vn[j][2], vn[j][3]}; }
#pragma unroll
        for (int c = 0; c < 4; ++c) { v4u p; p.x = pkbf(vn[0][c], vn[1][c]); p.y = pkbf(vn[2][c], vn[3][c]); p.z = pkbf(vn[4][c], vn[5][c]); p.w = pkbf(vn[6][c], vn[7][c]);
            *(LAS v4u*)(lds + MX_VNT + (c0 + c) * HP + 16 * sg) = p; }
    }
    {
        const int t = tid >> 2, sq = tid & 3;
#pragma unroll
        for (int jj = 0; jj < 4; ++jj) { const int s0 = sq * 32 + 8 * jj; float x[8];
            if (!sample) { const f32x4 a = *(const f32x4*)(wsp + t * 128 + s0), b = *(const f32x4*)(wsp + t * 128 + s0 + 4);
                x[0] = a[0]; x[1] = a[1]; x[2] = a[2]; x[3] = a[3]; x[4] = b[0]; x[5] = b[1]; x[6] = b[2]; x[7] = b[3];
#pragma unroll
                for (int e = 0; e < 8; ++e) x[e] = (s0 + e <= t) ? x[e] : 0.f; }
            else {
#pragma unroll
                for (int e = 0; e < 8; ++e) { const int s = s0 + e; x[e] = ((s >> 3) == (t >> 3) && (s & 7) <= (t & 7)) ? wsp[(t & 7) * 128 + (s & 7)] : 0.f; } }
            v4u p; p.x = pkbf(x[0], x[1]); p.y = pkbf(x[2], x[3]); p.z = pkbf(x[4], x[5]); p.w = pkbf(x[6], x[7]);
            *(LAS v4u*)(lds + MX_W + t * HP + s0 * 2) = p; }
    }
    LDS_BARRIER();
    const int i = lane & 15, q = lane >> 4;
    f32x4 acc[8];
#pragma unroll
    for (int ct = 0; ct < 8; ++ct) acc[ct] = (f32x4){0.f, 0.f, 0.f, 0.f};
    const int nks = (wave >> 1) + 1;
    for (int ks = 0; ks < nks; ++ks) { const bf16x8 Y = *(const LAS bf16x8*)(lds + MX_W + (16 * wave + i) * HP + (32 * ks + 8 * q) * 2);
#pragma unroll
        for (int ct = 0; ct < 8; ++ct) { const bf16x8 X = *(const LAS bf16x8*)(lds + MX_VNT + (16 * ct + i) * HP + (32 * ks + 8 * q) * 2); acc[ct] = MFMA16(X, Y, acc[ct]); } }
    const int t = 16 * wave + i; const float bias = bsp[sample ? (t & 7) : t];
#pragma unroll
    for (int ct = 0; ct < 8; ++ct) { const int c = g * 128 + 16 * ct + 4 * q; const v2u uw = *(const v2u*)(Z + (size_t)(r0 + t) * NIN + ZU + c);
        const float y0 = bflo(uw.x) * (acc[ct][0] + bias), y1 = bfhi(uw.x) * (acc[ct][1] + bias), y2 = bflo(uw.y) * (acc[ct][2] + bias), y3 = bfhi(uw.y) * (acc[ct][3] + bias);
        *(v2u*)(YA + (size_t)(r0 + t) * 1024 + c) = (v2u){pkbf(y0, y1), pkbf(y2, y3)}; }
    LDS_BARRIER();
}

constexpr int MD_PITCH = 144, MD_WT = 0, MD_AS = 128 * MD_PITCH, MD_BUF = MD_AS + 144 * MD_PITCH;
static_assert(2 * MD_BUF <= RING_BYTES, "mod lds");
DI void mod_direct(LAS unsigned char* lds, int tid, int wave, int lane, int slab, const float* cp, const float* cs, const float* adaw, const float* adab, float* MOD) {
    asm volatile("" : "+v"(tid), "+v"(lane), "+s"(wave));
    const int n0g = slab * 128, l = n0g / 12288, n0 = n0g - l * 12288, i = lane & 15, q = lane >> 4;
    const int wn = tid & 127, wk = tid >> 7;
    const float* W = adaw + (size_t)l * 2048 * 12288 + n0 + wn + (size_t)(16 * wk) * 12288;
    float wv[2][16]; f32x4 av[2][5];
    f32x4 acc[9];
#pragma unroll
    for (int mt = 0; mt < 9; ++mt) acc[mt] = (f32x4){0.f, 0.f, 0.f, 0.f};
#define MD_LOAD(kc, B) do { \
        _Pragma("unroll") for (int kk = 0; kk < 16; ++kk) wv[B][kk] = __builtin_nontemporal_load(W + (size_t)(64 * (kc) + kk) * 12288); \
        _Pragma("unroll") for (int ii = 0; ii < 5; ++ii) { const int idx = tid + 512 * ii, row = idx >> 4, c4 = idx & 15; \
            av[B][ii] = (f32x4){0.f, 0.f, 0.f, 0.f}; \
            if (idx < 2304 && row < NCOND) av[B][ii] = *(const f32x4*)((row < 4 ? cp + (size_t)row * DM : cs + (size_t)(row - 4) * DM) + 64 * (kc) + 4 * c4); } } while (0)
#define MD_STEP(kc, B) do { \
        LAS unsigned char* buf = lds + ((kc) & 1) * MD_BUF; \
        { v4u p0, p1; p0.x = pkbf(wv[B][0], wv[B][1]); p0.y = pkbf(wv[B][2], wv[B][3]); p0.z = pkbf(wv[B][4], wv[B][5]); p0.w = pkbf(wv[B][6], wv[B][7]); \
          p1.x = pkbf(wv[B][8], wv[B][9]); p1.y = pkbf(wv[B][10], wv[B][11]); p1.z = pkbf(wv[B][12], wv[B][13]); p1.w = pkbf(wv[B][14], wv[B][15]); \
          *(LAS v4u*)(buf + MD_WT + wn * MD_PITCH + 32 * wk) = p0; *(LAS v4u*)(buf + MD_WT + wn * MD_PITCH + 32 * wk + 16) = p1; } \
        _Pragma("unroll") for (int ii = 0; ii < 5; ++ii) { const int idx = tid + 512 * ii, row = idx >> 4, c4 = idx & 15; \
            if (idx < 2304) { const f32x4 v = av[B][ii]; \
                *(LAS v2u*)(buf + MD_AS + row * MD_PITCH + 8 * c4) = (v2u){pkbf(v[0] * sigm(v[0]), v[1] * sigm(v[1])), pkbf(v[2] * sigm(v[2]), v[3] * sigm(v[3]))}; } } \
        if ((kc) + 2 < 32) MD_LOAD((kc) + 2, B); \
        LDS_BARRIER(); \
        { bf16x8 X[2]; \
          _Pragma("unroll") for (int ks = 0; ks < 2; ++ks) X[ks] = *(const LAS bf16x8*)(buf + MD_WT + (16 * wave + i) * MD_PITCH + (32 * ks + 8 * q) * 2); \
          _Pragma("unroll") for (int mt = 0; mt < 9; ++mt) \
              _Pragma("unroll") for (int ks = 0; ks < 2; ++ks) { const bf16x8 Y = *(const LAS bf16x8*)(buf + MD_AS + (16 * mt + i) * MD_PITCH + (32 * ks + 8 * q) * 2); acc[mt] = MFMA16(X[ks], Y, acc[mt]); } } } while (0)
    MD_LOAD(0, 0); MD_LOAD(1, 1);
    for (int kc = 0; kc < 32; kc += 2) { MD_STEP(kc, 0); MD_STEP(kc + 1, 1); }
#undef MD_STEP
#undef MD_LOAD
    { const int n = n0g + 16 * wave + 4 * q; const f32x4 bias = *(const f32x4*)(adab + n);
#pragma unroll
      for (int mt = 0; mt < 9; ++mt) { const int cb = 16 * mt + i; if (cb < NCOND) *(f32x4*)(MOD + (size_t)cb * MODP + n) = acc[mt] + bias; } }
    LDS_BARRIER();
}

__global__ void __launch_bounds__(NWAVES * 64, 2) mk_fwd(Args args) {
    extern __shared__ __attribute__((aligned(16))) unsigned char lds_raw[];
    LAS unsigned char* lds = (LAS unsigned char*)lds_raw;
    volatile LAS unsigned* MISC = (volatile LAS unsigned*)(lds + MISC_OFF);
    const int wv0 = __builtin_amdgcn_readfirstlane((int)(threadIdx.x >> 6));
#define IDS() int tid = wv0 * 64 + hw_lane(); asm volatile("" : "+v"(tid)); const int lane = tid & 63, wave = __builtin_amdgcn_readfirstlane(tid >> 6), gw = vcu * NWAVES + wave; (void)lane; (void)gw
    const int G = gridDim.x, bx = blockIdx.x;
    const int vcu = (G % 8 == 0) ? (bx % 8) * (G / 8) + bx / 8 : bx;
    const int NGW = G * NWAVES;
    unsigned char* ws = args.ws;
    gu32* ctl = (gu32*)(ws + WS_CTL);
    for (int u = wv0 * 64 + hw_lane(); u < (LDS_BYTES - LDSCTL_OFF) / 4; u += NWAVES * 64) ((LAS unsigned*)(lds + LDSCTL_OFF))[u] = 0u;
    __syncthreads();
    XcdBarrier bar = xcd_barrier_post((unsigned*)(ctl + CW_BAR), MISC + 8, wv0);
#define GRID_BAR() do { XcdBarrier b_ = bar; int z_ = 0; asm volatile("" : "+s"(z_), "+s"(b_.x)); b_.bar += z_; xcd_barrier(b_); } while (0)

    float* MOD = (float*)(ws + WS_MOD);
    bf16* X = (bf16*)(ws + WS_X); bf16* H = (bf16*)(ws + WS_H); bf16* Z = (bf16*)(ws + WS_Z); bf16* UP = Z;
    bf16* YA = (bf16*)(ws + WS_YA); bf16* OB = (bf16*)(ws + WS_O); bf16* Y = (bf16*)(ws + WS_Y); bf16* ACT = (bf16*)(ws + WS_ACT);
    float* out = args.out; bf16* SLAB = (bf16*)(ws + WS_SLAB); bf16* Xs = X + (size_t)MP * DM;

    {
        IDS();
        for (int slab = bx; slab < 192; slab += G) mod_direct(lds, tid, wave, lane, slab, inp(args, I_CP), inp(args, I_CS), inp(args, I_ADAW), inp(args, I_ADAB), MOD);
        LAS float* scr = (LAS float*)(lds + RING_OFF + wave * 16384);
        constexpr int IT_IN = 32 * 448, IT_BA = 16 * 64, IT_BB = 32 * 64, IT_OUT = 32 * 64, IT_UP = 32 * 352, IT_DN = 88 * 64;
        const int nBA = (G == 256) ? 0 : IT_BA;
        const int IT_L = (G == 256) ? IT_IN + IT_BB + IT_OUT + IT_UP : IT_IN + IT_BA + IT_BB + IT_OUT + IT_UP + IT_DN;
        auto decode = [&](int it, P0It& d) {
            const int l = it / IT_L; int r = it - l * IT_L;
            if (r < IT_IN) { d = P0It{inp(args, I_WIN) + (size_t)l * 2048 * NIN, NIN, (bf16*)(ws + WS_WIN + l * SZ_WIN), 2048, r}; return; } r -= IT_IN;
            if (r < nBA) { d = P0It{inp(args, I_WBA) + (size_t)l * 1024 * 2048, 2048, (bf16*)(ws + WS_WBA + l * SZ_WBA), 1024, r}; return; } r -= nBA;
            if (r < IT_BB) { d = P0It{inp(args, I_WBB) + (size_t)l * 2048 * 2048, 2048, (bf16*)(ws + WS_WBB + l * SZ_WBB), 2048, r}; return; } r -= IT_BB;
            if (r < IT_OUT) { d = P0It{inp(args, I_WOUT) + (size_t)l * 2048 * 2048, 2048, (bf16*)(ws + WS_WOUT + l * SZ_WOUT), 2048, r}; return; } r -= IT_OUT;
            if (r < IT_UP) { d = P0It{inp(args, I_WUP) + (size_t)l * 2048 * NUP, NUP, (bf16*)(ws + WS_WUP + l * SZ_WUP), 2048, r}; return; } r -= IT_UP;
            d = P0It{inp(args, I_WDN) + (size_t)l * DFF * 2048, 2048, (bf16*)(ws + WS_WDN + l * SZ_WDN), DFF, r}; };
        { P0It da, db; float va[32], vb[32]; int it = gw;
          if (it < 2 * IT_L) { decode(it, da); p0_item_load(da, lane, va); }
          while (it < 2 * IT_L) {
              int itn = it + NGW; if (itn < 2 * IT_L) { decode(itn, db); p0_item_load(db, lane, vb); }
              p0_item_store(da, scr, lane, va);
              it = itn; if (it >= 2 * IT_L) break;
              itn = it + NGW; if (itn < 2 * IT_L) { decode(itn, da); p0_item_load(da, lane, va); }
              p0_item_store(db, scr, lane, vb);
              it = itn; } }
    }
    GRID_BAR();

    for (int l = 0; l < 2; ++l) {
        int bxl = blockIdx.x; asm volatile("" : "+s"(bxl));
        const float* modl = MOD + (size_t)l * 12288;
        const void* xin_p = (l == 0) ? (const void*)inp(args, I_XP) : (const void*)X; const void* xin_s = (l == 0) ? (const void*)inp(args, I_XS) : (const void*)Xs;
        { IDS(); norm_rows<false>(xin_p, xin_s, l != 0, l != 0, inp(args, I_N1) + l * DM, modl, H, nullptr, gw, NGW, lane, (l == 0) ? nullptr : SLAB, MOD + 5 * DM  , Xs, lds); }
        GRID_BAR();
        {
            pg8::Gemm g{H, (const bf16*)(ws + WS_WIN + l * SZ_WIN), MT, 40 * 256, DM}; pg8::StaticOrder S; S.init(MT, 40 * 256, DM, G, bxl);
            pg8::EpiZ E{Z, NIN, 0};
            pg8::gemm_phase<pg8::EpiZ, pg8::StaticOrder, true, true>(lds + RING_OFF, g, S, E, wv0);
        }
        if (G == 256 && bxl >= 160) {
            IDS();
            LAS float* scr = (LAS float*)(lds + RING_OFF + wave * 16384);
            constexpr int IT_DN = 88 * 64; const int w0 = (bxl - 160) * NWAVES + wave, nw = 96 * NWAVES;
            const float* wsrc = inp(args, I_WDN) + (size_t)l * DFF * 2048; bf16* wdst = (bf16*)(ws + WS_WDN + l * SZ_WDN);
            const float* wsrc2 = inp(args, I_WBA) + (size_t)l * 1024 * 2048; bf16* wdst2 = (bf16*)(ws + WS_WBA + l * SZ_WBA);
            for (int it = w0; it < IT_DN + 1024; it += nw) { int it_ = it; asm volatile("" : "+s"(it_));
                const bool sec = it_ >= IT_DN;
                const P0It d{sec ? wsrc2 : wsrc, 2048, sec ? wdst2 : wdst, sec ? 1024 : DFF, sec ? it_ - IT_DN : it_}; float v[32]; p0_item_load(d, lane, v); p0_item_store(d, scr, lane, v); }
        }
        GRID_BAR();
        {
            IDS();
            const float* hng = inp(args, I_HNG) + l * 2048; const float* lbp = inp(args, I_LB);
            for (int pu = bxl; pu < 64; pu += G) { const int b = pu >> 4, h = pu & 15;
                hgrn_prompt_unit(lds, tid, wave, lane, Z, OB, out + O_HP + ((size_t)(l * 4 + b) * 16 + h) * 16384, hng + h * 128, lbp, l, h, b * 2048, 32); }
            const int nb = (G > 64) ? G - 64 : G, jb = (G > 64) ? bxl - 64 : bxl;
            if (jb >= 0) for (int step = 0; step < 2; ++step) {
                if (((step ^ jb) & 1) == 0) {
                    pg8::Gemm g{H, (const bf16*)(ws + WS_WIN + l * SZ_WIN) + (size_t)40 * 256 * DM, MT, 16 * 256, DM}; pg8::StaticOrder S; S.init(MT, 16 * 256, DM, nb, jb);
                    pg8::EpiZ E{Z, NIN, 40};
                    pg8::gemm_phase<pg8::EpiZ, pg8::StaticOrder, true, true>(lds + RING_OFF, g, S, E, wv0);
                    continue;
                }
                hgrn_sample_loop(lds, tid, wave, lane, Z, OB, inp(args, I_SH) + (size_t)l * 2048 * 16384, out + O_HS + (size_t)l * 2048 * 16384, hng, lbp, l, jb, nb);
                for (int mu = jb; mu < 576; mu += nb) { const int tt = mu % 72, g = mu / 72;
                    float* vout = nullptr;
                    if (tt >= 64) vout = out + O_VS + ((size_t)l * 1024 + (size_t)(tt - 64) * 128) * 1024 + g * 128;
                    else if ((tt & 15) == 15) vout = out + O_VP + ((size_t)(l * 4 + (tt >> 4)) * 128) * 1024 + g * 128;
                    mixer_unit(lds, tid, wave, lane, tt, g, Z, YA, inp(args, I_WS) + (size_t)(l * 8 + g) * 16384, inp(args, I_BS) + (l * 8 + g) * 128, inp(args, I_VG) + l * 1024 + g * 128, vout); }
            }
        }
        GRID_BAR();
        {
            { pg8::SplitOrder S; S.init(1024, 4, G, bxl); pg8::Gemm g{YA, (const bf16*)(ws + WS_WBA + l * SZ_WBA), MT, DM, 1024};
              pg8::EpiSplit<pg8::EpiBranch<false>> E{{Z + ZGA, Y}, SLAB};
              pg8::gemm_phase<pg8::EpiSplit<pg8::EpiBranch<false>>, pg8::SplitOrder, true, true>(lds + RING_OFF, g, S, E, wv0); }
            { pg8::SplitOrder S; S.init(2048, 8, G, bxl); pg8::Gemm g{OB, (const bf16*)(ws + WS_WBB + l * SZ_WBB), MT, DM, 2048};
              pg8::EpiSplit<pg8::EpiBranch<true>> E{{Z + ZGB, Y}, SLAB + 4 * pg8::SLAB_ELEMS};
              pg8::gemm_phase<pg8::EpiSplit<pg8::EpiBranch<true>>, pg8::SplitOrder, true, true>(lds + RING_OFF, g, S, E, wv0); }
        }
        GRID_BAR();
        { IDS();
        for (int it = gw; it < 2 * MS; it += NGW) { const int r = it >> 1, c0 = (it & 1) * 1024 + 8 * lane;
            f32x4 a[2][2], b[2][2];
#pragma unroll
            for (int h = 0; h < 2; ++h) { a[h][0] = (f32x4){0.f, 0.f, 0.f, 0.f}; a[h][1] = a[h][0]; b[h][0] = a[h][0]; b[h][1] = a[h][0]; }
            v4u w[12][2];
#pragma unroll
            for (int s2 = 0; s2 < 12; ++s2)
#pragma unroll
                for (int h = 0; h < 2; ++h) w[s2][h] = *(const v4u*)(SLAB + (size_t)s2 * pg8::SLAB_ELEMS + (size_t)r * DM + c0 + 512 * h);
            const bf16* zr = Z + (size_t)(MP + r) * NIN + c0;
            v4u ga[2], gb[2];
#pragma unroll
            for (int h = 0; h < 2; ++h) { ga[h] = *(const v4u*)(zr + ZGA + 512 * h); gb[h] = *(const v4u*)(zr + ZGB + 512 * h); }
#pragma unroll
            for (int s2 = 0; s2 < 12; ++s2)
#pragma unroll
                for (int h = 0; h < 2; ++h) { const v4u x = w[s2][h]; const f32x4 lo = {bflo(x.x), bfhi(x.x), bflo(x.y), bfhi(x.y)}, hi = {bflo(x.z), bfhi(x.z), bflo(x.w), bfhi(x.w)};
                    if (s2 < 4) { a[h][0] += lo; a[h][1] += hi; } else { b[h][0] += lo; b[h][1] += hi; } }
#pragma unroll
            for (int h = 0; h < 2; ++h) { const v4u p = ga[h], q = gb[h];
                const f32x4 gal = {bflo(p.x), bfhi(p.x), bflo(p.y), bfhi(p.y)}, gah = {bflo(p.z), bfhi(p.z), bflo(p.w), bfhi(p.w)}, gbl = {bflo(q.x), bfhi(q.x), bflo(q.y), bfhi(q.y)}, gbh = {bflo(q.z), bfhi(q.z), bflo(q.w), bfhi(q.w)};
                const f32x4 yl = gal * a[h][0] + gbl * b[h][0], yh = gah * a[h][1] + gbh * b[h][1];
                v4u o; o.x = pkbf(yl.x, yl.y); o.y = pkbf(yl.z, yl.w); o.z = pkbf(yh.x, yh.y); o.w = pkbf(yh.z, yh.w);
                *(v4u*)(Y + (size_t)(MP + r) * DM + c0 + 512 * h) = o; } } }
        GRID_BAR();
        {
            pg8::SplitOrder S; S.init(DM, 8, G, bxl); pg8::Gemm g{Y, (const bf16*)(ws + WS_WOUT + l * SZ_WOUT), MT, DM, DM};
            pg8::EpiSplit<pg8::EpiResid> E{{(const float*)xin_p, X, modl + 2 * DM, l == 0}, SLAB};
            pg8::gemm_phase<pg8::EpiSplit<pg8::EpiResid>, pg8::SplitOrder, true, true>(lds + RING_OFF, g, S, E, wv0);
        }
        GRID_BAR();
        { IDS(); norm_rows<false>(X, xin_s, true, l != 0, inp(args, I_N2) + l * DM, modl + 3 * DM, H, nullptr, gw, NGW, lane, SLAB, modl + 2 * DM, Xs, lds); }
        GRID_BAR();
        {
            pg8::Gemm g{H, (const bf16*)(ws + WS_WUP + l * SZ_WUP), MT, NUP, DM}; pg8::UpOrder S; S.init(G, bxl);
            pg8::EpiUpSplit E{{UP, out + O_CP + (size_t)l * 4 * 2 * NUP, out + O_CS + (size_t)l * 128 * 2 * NUP}, SLAB};
            pg8::gemm_phase<pg8::EpiUpSplit, pg8::UpOrder, true, true>(lds + RING_OFF, g, S, E, wv0);
        }
        GRID_BAR();
        {
            const float* cw = inp(args, I_CW) + (size_t)l * 3 * NUP; const float* cbias = inp(args, I_CB) + (size_t)l * NUP; const float* cst = inp(args, I_SC) + (size_t)l * 128 * 2 * NUP;
            IDS();
            constexpr int NWC = DFF / 512, NRG = MT / 8, NSB = 4;
            const int nseg = NGW / NWC;
            if (gw < nseg * NWC) {
                const int wcb = gw % NWC, sg = gw / NWC, col = (wcb * 64 + lane) * 8;
                constexpr int NPR = MP / 8, NSR = MS / 8;
                const bool wdeal = nseg > NSR && 5 * NSR < NPR;
                const int pr0 = wdeal ? (sg < NSR ? 5 * sg : 5 * NSR + ((sg - NSR) * (NPR - 5 * NSR)) / (nseg - NSR)) : (sg * NPR) / nseg;
                const int pr1 = wdeal ? (sg < NSR ? 5 * sg + 5 : 5 * NSR + ((sg + 1 - NSR) * (NPR - 5 * NSR)) / (nseg - NSR)) : ((sg + 1) * NPR) / nseg;
                float wa[3][8], wb[3][8], ba[8], bb[8];
#pragma unroll
                for (int k = 0; k < 3; ++k) { const f32x4 a0 = *(const f32x4*)(cw + k * NUP + col), a1 = *(const f32x4*)(cw + k * NUP + col + 4), b0 = *(const f32x4*)(cw + k * NUP + DFF + col), b1 = *(const f32x4*)(cw + k * NUP + DFF + col + 4);
#pragma unroll
                    for (int e = 0; e < 4; ++e) { wa[k][e] = a0[e]; wa[k][4 + e] = a1[e]; wb[k][e] = b0[e]; wb[k][4 + e] = b1[e]; } }
                { const f32x4 a0 = *(const f32x4*)(cbias + col), a1 = *(const f32x4*)(cbias + col + 4), b0 = *(const f32x4*)(cbias + DFF + col), b1 = *(const f32x4*)(cbias + DFF + col + 4);
#pragma unroll
                  for (int e = 0; e < 4; ++e) { ba[e] = a0[e]; ba[4 + e] = a1[e]; bb[e] = b0[e]; bb[4 + e] = b1[e]; } }
                const bool slabcols = col >= 2560;
                for (int part = 0;; ++part) {
                int rg0 = pr0, rg1 = pr1;
                if (part > 0) { const int srg = sg + (part - 1) * nseg; if (srg >= NSR) break; rg0 = NPR + srg; rg1 = rg0 + 1; }
                for (int rs = rg0; rs < rg1;) {
                    float pa2[8], pa1[8], pb2[8], pb1[8];
                    const int rb = rs * 8;
                    int re = rs + 1;
                    if (rb >= MP) { const float* s0 = cst + (size_t)((rb - MP) >> 3) * 2 * NUP + col;
#pragma unroll
                        for (int e = 0; e < 8; ++e) { pa2[e] = s0[e]; pa1[e] = s0[NUP + e]; pb2[e] = s0[DFF + e]; pb1[e] = s0[NUP + DFF + e]; } }
                    else {
                        re = ((rs >> 8) + 1) << 8; re = re < rg1 ? re : rg1;
                        if ((rb & 2047) == 0) {
#pragma unroll
                            for (int e = 0; e < 8; ++e) { pa2[e] = 0.f; pa1[e] = 0.f; pb2[e] = 0.f; pb1[e] = 0.f; } }
                        else { const v4u a2 = *(const v4u*)(UP + (size_t)(rb - 2) * NUP + col), a1 = *(const v4u*)(UP + (size_t)(rb - 1) * NUP + col), b2 = *(const v4u*)(UP + (size_t)(rb - 2) * NUP + DFF + col), b1 = *(const v4u*)(UP + (size_t)(rb - 1) * NUP + DFF + col);
#pragma unroll
                            for (int e = 0; e < 4; ++e) { pa2[2 * e] = bflo(a2[e]); pa2[2 * e + 1] = bfhi(a2[e]); pa1[2 * e] = bflo(a1[e]); pa1[2 * e + 1] = bfhi(a1[e]);
                                pb2[2 * e] = bflo(b2[e]); pb2[2 * e + 1] = bfhi(b2[e]); pb1[2 * e] = bflo(b1[e]); pb1[2 * e + 1] = bfhi(b1[e]); } } }
                    for (int rg = rs; rg < re; ++rg) {
                    const int r0 = rg * 8;
                    const bool fromslab = (r0 >= MP) && slabcols;
                    if (!fromslab) {
#pragma unroll
                        for (int jb = 0; jb < 8; jb += 8) {
                        v4u avr[8], bvr[8];
#pragma unroll
                        for (int j = 0; j < 8; ++j) { avr[j] = *(const v4u*)(UP + (size_t)(r0 + jb + j) * NUP + col); bvr[j] = *(const v4u*)(UP + (size_t)(r0 + jb + j) * NUP + DFF + col); }
#pragma unroll
                        for (int jj = 0; jj < 8; ++jj) { const int j = jb + jj; float ca[8], cb2[8], res[8];
#pragma unroll
                            for (int e = 0; e < 4; ++e) { ca[2 * e] = bflo(avr[jj][e]); ca[2 * e + 1] = bfhi(avr[jj][e]); cb2[2 * e] = bflo(bvr[jj][e]); cb2[2 * e + 1] = bfhi(bvr[jj][e]); }
#pragma unroll
                            for (int e = 0; e < 8; ++e) { const float a = ba[e] + wa[0][e] * pa2[e] + wa[1][e] * pa1[e] + wa[2][e] * ca[e]; const float b = bb[e] + wb[0][e] * pb2[e] + wb[1][e] * pb1[e] + wb[2][e] * cb2[e];
                                res[e] = gelu_t(a) * b; pa2[e] = pa1[e]; pa1[e] = ca[e]; pb2[e] = pb1[e]; pb1[e] = cb2[e]; }
                            v4u w; w.x = pkbf(res[0], res[1]); w.y = pkbf(res[2], res[3]); w.z = pkbf(res[4], res[5]); w.w = pkbf(res[6], res[7]);
                            *(v4u*)(ACT + (size_t)(r0 + j) * DFF + col) = w; }
                        asm volatile("" ::: "memory"); }
                    } else
#pragma unroll
                    for (int jb = 0; jb < 8; jb += NSB) {
                        v4u avs[NSB], sls[NSB][4];
#pragma unroll
                        for (int jj = 0; jj < NSB; ++jj) { avs[jj] = *(const v4u*)(UP + (size_t)(r0 + jb + jj) * NUP + col);
                            const bf16* sp = SLAB + (size_t)(r0 - MP + jb + jj) * 3072 + (col - 2560);
#pragma unroll
                            for (int q = 0; q < 4; ++q) sls[jj][q] = *(const v4u*)(sp + q * pg8::UPSLAB_ELEMS); }
#pragma unroll
                        for (int jj = 0; jj < NSB; ++jj) { const int j = jb + jj; const v4u av = avs[jj];
                        float ca[8], cb2[8], res[8];
#pragma unroll
                        for (int e = 0; e < 4; ++e) { ca[2 * e] = bflo(av[e]); ca[2 * e + 1] = bfhi(av[e]); }
                        { f32x4 s0 = {0.f, 0.f, 0.f, 0.f}, s1 = s0;
#pragma unroll
                          for (int q = 0; q < 4; ++q) { const v4u w = sls[jj][q]; s0 += (f32x4){bflo(w.x), bfhi(w.x), bflo(w.y), bfhi(w.y)}; s1 += (f32x4){bflo(w.z), bfhi(w.z), bflo(w.w), bfhi(w.w)}; }
#pragma unroll
                          for (int e = 0; e < 4; ++e) { cb2[e] = s0[e]; cb2[4 + e] = s1[e]; }
                          if (j >= 6) { float* fo = out + O_CS + (size_t)l * 128 * 2 * NUP + (size_t)(((r0 - MP) >> 3) * 2 + (j - 6)) * NUP + DFF + col; *(f32x4*)fo = s0; *(f32x4*)(fo + 4) = s1; } }
#pragma unroll
                        for (int e = 0; e < 8; ++e) { const float a = ba[e] + wa[0][e] * pa2[e] + wa[1][e] * pa1[e] + wa[2][e] * ca[e]; const float b = bb[e] + wb[0][e] * pb2[e] + wb[1][e] * pb1[e] + wb[2][e] * cb2[e];
                            res[e] = gelu_t(a) * b; pa2[e] = pa1[e]; pa1[e] = ca[e]; pb2[e] = pb1[e]; pb1[e] = cb2[e]; }
                        v4u w; w.x = pkbf(res[0], res[1]); w.y = pkbf(res[2], res[3]); w.z = pkbf(res[4], res[5]); w.w = pkbf(res[6], res[7]);
                        *(v4u*)(ACT + (size_t)(r0 + j) * DFF + col) = w; }
                        asm volatile("" ::: "memory"); }
                    }
                    rs = re;
                }
                }
            }
        }
        GRID_BAR();
        {
            pg8::Gemm g{ACT, (const bf16*)(ws + WS_WDN + l * SZ_WDN), MT, DM, DFF}; pg8::SplitOrder S; S.init(DFF, 8, G, bxl);
            pg8::EpiSplit<pg8::EpiResid> E{{nullptr, X, modl + 5 * DM, false}, SLAB};
            pg8::gemm_phase<pg8::EpiSplit<pg8::EpiResid>, pg8::SplitOrder, true, true>(lds + RING_OFF, g, S, E, wv0);
        }
        GRID_BAR();
    }
    { IDS(); norm_rows<true>(X, Xs, true, true, inp(args, I_FNG), nullptr, nullptr, out, gw, NGW, lane, SLAB, MOD + 12288 + 5 * DM  , nullptr, lds); }
}

extern "C" void kernel_launch(void* const* d_in, const int* in_sizes, int n_in, void* d_out, int out_size, void* d_ws, size_t ws_size, hipStream_t stream) {
    static int grid = 0;
    if (grid == 0) {
        if (n_in != 24 || (size_t)out_size != O_END || ws_size < WS_END) { fprintf(stderr, "kernel_launch: unexpected shapes (n_in %d, out %d, ws %zu); nothing launched\n", n_in, out_size, ws_size); grid = -1; return; }
        int dev = 0, cus = 0, per_cu = 0;
        if (hipGetDevice(&dev) != hipSuccess || hipDeviceGetAttribute(&cus, hipDeviceAttributeMultiprocessorCount, dev) != hipSuccess) { grid = -1; return; }
        if (hipFuncSetAttribute((const void*)mk_fwd, hipFuncAttributeMaxDynamicSharedMemorySize, LDS_BYTES) != hipSuccess) { fprintf(stderr, "kernel_launch: hipFuncSetAttribute failed\n"); grid = -1; return; }
        if (hipOccupancyMaxActiveBlocksPerMultiprocessor(&per_cu, (const void*)mk_fwd, NWAVES * 64, LDS_BYTES) != hipSuccess || per_cu < 1) { fprintf(stderr, "kernel_launch: occupancy query reports %d blocks per CU\n", per_cu); }
        (void)hipGetLastError();
        grid = cus;
    }
    if (grid < 0) return;
    if (hipMemsetAsync((char*)d_ws + WS_CTL, 0, CTL_ZERO_BYTES, stream) != hipSuccess) return;
    Args a{};
    for (int i = 0; i < 24; ++i) a.in[i] = (const float*)d_in[i];
    a.out = (float*)d_out; a.ws = (unsigned char*)d_ws;
    hipLaunchKernelGGL(mk_fwd, dim3(grid), dim3(NWAVES * 64), LDS_BYTES, stream, a);
}
```
